# Optimizing an MI355X kernel written in HIP

```python
import jax, jax.numpy as jnp
from jax import lax
import numpy as np

D_MODEL = 1024
BATCH = 8
SEQ = 4096
DEPTH = 2

CHUNK = 64
N_EVEN = (DEPTH + 1) // 2
N_ODD = DEPTH // 2
EPS = 1e-6

POOL_WINDOWS = (2, 4, 8, 16)
POOL_GROUP = D_MODEL // 8
POOL_WIDTH = POOL_GROUP * len(POOL_WINDOWS)
SC_WIDTH = D_MODEL // 2
SC_GROUPS = 8
CONV_WIDTH = 3
AB_IN = POOL_WIDTH + 3 * SC_WIDTH
AB_OUT = POOL_WIDTH + SC_WIDTH
GLA_HEADS = 4
GLA_DK = D_MODEL // 2
GLA_DV = D_MODEL
GLA_HK = GLA_DK // GLA_HEADS
GLA_HV = GLA_DV // GLA_HEADS
GLA_RANK = 16
GLA_TAU = 16.0
GLA_IN = 2 * GLA_DK + 2 * GLA_DV + GLA_RANK
D_FF = 2816

kernel_name = "hybrid_pool_shortconv_gla_convffn"


def rmsnorm(x, g):
    xf = x.astype(jnp.float32)
    y = xf * lax.rsqrt(jnp.mean(xf * xf, axis=-1, keepdims=True) + EPS)
    return (y * g.astype(jnp.float32)).astype(x.dtype)


def causal_dwconv(u, w, b):
    k = w.shape[0]
    s = u.shape[1]
    up = jnp.pad(u, ((0, 0), (k - 1, 0), (0, 0)))
    y = b
    for i in range(k):
        y = y + up[:, i:i + s] * w[i]
    return y


def pool_mixer(u, w, b, scale):
    bsz, s, _ = u.shape
    t = jnp.arange(1, s + 1, dtype=jnp.float32)[None, :, None]
    uf = u.astype(jnp.float32)
    outs = []
    for gi, win in enumerate(POOL_WINDOWS):
        ug = uf[..., gi * POOL_GROUP:(gi + 1) * POOL_GROUP]
        c = jnp.cumsum(ug, axis=1)
        c_lag = jnp.pad(c, ((0, 0), (win, 0), (0, 0)))[:, :s]
        mean = (c - c_lag) / jnp.minimum(t, float(win))
        outs.append(mean - ug)
    p = jnp.stack(outs, axis=2).astype(u.dtype)
    y = jnp.einsum('bsgc,gcd->bsgd', p, w).reshape(bsz, s, POOL_WIDTH) + b
    return y * scale


def gla_mixer(h, w_g2, b_g, norm_g):
    bsz, s, _ = h.shape
    f32 = jnp.float32
    q, k, v, r, gl = jnp.split(h, [GLA_DK, 2 * GLA_DK, 2 * GLA_DK + GLA_DV, 2 * GLA_DK + 2 * GLA_DV], axis=-1)
    g = jax.nn.log_sigmoid((gl @ w_g2 + b_g).astype(f32)) / GLA_TAU
    n = s // CHUNK

    def heads(t, hd):
        return t.astype(f32).reshape(bsz, n, CHUNK, GLA_HEADS, hd).transpose(0, 3, 1, 2, 4)

    q = heads(q, GLA_HK) * (GLA_HK ** -0.5)
    k = heads(k, GLA_HK)
    v = heads(v, GLA_HV)
    bcum = jnp.cumsum(heads(g, GLA_HK), axis=3)
    b_last = bcum[:, :, :, -1:]
    q_in = q * jnp.exp(bcum)
    k_in = k * jnp.exp(-bcum)
    mask = jnp.tril(jnp.ones((CHUNK, CHUNK), dtype=bool))
    att = jnp.where(mask, jnp.einsum('bhnlk,bhnmk->bhnlm', q_in, k_in), 0.0)
    o_intra = jnp.einsum('bhnlm,bhnmv->bhnlv', att, v)
    kv = jnp.einsum('bhnlk,bhnlv->bhnkv', k * jnp.exp(b_last - bcum), v)
    decay = jnp.exp(b_last[:, :, :, 0])

    def step(state, inp):
        kv_n, d_n = inp
        return d_n[..., None] * state + kv_n, state

    init = jnp.zeros((bsz, GLA_HEADS, GLA_HK, GLA_HV), f32)
    _, states = lax.scan(step, init, (jnp.moveaxis(kv, 2, 0), jnp.moveaxis(decay, 2, 0)))
    states = jnp.moveaxis(states, 0, 2)
    o = o_intra + jnp.einsum('bhnlk,bhnkv->bhnlv', q_in, states)
    o = o.transpose(0, 2, 3, 1, 4).reshape(bsz, s, GLA_HEADS, GLA_HV)
    o = o * lax.rsqrt(jnp.mean(o * o, axis=-1, keepdims=True) + EPS) * norm_g.astype(f32)
    o = o.reshape(bsz, s, GLA_DV) * jax.nn.silu(r.astype(f32))
    return o.astype(h.dtype)


def conv_ffn(h, w_up, conv_w, conv_b, w_down):
    u, v = jnp.split(h @ w_up, 2, axis=-1)
    u = causal_dwconv(u, conv_w, conv_b)
    return (jax.nn.gelu(u, approximate=False) * v) @ w_down


def setup_inputs(seed: int = 0) -> dict:
    key = jax.random.key(seed)
    ks = jax.random.split(key, 24)
    nrm = jax.random.normal
    f = jnp.float32
    return {
        "x": nrm(ks[0], (BATCH, SEQ, D_MODEL), f),
        "mix_norm": 1.0 + 0.02 * nrm(ks[1], (DEPTH, D_MODEL), f),
        "ffn_norm": 1.0 + 0.02 * nrm(ks[2], (DEPTH, D_MODEL), f),
        "ab_w_in": nrm(ks[3], (N_EVEN, D_MODEL, AB_IN), f) * D_MODEL ** -0.5,
        "pool_w": nrm(ks[4], (N_EVEN, len(POOL_WINDOWS), POOL_GROUP, POOL_GROUP), f) * POOL_GROUP ** -0.5,
        "pool_b": 0.02 * nrm(ks[5], (N_EVEN, POOL_WIDTH), f),
        "pool_scale": 1.0 + 0.02 * nrm(ks[6], (N_EVEN, POOL_WIDTH), f),
        "sc_conv_w": nrm(ks[7], (N_EVEN, CONV_WIDTH, SC_WIDTH), f) * CONV_WIDTH ** -0.5,
        "sc_conv_b": 0.02 * nrm(ks[8], (N_EVEN, SC_WIDTH), f),
        "ab_w_out": nrm(ks[9], (N_EVEN, AB_OUT, D_MODEL), f) * AB_OUT ** -0.5,
        "gla_w_in": nrm(ks[10], (N_ODD, D_MODEL, GLA_IN), f) * D_MODEL ** -0.5,
        "gla_w_g2": nrm(ks[11], (N_ODD, GLA_RANK, GLA_DK), f) * GLA_RANK ** -0.5,
        "gla_b_g": 0.1 * nrm(ks[12], (N_ODD, GLA_DK), f),
        "gla_norm": 1.0 + 0.02 * nrm(ks[13], (N_ODD, GLA_HV), f),
        "gla_w_out": nrm(ks[14], (N_ODD, GLA_DV, D_MODEL), f) * GLA_DV ** -0.5,
        "ffn_w_up": nrm(ks[15], (DEPTH, D_MODEL, 2 * D_FF), f) * D_MODEL ** -0.5,
        "ffn_conv_w": nrm(ks[16], (DEPTH, CONV_WIDTH, D_FF), f) * CONV_WIDTH ** -0.5,
        "ffn_conv_b": 0.02 * nrm(ks[17], (DEPTH, D_FF), f),
        "ffn_w_down": nrm(ks[18], (DEPTH, D_FF, D_MODEL), f) * D_FF ** -0.5,
        "final_norm": 1.0 + 0.02 * nrm(ks[19], (D_MODEL,), f),
    }


def reference(x, mix_norm, ffn_norm, ab_w_in, pool_w, pool_b, pool_scale, sc_conv_w, sc_conv_b,
              ab_w_out, gla_w_in, gla_w_g2, gla_b_g, gla_norm, gla_w_out, ffn_w_up, ffn_conv_w,
              ffn_conv_b, ffn_w_down, final_norm):
    for l in range(DEPTH):
        hn = rmsnorm(x, mix_norm[l])
        i = l // 2
        if l % 2 == 0:
            h = hn @ ab_w_in[i]
            pu, sb, sc, sx = jnp.split(h, [POOL_WIDTH, POOL_WIDTH + SC_WIDTH, POOL_WIDTH + 2 * SC_WIDTH], axis=-1)
            ya = pool_mixer(pu, pool_w[i], pool_b[i], pool_scale[i])
            yb = sb * causal_dwconv(sc * sx, sc_conv_w[i], sc_conv_b[i])
            y = jnp.concatenate([ya, yb], axis=-1) @ ab_w_out[i]
        else:
            y = gla_mixer(hn @ gla_w_in[i], gla_w_g2[i], gla_b_g[i], gla_norm[i]) @ gla_w_out[i]
        x = x + y
        x = x + conv_ffn(rmsnorm(x, ffn_norm[l]), ffn_w_up[l], ffn_conv_w[l], ffn_conv_b[l], ffn_w_down[l])
    return rmsnorm(x, final_norm)
```

```cpp
#include <hip/hip_runtime.h>
#include <hip/hip_cooperative_groups.h>
#include <cstdio>
#include <cstdint>
namespace cg = cooperative_groups;
__device__ __forceinline__ int fresh_tid() { int t = threadIdx.x; asm volatile("" : "+v"(t)); return t; }
namespace pg8 {
#define PG8_LAS __attribute__((address_space(3)))
typedef unsigned short bf16_t;
typedef short bf16x8 __attribute__((ext_vector_type(8)));
typedef float f32x4 __attribute__((ext_vector_type(4)));
typedef unsigned u32x4 __attribute__((ext_vector_type(4)));
constexpr int BM = 256, BK = 64, HALF = 128, HTB = HALF * BK * 2  , STAGE_BYTES = 8 * HTB, NXCD = 8, WGM = 8;

__host__ __device__ __forceinline__ int lds_byte(int r, int c) { const int st = (r >> 4) * 2 + (c >> 5), rr = r & 15, cc = c & 31, ob = rr * 64 + cc * 2; return st * 1024 + (ob ^ (((ob >> 9) & 1) << 5)); }
__host__ __device__ __forceinline__ void stage_rc(int b, int& R, int& C) { const int st = b / 1024, sb = b % 1024, swz = sb ^ (((sb >> 9) & 1) << 5); R = (st >> 1) * 16 + swz / 64; C = (st & 1) * 32 + (swz % 64) / 2; }
__host__ __device__ __forceinline__ int perm32(int rho) { const int n = rho >> 4, i = rho & 15; return 8 * (i >> 2) + 4 * n + (i & 3); }

struct Unit { int pm, pn; };
struct Gemm { const bf16_t* A; const bf16_t* Bt; int M, N, K; };

struct StaticOrder {
    int nM, nN, nwg, G, c;
    __host__ __device__ void init(int M, int N, int G_, int c_) { nM = M / BM; nN = N / BM; nwg = nM * nN; G = G_; c = c_; }
    __host__ __device__ bool next(int i, Unit& u) const {
        const long L = (long)i * G + c; if (L >= nwg) return false;
        int wgid = (int)L; { const int q = nwg / NXCD, r = nwg % NXCD, xcd = wgid % NXCD, off = wgid / NXCD; wgid = (xcd < r ? xcd * (q + 1) : r * (q + 1) + (xcd - r) * q) + off; }
        const int nig = WGM * nN, gid = wgid / nig, fm = gid * WGM, gsz = (nM - fm) < WGM ? (nM - fm) : WGM;
        u.pm = fm + ((wgid % nig) % gsz); u.pn = (wgid % nig) / gsz; return true;
    }
    __device__ __forceinline__ void a_ready(const Unit&) const {}
    __device__ __forceinline__ void done(const Unit&) const {}
};

typedef float f32x2c_t __attribute__((ext_vector_type(2))); typedef __bf16 bf16x2c_t __attribute__((ext_vector_type(2)));
__device__ __forceinline__ unsigned cvt_pk_bf16(float lo, float hi) { const f32x2c_t v = {lo, hi}; const bf16x2c_t b = __builtin_convertvector(v, bf16x2c_t); return __builtin_bit_cast(unsigned, b); }
typedef float f32x2 __attribute__((ext_vector_type(2)));
__device__ __forceinline__ f32x2 gelu_pk(f32x2 v) {
    const f32x2 av = __builtin_elementwise_abs(v), d = av * 0.2316418882f + 1.0f;
    f32x2 t; t.x = __builtin_amdgcn_rcpf(d.x); t.y = __builtin_amdgcn_rcpf(d.y);
    f32x2 q = t * 0.5307027145f + (-0.7265760135f); q = q * t + 0.7107068705f; q = q * t + (-0.142248368f); q = q * t + 0.127414796f; q = q * t;
    const f32x2 s = (v * v) * (-0.72134752044f);
    f32x2 e; e.x = __builtin_amdgcn_exp2f(s.x); e.y = __builtin_amdgcn_exp2f(s.y);
    const f32x2 m = av * (q * e);
    return __builtin_elementwise_max(v, (f32x2){0.f, 0.f}) - m;
}
}
namespace pg8 {
template <class Epi, class Sched, bool ALIGN_EPI = false, bool SP2 = false, bool APERM = false  >
__device__ __forceinline__ void gemm_phase(PG8_LAS unsigned char* lds, const Gemm g, const Sched& S, const Epi& E) {
    const int tid = fresh_tid(), wid = __builtin_amdgcn_readfirstlane(tid >> 6), lane = tid & 63, wr = wid >> 2, wc = wid & 3, fr = lane & 15, fq = lane >> 4;
    const int K = g.K, nt = K / BK;
    unsigned voffA[2], voffB[2];
#pragma unroll
    for (int i = 0; i < 2; ++i) { int R, C; stage_rc(tid * 16 + i * 8192, R, C); const int Rb = Epi::PERM ? ((R & ~31) + perm32(R & 31)) : R;
        const int Ra = APERM ? ((R & ~63) + 4 * (R & 15) + ((R >> 4) & 3)) : R;
        voffA[i] = (unsigned)(Ra * K + C) * 2u; voffB[i] = (unsigned)(Rb * K + C) * 2u; }
    const size_t kstep = (size_t)(BK * 2);
    const size_t hstep = (size_t)HALF * K * 2;
    const size_t tstep = 2 * hstep;
    const unsigned ldsw = (unsigned)wid * 1024u;
    const int aoff = lds_byte(wr * 64 + fr, fq * 8), boff = lds_byte(wc * 32 + fr, fq * 8);
#define PG8_SA(b, h) (((b) * 2 + (h)) * HTB)
#define PG8_SB(b, h) ((4 + (b) * 2 + (h)) * HTB)
#define PG8_STAGE(bufoff, gbase, voff) do { _Pragma("unroll") for (int _i = 0; _i < 2; ++_i) \
        __builtin_amdgcn_global_load_lds((const unsigned*)((const char*)(gbase) + (voff)[_i]), (PG8_LAS unsigned*)(lds + (bufoff) + ldsw + _i * 8192), 16, 0, 0); } while (0)
#define PG8_LDA(dst, b, h) do { _Pragma("unroll") for (int m = 0; m < 4; ++m) _Pragma("unroll") for (int k = 0; k < 2; ++k) dst[m][k] = *(const PG8_LAS bf16x8*)(lds + PG8_SA(b, h) + aoff + m * 2048 + k * 1024); } while (0)
#define PG8_LDB(dst, b, h) do { _Pragma("unroll") for (int n = 0; n < 2; ++n) _Pragma("unroll") for (int k = 0; k < 2; ++k) dst[n][k] = *(const PG8_LAS bf16x8*)(lds + PG8_SB(b, h) + boff + n * 2048 + k * 1024); } while (0)
#define PG8_MMA(ai, bj, At, Bt) do { __builtin_amdgcn_s_setprio(1); _Pragma("unroll") for (int m = 0; m < 4; ++m) _Pragma("unroll") for (int n = 0; n < 2; ++n) _Pragma("unroll") for (int k = 0; k < 2; ++k) \
        acc[ai][bj][m][n] = __builtin_amdgcn_mfma_f32_16x16x32_bf16(Bt[n][k], At[m][k], acc[ai][bj][m][n], 0, 0, 0); __builtin_amdgcn_s_setprio(0); } while (0)
#define PG8_WAIT_V(n) asm volatile("s_waitcnt vmcnt(" #n ")" ::: "memory")
#define PG8_WAIT_L(n) asm volatile("s_waitcnt lgkmcnt(" #n ")" ::: "memory")
#define PG8_BAR __builtin_amdgcn_s_barrier()
#define PG8_SCHED __builtin_amdgcn_sched_barrier(0)
    Unit cur, nxt; int ui = 0;
    if (!S.next(0, cur)) return;
    f32x4 acc[2][2][4][2];
#pragma unroll
    for (int a = 0; a < 2; ++a)
#pragma unroll
        for (int b = 0; b < 2; ++b)
#pragma unroll
            for (int m = 0; m < 4; ++m)
#pragma unroll
                for (int n = 0; n < 2; ++n) acc[a][b][m][n] = (f32x4){0.f, 0.f, 0.f, 0.f};
    bf16x8 At[4][2], B0[2][2], B1[2][2];
    const char* cA = (const char*)g.A + (size_t)cur.pm * tstep; const char* cB = (const char*)g.Bt + (size_t)cur.pn * tstep;
    S.a_ready(cur);
    if constexpr (SP2) {
        PG8_STAGE(PG8_SB(0, 0), cB, voffB); PG8_STAGE(PG8_SB(0, 1), cB + hstep, voffB); PG8_STAGE(PG8_SA(0, 0), cA, voffA); PG8_STAGE(PG8_SA(0, 1), cA + hstep, voffA);
        if (wr == 1) PG8_BAR;
        PG8_WAIT_V(2); PG8_BAR;
        PG8_STAGE(PG8_SB(1, 0), cB + kstep, voffB); PG8_STAGE(PG8_SA(1, 0), cA + kstep, voffA); PG8_STAGE(PG8_SB(1, 1), cB + hstep + kstep, voffB);
        PG8_WAIT_V(6); PG8_BAR;
    } else {
        PG8_STAGE(PG8_SB(0, 0), cB, voffB); PG8_STAGE(PG8_SA(0, 0), cA, voffA); PG8_STAGE(PG8_SB(0, 1), cB + hstep, voffB); PG8_STAGE(PG8_SA(0, 1), cA + hstep, voffA);
        if (wr == 1) PG8_BAR;
        PG8_WAIT_V(4); PG8_BAR;
        PG8_STAGE(PG8_SB(1, 0), cB + kstep, voffB); PG8_STAGE(PG8_SA(1, 0), cA + kstep, voffA); PG8_STAGE(PG8_SB(1, 1), cB + hstep + kstep, voffB);
        PG8_WAIT_V(6); PG8_BAR;
    }
    for (;;) {
        const bool has_next = S.next(ui + 1, nxt);
        const char* nA = has_next ? (const char*)g.A + (size_t)nxt.pm * tstep : cA; const char* nB = has_next ? (const char*)g.Bt + (size_t)nxt.pn * tstep : cB;
        for (int t = 0; t < nt; t += 2) {
            const bool last = (t == nt - 2);
            const char* a1 = cA + (size_t)(t + 1) * kstep;
            const char* a2 = last ? nA : cA + (size_t)(t + 2) * kstep; const char* b2 = last ? nB : cB + (size_t)(t + 2) * kstep;
            const char* a3 = a2 + kstep; const char* b3 = b2 + kstep;
            if (last && has_next) S.a_ready(nxt);
            if constexpr (SP2) {
            PG8_LDB(B0, 0, 0); PG8_LDB(B1, 0, 1); PG8_SCHED; PG8_LDA(At, 0, 0); PG8_STAGE(PG8_SA(1, 1), a1 + hstep, voffA);
            PG8_WAIT_V(8); PG8_WAIT_L(0); PG8_BAR; PG8_MMA(0, 0, At, B0); PG8_MMA(0, 1, At, B1); PG8_BAR; PG8_SCHED;
            PG8_LDA(At, 0, 1); PG8_STAGE(PG8_SB(0, 0), b2, voffB); PG8_STAGE(PG8_SB(0, 1), b2 + hstep, voffB); PG8_STAGE(PG8_SA(0, 0), a2, voffA);
            PG8_WAIT_V(8); PG8_WAIT_L(0); PG8_BAR; PG8_MMA(1, 0, At, B0); PG8_MMA(1, 1, At, B1); PG8_BAR; PG8_SCHED;
            PG8_LDB(B0, 1, 0); PG8_LDB(B1, 1, 1); PG8_SCHED; PG8_LDA(At, 1, 0); PG8_STAGE(PG8_SA(0, 1), a2 + hstep, voffA);
            PG8_WAIT_V(8); PG8_WAIT_L(0); PG8_BAR; PG8_MMA(0, 0, At, B0); PG8_MMA(0, 1, At, B1); PG8_BAR; PG8_SCHED;
            PG8_LDA(At, 1, 1); PG8_STAGE(PG8_SB(1, 0), b3, voffB); PG8_STAGE(PG8_SB(1, 1), b3 + hstep, voffB); PG8_STAGE(PG8_SA(1, 0), a3, voffA);
            PG8_WAIT_V(8); PG8_WAIT_L(0); PG8_BAR; PG8_MMA(1, 0, At, B0); PG8_MMA(1, 1, At, B1); PG8_BAR; PG8_SCHED;
            } else {
            PG8_LDB(B0, 0, 0); PG8_SCHED; PG8_LDA(At, 0, 0); PG8_STAGE(PG8_SA(1, 1), a1 + hstep, voffA);
            PG8_WAIT_L(8); PG8_BAR; PG8_WAIT_L(0); PG8_MMA(0, 0, At, B0); PG8_BAR; PG8_SCHED;
            PG8_LDB(B1, 0, 1); PG8_STAGE(PG8_SB(0, 0), b2, voffB);
            PG8_BAR; PG8_WAIT_L(0); PG8_MMA(0, 1, At, B1); PG8_BAR;
            PG8_LDA(At, 0, 1); PG8_STAGE(PG8_SA(0, 0), a2, voffA);
            PG8_BAR; PG8_WAIT_L(0); PG8_MMA(1, 0, At, B0); PG8_BAR; PG8_SCHED;
            PG8_STAGE(PG8_SB(0, 1), b2 + hstep, voffB);
            PG8_WAIT_V(6); PG8_BAR; PG8_MMA(1, 1, At, B1); PG8_BAR;
            PG8_LDB(B0, 1, 0); PG8_SCHED; PG8_LDA(At, 1, 0); PG8_STAGE(PG8_SA(0, 1), a2 + hstep, voffA);
            PG8_WAIT_L(8); PG8_BAR; PG8_WAIT_L(0); PG8_MMA(0, 0, At, B0); PG8_BAR; PG8_SCHED;
            PG8_LDB(B1, 1, 1); PG8_STAGE(PG8_SB(1, 0), b3, voffB);
            PG8_BAR; PG8_WAIT_L(0); PG8_MMA(0, 1, At, B1); PG8_BAR;
            PG8_LDA(At, 1, 1); PG8_STAGE(PG8_SA(1, 0), a3, voffA);
            PG8_BAR; PG8_WAIT_L(0); PG8_MMA(1, 0, At, B0); PG8_BAR; PG8_SCHED;
            PG8_STAGE(PG8_SB(1, 1), b3 + hstep, voffB);
            PG8_WAIT_V(6); PG8_BAR; PG8_MMA(1, 1, At, B1); PG8_BAR;
            }
        }
        if constexpr (ALIGN_EPI) { if (wr == 0) PG8_BAR; }
        if constexpr (!Epi::AFTER_DRAIN) { E(acc, cur, wr, wc, fr, fq); S.done(cur); }
        if (!has_next) break;
#pragma unroll
        for (int a = 0; a < 2; ++a)
#pragma unroll
            for (int b = 0; b < 2; ++b)
#pragma unroll
                for (int m = 0; m < 4; ++m)
#pragma unroll
                    for (int n = 0; n < 2; ++n) acc[a][b][m][n] = (f32x4){0.f, 0.f, 0.f, 0.f};
        cur = nxt; cA = nA; cB = nB; ++ui;
        if constexpr (ALIGN_EPI) { if (wr == 1) PG8_BAR; }
    }
    PG8_WAIT_V(0);
    if constexpr (!ALIGN_EPI) { if (wr == 0) PG8_BAR; }
    PG8_BAR;
    if constexpr (Epi::AFTER_DRAIN) { E.fused(acc, cur, wr, wc, fr, fq, lds, wid, lane); S.done(cur); }
#undef PG8_SA
#undef PG8_SB
#undef PG8_STAGE
#undef PG8_LDA
#undef PG8_LDB
#undef PG8_MMA
#undef PG8_WAIT_V
#undef PG8_WAIT_L
#undef PG8_BAR
#undef PG8_SCHED
}
}
namespace pg8 {
template <int CTRL> __device__ __forceinline__ float dppf(float v) { return __builtin_bit_cast(float, __builtin_amdgcn_update_dpp(0, __builtin_bit_cast(int, v), CTRL, 0xf, 0xf, false)); }

template <int CTRL> __device__ __forceinline__ float dppo(float old, float v) { return __builtin_bit_cast(float, __builtin_amdgcn_update_dpp(__builtin_bit_cast(int, old), __builtin_bit_cast(int, v), CTRL, 0xf, 0xf, false)); }
struct EpiBf16P {
    static constexpr bool PERM = true, AFTER_DRAIN = false;
    bf16_t* O; int ldc; const float* rss;
    __device__ __forceinline__ void operator()(const f32x4 (&acc)[2][2][4][2], const Unit& u, int wr, int wc, int fr, int fq) const {
        const int row0 = u.pm * BM + wr * 64 + fr, col0 = u.pn * BM + wc * 32 + 8 * fq;
#pragma unroll
        for (int ai = 0; ai < 2; ++ai)
#pragma unroll
            for (int m = 0; m < 4; ++m) { const int row = row0 + ai * HALF + m * 16; bf16_t* rowp = O + (size_t)row * ldc + col0;
                const float rs = rss ? __builtin_amdgcn_rsqf(((rss[row] + rss[32768 + row]) + (rss[65536 + row] + rss[98304 + row])) * (1.f / 1024.f) + 1e-6f) : 1.f;
#pragma unroll
                for (int bj = 0; bj < 2; ++bj) { const f32x4 v0 = acc[ai][bj][m][0] * rs, v1 = acc[ai][bj][m][1] * rs;
                    u32x4 w; w.x = cvt_pk_bf16(v0[0], v0[1]); w.y = cvt_pk_bf16(v0[2], v0[3]); w.z = cvt_pk_bf16(v1[0], v1[1]); w.w = cvt_pk_bf16(v1[2], v1[3]);
                    *(u32x4*)(rowp + bj * HALF) = w; } }
    }
};
struct EpiRes {
    static constexpr bool PERM = true, AFTER_DRAIN = false;
    const float* base32; bf16_t* xs; int ldc; float* rssp; PG8_LAS float* red;
    __device__ __forceinline__ void operator()(const f32x4 (&acc)[2][2][4][2], const Unit& u, int wr, int wc, int fr, int fq) const {
        const int col0 = u.pn * BM + wc * 32 + 8 * fq;
        const size_t off0 = (size_t)(u.pm * BM + wr * 64 + fr) * ldc + col0;
#pragma unroll
        for (int ai = 0; ai < 2; ++ai) {
            u32x4 bv[4][2];
#pragma unroll
            for (int m = 0; m < 4; ++m)
#pragma unroll
                for (int bj = 0; bj < 2; ++bj) bv[m][bj] = *(const u32x4*)(xs + off0 + (size_t)(ai * HALF + m * 16) * ldc + bj * HALF);
#pragma unroll
            for (int m = 0; m < 4; ++m) { float ss = 0.f;
#pragma unroll
                for (int bj = 0; bj < 2; ++bj) { const size_t off = off0 + (size_t)(ai * HALF + m * 16) * ldc + bj * HALF; const u32x4 b = bv[m][bj];
                    f32x4 o0 = (f32x4){__builtin_bit_cast(float, b.x << 16), __builtin_bit_cast(float, b.x & 0xffff0000u), __builtin_bit_cast(float, b.y << 16), __builtin_bit_cast(float, b.y & 0xffff0000u)};
                    f32x4 o1 = (f32x4){__builtin_bit_cast(float, b.z << 16), __builtin_bit_cast(float, b.z & 0xffff0000u), __builtin_bit_cast(float, b.w << 16), __builtin_bit_cast(float, b.w & 0xffff0000u)};
                    o0 = o0 + acc[ai][bj][m][0]; o1 = o1 + acc[ai][bj][m][1];
                    ss += ((o0[0] * o0[0] + o0[1] * o0[1]) + (o0[2] * o0[2] + o0[3] * o0[3])) + ((o1[0] * o1[0] + o1[1] * o1[1]) + (o1[2] * o1[2] + o1[3] * o1[3]));
                    u32x4 w; w.x = cvt_pk_bf16(o0[0], o0[1]); w.y = cvt_pk_bf16(o0[2], o0[3]); w.z = cvt_pk_bf16(o1[0], o1[1]); w.w = cvt_pk_bf16(o1[2], o1[3]); *(u32x4*)(xs + off) = w; }
                ss += __shfl_xor(ss, 16); ss += __shfl_xor(ss, 32);
                if (fq == 0) red[wc * 256 + ai * HALF + wr * 64 + m * 16 + fr] = ss; }
            asm volatile("" ::: "memory"); }
        asm volatile("s_waitcnt lgkmcnt(0)" ::: "memory"); __builtin_amdgcn_s_barrier(); asm volatile("" ::: "memory");
        if (wr == 0) { const int row = wc * 64 + fq * 16 + fr;
            rssp[(size_t)u.pn * 32768 + u.pm * BM + row] = (red[row] + red[256 + row]) + (red[512 + row] + red[768 + row]); }
    }
};
struct EpiResFinal {
    static constexpr bool PERM = true, AFTER_DRAIN = false;
    const bf16_t* xs; float* out; int ldc; float* rssp; const float* g; unsigned* cnt; PG8_LAS float* red;
    __device__ __forceinline__ void operator()(const f32x4 (&acc_)[2][2][4][2], const Unit& u, int wr, int wc, int fr, int fq) const {
        f32x4 (&acc)[2][2][4][2] = const_cast<f32x4 (&)[2][2][4][2]>(acc_);
        const int col0 = u.pn * BM + wc * 32 + 8 * fq;
        const size_t off0 = (size_t)(u.pm * BM + wr * 64 + fr) * ldc + col0;
#pragma unroll
        for (int ai = 0; ai < 2; ++ai) {
          u32x4 bv[4][2];
#pragma unroll
          for (int m = 0; m < 4; ++m)
#pragma unroll
              for (int bj = 0; bj < 2; ++bj) bv[m][bj] = *(const u32x4*)(xs + off0 + (size_t)(ai * HALF + m * 16) * ldc + bj * HALF);
#pragma unroll
            for (int m = 0; m < 4; ++m) { float ss = 0.f;
#pragma unroll
                for (int bj = 0; bj < 2; ++bj) {
                    const u32x4 b = bv[m][bj];
                    const f32x4 o0 = (f32x4){__builtin_bit_cast(float, b.x << 16), __builtin_bit_cast(float, b.x & 0xffff0000u), __builtin_bit_cast(float, b.y << 16), __builtin_bit_cast(float, b.y & 0xffff0000u)} + acc[ai][bj][m][0];
                    const f32x4 o1 = (f32x4){__builtin_bit_cast(float, b.z << 16), __builtin_bit_cast(float, b.z & 0xffff0000u), __builtin_bit_cast(float, b.w << 16), __builtin_bit_cast(float, b.w & 0xffff0000u)} + acc[ai][bj][m][1];
                    ss += ((o0[0] * o0[0] + o0[1] * o0[1]) + (o0[2] * o0[2] + o0[3] * o0[3])) + ((o1[0] * o1[0] + o1[1] * o1[1]) + (o1[2] * o1[2] + o1[3] * o1[3]));
                    acc[ai][bj][m][0] = o0; acc[ai][bj][m][1] = o1; }
                ss += __shfl_xor(ss, 16); ss += __shfl_xor(ss, 32);
                if (fq == 0) red[wc * 256 + ai * HALF + wr * 64 + m * 16 + fr] = ss;
                asm volatile("" ::: "memory"); } }
        asm volatile("s_waitcnt lgkmcnt(0)" ::: "memory"); __builtin_amdgcn_s_barrier(); asm volatile("" ::: "memory");
        const int trow = wc * 64 + fq * 16 + fr;
        float* slot = rssp + (size_t)u.pm * BM + trow;
        if (wr == 0) __hip_atomic_store(slot + (size_t)u.pn * 32768, (red[trow] + red[256 + trow]) + (red[512 + trow] + red[768 + trow]), __ATOMIC_RELAXED, __HIP_MEMORY_SCOPE_AGENT);
        asm volatile("s_waitcnt vmcnt(0)" ::: "memory"); __builtin_amdgcn_s_barrier(); asm volatile("" ::: "memory");
        if (wr == 0 && wc == 0 && fq == 0 && fr == 0) {
            unsigned* c = cnt + 64 * u.pm; __hip_atomic_fetch_add(c, 1u, __ATOMIC_RELAXED, __HIP_MEMORY_SCOPE_AGENT);
            unsigned spins = 0; while (__hip_atomic_load(c, __ATOMIC_RELAXED, __HIP_MEMORY_SCOPE_AGENT) < 4u && ++spins < (1u << 22)) __builtin_amdgcn_s_sleep(1);
        }
        asm volatile("s_waitcnt vmcnt(0)" ::: "memory"); __builtin_amdgcn_s_barrier(); asm volatile("" ::: "memory");
        if (wr == 0) { const float t = (__hip_atomic_load(slot, __ATOMIC_RELAXED, __HIP_MEMORY_SCOPE_AGENT) + __hip_atomic_load(slot + 32768, __ATOMIC_RELAXED, __HIP_MEMORY_SCOPE_AGENT))
                                     + (__hip_atomic_load(slot + 65536, __ATOMIC_RELAXED, __HIP_MEMORY_SCOPE_AGENT) + __hip_atomic_load(slot + 98304, __ATOMIC_RELAXED, __HIP_MEMORY_SCOPE_AGENT));
            red[1024 + trow] = __builtin_amdgcn_rsqf(t * (1.f / 1024.f) + 1e-6f); }
        asm volatile("s_waitcnt lgkmcnt(0)" ::: "memory"); __builtin_amdgcn_s_barrier(); asm volatile("" ::: "memory");
#pragma unroll
        for (int bj = 0; bj < 2; ++bj) { const f32x4 g0 = *(const f32x4*)(g + col0 + bj * HALF), g1 = *(const f32x4*)(g + col0 + bj * HALF + 4);
#pragma unroll
            for (int ai = 0; ai < 2; ++ai)
#pragma unroll
                for (int m = 0; m < 4; ++m) { const float rs = red[1024 + ai * HALF + wr * 64 + m * 16 + fr]; const size_t off = off0 + (size_t)(ai * HALF + m * 16) * ldc + bj * HALF;
                    *(f32x4*)(out + off) = acc[ai][bj][m][0] * rs * g0; *(f32x4*)(out + off + 4) = acc[ai][bj][m][1] * rs * g1; } }
    }
};
struct EpiFfnUp {
    static constexpr bool PERM = true, AFTER_DRAIN = false;
    static constexpr int FFD = 2816;
    bf16_t* act; const float* cw; const float* cb; float* ulast; float* ufirst; float* vfirst; PG8_LAS f32x4* xch; const float* rss;
    __device__ __forceinline__ void operator()(const f32x4 (&acc)[2][2][4][2], const Unit& u, int wr, int wc, int fr, int fq) const {
        const int ch0 = u.pn * 128 + wc * 32 + 8 * fq;
        f32x4 w0[2], w1[2], w2[2], bb[2];
#pragma unroll
        for (int n = 0; n < 2; ++n) { w0[n] = *(const f32x4*)(cw + ch0 + 4 * n); w1[n] = *(const f32x4*)(cw + FFD + ch0 + 4 * n); w2[n] = *(const f32x4*)(cw + 2 * FFD + ch0 + 4 * n); bb[n] = *(const f32x4*)(cb + ch0 + 4 * n); }
        PG8_LAS float* tab = (PG8_LAS float*)(xch + 256);
#define RSTD4(r_) __builtin_amdgcn_rsqf(((rss[(r_)] + rss[32768 + (r_)]) + (rss[65536 + (r_)] + rss[98304 + (r_)])) * (1.f / 1024.f) + 1e-6f)
        if (wr == 0) { const int trow = wc * 64 + fq * 16 + fr; tab[trow] = RSTD4(u.pm * BM + trow); }
        const int rl = wr * 64 + 4 * fr;
        if (fr == 15) {
#pragma unroll
            for (int ai = 0; ai < 2; ++ai)
#pragma unroll
                for (int q = 0; q < 2; ++q) { PG8_LAS f32x4* s = xch + (((((ai * 2 + wr) * 4 + wc) * 4 + fq) * 2 + q) * 2); s[0] = acc[ai][0][2 + q][0]; s[1] = acc[ai][0][2 + q][1]; }
        }
        asm volatile("s_waitcnt lgkmcnt(0)" ::: "memory"); __builtin_amdgcn_s_barrier(); asm volatile("" ::: "memory");
        if (fr == 15 && wr == 1) {
#pragma unroll
            for (int q = 0; q < 2; ++q) { const float r3 = tab[rl + HALF + 2 + q]; float* g = ulast + (size_t)(u.pm * 2 + q) * FFD + ch0; *(f32x4*)g = acc[1][0][2 + q][0] * r3; *(f32x4*)(g + 4) = acc[1][0][2 + q][1] * r3; } }
        if (fr == 0 && wr == 0) {
#pragma unroll
            for (int q = 0; q < 2; ++q) { const float r0 = tab[q]; float* g = ufirst + (size_t)(u.pm * 2 + q) * FFD + ch0; *(f32x4*)g = acc[0][0][q][0] * r0; *(f32x4*)(g + 4) = acc[0][0][q][1] * r0;
                float* h = vfirst + (size_t)(u.pm * 2 + q) * FFD + ch0; *(f32x4*)h = acc[0][1][q][0] * r0; *(f32x4*)(h + 4) = acc[0][1][q][1] * r0; } }
#pragma unroll
        for (int ai = 0; ai < 2; ++ai) {
            f32x4 h2[2] = {(f32x4){0.f, 0.f, 0.f, 0.f}, (f32x4){0.f, 0.f, 0.f, 0.f}}, h3[2] = {h2[0], h2[0]};
            if (wr == 1 || ai == 1) { const int sai = (wr == 1) ? ai : 0, swr = (wr == 1) ? 0 : 1;
                const PG8_LAS f32x4* s = xch + ((((sai * 2 + swr) * 4 + wc) * 4 + fq) * 2) * 2; const float ra = tab[sai * HALF + swr * 64 + 62], rb = tab[sai * HALF + swr * 64 + 63];
                h2[0] = s[0] * ra; h2[1] = s[1] * ra; h3[0] = s[2] * rb; h3[1] = s[3] * rb; }
            const f32x4 rs4 = *(const PG8_LAS f32x4*)(tab + rl + ai * HALF);
            f32x4 us[4][2];
#pragma unroll
            for (int m = 0; m < 4; ++m) { us[m][0] = acc[ai][0][m][0] * rs4[m]; us[m][1] = acc[ai][0][m][1] * rs4[m]; }
            f32x4 s2[2], s3[2];
#pragma unroll
            for (int n = 0; n < 2; ++n)
#pragma unroll
                for (int e = 0; e < 4; ++e) { s2[n][e] = dppo<0x111>(h2[n][e], us[2][n][e]); s3[n][e] = dppo<0x111>(h3[n][e], us[3][n][e]); }
#pragma unroll
            for (int m = 0; m < 4; ++m) {
                f32x4 uc[2];
#pragma unroll
                for (int n = 0; n < 2; ++n) { const f32x4 um1 = (m == 0) ? s3[n] : us[m - 1][n], um2 = (m == 0) ? s2[n] : (m == 1) ? s3[n] : us[m - 2][n];
                    uc[n] = bb[n] + w0[n] * um2 + w1[n] * um1 + w2[n] * us[m][n]; }
                const f32x4 v0 = acc[ai][1][m][0] * rs4[m], v1 = acc[ai][1][m][1] * rs4[m];
                const f32x2 a = gelu_pk((f32x2){uc[0][0], uc[0][1]}), b = gelu_pk((f32x2){uc[0][2], uc[0][3]}), c = gelu_pk((f32x2){uc[1][0], uc[1][1]}), d = gelu_pk((f32x2){uc[1][2], uc[1][3]});
                u32x4 w; w.x = cvt_pk_bf16(a.x * v0[0], a.y * v0[1]); w.y = cvt_pk_bf16(b.x * v0[2], b.y * v0[3]); w.z = cvt_pk_bf16(c.x * v1[0], c.y * v1[1]); w.w = cvt_pk_bf16(d.x * v1[2], d.y * v1[3]);
                *(u32x4*)(act + (size_t)(u.pm * BM + ai * HALF + rl + m) * FFD + ch0) = w;
            }
        }
    }
};
}
#define LAS __attribute__((address_space(3)))
typedef unsigned short bf16;
typedef unsigned v4u __attribute__((ext_vector_type(4)));
typedef unsigned v2u __attribute__((ext_vector_type(2)));
typedef float f32x4 __attribute__((ext_vector_type(4)));
typedef float f32x2 __attribute__((ext_vector_type(2)));
typedef short bf16x8 __attribute__((ext_vector_type(8)));
constexpr int NWAVES = 8, NTHR = 512;
constexpr int BATCH = 8, SEQ = 4096, D = 1024, M = BATCH * SEQ, FFD = 2816, NUP = 2 * FFD, NAB = 2048, NGLA = 3584, GLA_SRC_N = 3088;
constexpr float EPS = 1e-6f;
constexpr size_t MiB = 1u << 20;
constexpr size_t WS_DEC = 1 * MiB, WS_ULAST = 2 * MiB, WS_UFIRST = 5 * MiB, WS_VFIRST = 8 * MiB;
constexpr size_t WS_WABIN = 12 * MiB, WS_WABOUT = 16 * MiB, WS_WGLAIN = 18 * MiB, WS_WGLAOUT = 25 * MiB, WS_WUP = 27 * MiB  , WS_WDN = 49 * MiB  ;
constexpr size_t WS_XN = 64 * MiB, WS_CAT = 128 * MiB, WS_H = 192 * MiB, WS_XS = 416 * MiB  , WS_END = 480 * MiB;
constexpr int LDS_BYTES = 147456, XCH_OFF = 131072;
#ifndef PHM
#define PHM 0xffff
#endif

__device__ __forceinline__ float bflo(unsigned w) { return __builtin_bit_cast(float, w << 16); }
__device__ __forceinline__ float bfhi(unsigned w) { return __builtin_bit_cast(float, w & 0xffff0000u); }
__device__ __forceinline__ unsigned pk2(float lo, float hi) { return pg8::cvt_pk_bf16(lo, hi); }
__device__ __forceinline__ float wave_sum(float v) {
#pragma unroll
    for (int o = 1; o < 64; o <<= 1) v += __shfl_xor(v, o);
    return v;
}
#define LDS_WAIT() asm volatile("s_waitcnt lgkmcnt(0)" ::: "memory")

__device__ __forceinline__ void transpose_item(const float* W, int ldw, int K, bf16* WT, int k0, int n0, int trow0, LAS float* scr, int lane, const float* g = nullptr) {
    float tv[32];
#pragma unroll
    for (int i = 0; i < 32; ++i) { const int kk = 2 * i + (lane >> 5); tv[i] = W[(size_t)(k0 + kk) * ldw + n0 + (lane & 31)]; }
#pragma unroll
    for (int i = 0; i < 32; ++i) { const int kk = 2 * i + (lane >> 5); scr[kk * 33 + (lane & 31)] = tv[i] * (g ? g[k0 + kk] : 1.f); }
    LDS_WAIT(); asm volatile("" ::: "memory");
    const int c = lane & 7;
#pragma unroll
    for (int j = 0; j < 4; ++j) { const int n = (lane >> 3) + 8 * j; const LAS float* s = scr + (8 * c) * 33 + n;
        v4u o; o.x = pk2(s[0 * 33], s[1 * 33]); o.y = pk2(s[2 * 33], s[3 * 33]); o.z = pk2(s[4 * 33], s[5 * 33]); o.w = pk2(s[6 * 33], s[7 * 33]);
        *(v4u*)(WT + (size_t)(trow0 + n) * K + k0 + 8 * c) = o; }
    LDS_WAIT(); asm volatile("" ::: "memory");
}

struct Args { const float* in[20]; float* out; unsigned char* ws; };

__device__ __forceinline__ void convert_rows(const float* X, bf16* XS, float* rss, int gw, int ngw, int lane) {
#pragma unroll 2
    for (int m = gw; m < M; m += ngw) {
        const f32x4* xr = (const f32x4*)(X + (size_t)m * D) + lane;
        f32x4 v[4]; float s = 0.f;
#pragma unroll
        for (int j = 0; j < 4; ++j) { v[j] = xr[64 * j]; s += (v[j].x * v[j].x + v[j].y * v[j].y) + (v[j].z * v[j].z + v[j].w * v[j].w); }
        s = wave_sum(s);
        unsigned long long* o8 = (unsigned long long*)(XS + (size_t)m * D) + lane;
#pragma unroll
        for (int j = 0; j < 4; ++j) o8[64 * j] = (unsigned long long)pk2(v[j].x, v[j].y) | ((unsigned long long)pk2(v[j].z, v[j].w) << 32);
        if (lane < 4) rss[(size_t)lane * 32768 + m] = lane == 0 ? s : 0.f;
    }
}
__device__ __forceinline__ void final_norm_rows(const bf16* XS, float* OUT, const float* g, const float* rss, int gw, int ngw, int lane) {
    f32x4 gv[4];
#pragma unroll
    for (int j = 0; j < 4; ++j) gv[j] = ((const f32x4*)g)[lane + 64 * j];
#pragma unroll 4
    for (int m = gw; m < M; m += ngw) {
        const v2u* xr = (const v2u*)(XS + (size_t)m * D) + lane; f32x4* orow = (f32x4*)(OUT + (size_t)m * D) + lane;
        const float rstd = rsqrtf(((rss[m] + rss[32768 + m]) + (rss[65536 + m] + rss[98304 + m])) * (1.f / D) + EPS);
#pragma unroll
        for (int j = 0; j < 4; ++j) { const v2u w = xr[64 * j]; orow[64 * j] = (f32x4){bflo(w.x), bfhi(w.x), bflo(w.y), bfhi(w.y)} * rstd * gv[j]; }
    }
}

__device__ __forceinline__ void unpack8(const v4u w, float (&f)[8]) {
    f[0] = bflo(w.x); f[1] = bfhi(w.x); f[2] = bflo(w.y); f[3] = bfhi(w.y); f[4] = bflo(w.z); f[5] = bfhi(w.z); f[6] = bflo(w.w); f[7] = bfhi(w.w);
}
__device__ __forceinline__ void ab_mixer(const bf16* H, bf16* CAT, const float* pool_b, const float* pool_scale, const float* scw, const float* scb, int wg, int nwg, int tid) {
    const int cv = tid & 127, sub = tid >> 7;
    float pa[8], pb[8], pc[8], pd[8];
    if (cv < 64) {
#pragma unroll
        for (int e = 0; e < 8; ++e) { pa[e] = pool_b[cv * 8 + e]; pb[e] = pool_scale[cv * 8 + e]; pc[e] = 0.f; pd[e] = 0.f; }
    } else {
        const int c = (cv - 64) * 8;
#pragma unroll
        for (int e = 0; e < 8; ++e) { pa[e] = scw[c + e]; pb[e] = scw[512 + c + e]; pc[e] = scw[1024 + c + e]; pd[e] = scb[c + e]; }
    }
    for (int chunk = wg * 4 + sub; chunk < M / 32; chunk += nwg * 4) {
        const int r0 = chunk * 32, t0 = r0 & (SEQ - 1);
        bf16* outp = CAT + (size_t)r0 * D + cv * 8;
        if (cv < 64) {
            const int win = 2 << (cv >> 4);
            const bf16* p = H + (size_t)r0 * NAB + cv * 8;
            float s[8], f[8];
#pragma unroll
            for (int e = 0; e < 8; ++e) s[e] = 0.f;
            if (t0 > 0) for (int i = 1; i < win; ++i) { unpack8(*(const v4u*)(p - (size_t)i * NAB), f);
#pragma unroll
                for (int e = 0; e < 8; ++e) s[e] += f[e]; }
#pragma unroll 4
            for (int jr = 0; jr < 32; ++jr) {
                const int t = t0 + jr; float cur[8], y[8];
                unpack8(*(const v4u*)(p + (size_t)jr * NAB), cur);
                if (jr >= 1 && t >= win) { unpack8(*(const v4u*)(p + (ptrdiff_t)(jr - win) * NAB), f);
#pragma unroll
                    for (int e = 0; e < 8; ++e) s[e] -= f[e]; }
#pragma unroll
                for (int e = 0; e < 8; ++e) s[e] += cur[e];
                const float inv = 1.f / (float)((t + 1) < win ? (t + 1) : win);
#pragma unroll
                for (int e = 0; e < 8; ++e) y[e] = (s[e] * inv - cur[e] + pa[e]) * pb[e];
                v4u o; o.x = pk2(y[0], y[1]); o.y = pk2(y[2], y[3]); o.z = pk2(y[4], y[5]); o.w = pk2(y[6], y[7]);
                *(v4u*)(outp + (size_t)jr * D) = o;
            }
        } else {
            const bf16* p = H + (size_t)r0 * NAB + (cv - 64) * 8;
            float p1[8], p2[8], a[8], b[8];
#pragma unroll
            for (int e = 0; e < 8; ++e) { p1[e] = 0.f; p2[e] = 0.f; }
            if (t0 > 0) { unpack8(*(const v4u*)(p - NAB + 1024), a); unpack8(*(const v4u*)(p - NAB + 1536), b);
#pragma unroll
                for (int e = 0; e < 8; ++e) p1[e] = a[e] * b[e];
                unpack8(*(const v4u*)(p - 2 * NAB + 1024), a); unpack8(*(const v4u*)(p - 2 * NAB + 1536), b);
#pragma unroll
                for (int e = 0; e < 8; ++e) p2[e] = a[e] * b[e]; }
#pragma unroll 4
            for (int jr = 0; jr < 32; ++jr) {
                float sb[8], y[8];
                unpack8(*(const v4u*)(p + (size_t)jr * NAB + 512), sb); unpack8(*(const v4u*)(p + (size_t)jr * NAB + 1024), a); unpack8(*(const v4u*)(p + (size_t)jr * NAB + 1536), b);
#pragma unroll
                for (int e = 0; e < 8; ++e) { const float pr = a[e] * b[e]; y[e] = sb[e] * (pd[e] + pc[e] * pr + pb[e] * p1[e] + pa[e] * p2[e]); p2[e] = p1[e]; p1[e] = pr; }
                v4u o; o.x = pk2(y[0], y[1]); o.y = pk2(y[2], y[3]); o.z = pk2(y[4], y[5]); o.w = pk2(y[6], y[7]);
                *(v4u*)(outp + (size_t)jr * D) = o;
            }
        }
    }
}

__device__ __forceinline__ float gate_log(float z) { return (fminf(z, 0.f) - __logf(1.f + __expf(-fabsf(z)))) * (1.f / 16.f); }
__device__ __forceinline__ void gla_prep(bf16* H, bf16* KDT, float* DEC, const float* b_g, int wg, int nwg, int tid) {
    const int half = tid >> 8, cp = tid & 255, c = 2 * cp;
    const float bg0 = b_g[c], bg1 = b_g[c + 1];
    const float QS = 0.08838834764831845f;
    for (int it = wg * 2 + half; it < BATCH * 64; it += nwg * 2) {
        bf16* base = H + (size_t)it * 64 * NGLA + c;
        unsigned cg[8], cq[8], ck[8], ng[8], nq[8], nk[8];
#pragma unroll
        for (int m = 0; m < 8; ++m) { const bf16* rp = base + (size_t)m * NGLA; cg[m] = *(const unsigned*)(rp + 3072); cq[m] = *(const unsigned*)rp; ck[m] = *(const unsigned*)(rp + 512); }
        float c0 = 0.f, c1 = 0.f;
        v4u* o0 = (v4u*)(KDT + ((size_t)it * 512 + c) * 64); v4u* o1 = o0 + 8;
        for (int g = 0; g < 8; ++g) {
            bf16* gb = base + (size_t)(g * 8) * NGLA;
            if (g < 7) {
#pragma unroll
                for (int m = 0; m < 8; ++m) { const bf16* rp = gb + (size_t)(8 + m) * NGLA; ng[m] = *(const unsigned*)(rp + 3072); nq[m] = *(const unsigned*)rp; nk[m] = *(const unsigned*)(rp + 512); }
            }
            unsigned kd0[4], kd1[4]; float h0 = 0.f, h1 = 0.f;
#pragma unroll
            for (int m = 0; m < 8; ++m) { bf16* rp = gb + (size_t)m * NGLA;
                c0 += gate_log(bflo(cg[m]) + bg0); c1 += gate_log(bfhi(cg[m]) + bg1);
                const float d0 = bflo(ck[m]) * __expf(-c0), d1 = bfhi(ck[m]) * __expf(-c1);
                *(unsigned*)rp = pk2(bflo(cq[m]) * QS * __expf(c0), bfhi(cq[m]) * QS * __expf(c1));
                *(unsigned*)(rp + 512) = pk2(d0, d1);
                if (m & 1) { kd0[m >> 1] = pk2(h0, d0); kd1[m >> 1] = pk2(h1, d1); } else { h0 = d0; h1 = d1; } }
            o0[g] = (v4u){kd0[0], kd0[1], kd0[2], kd0[3]}; o1[g] = (v4u){kd1[0], kd1[1], kd1[2], kd1[3]};
#pragma unroll
            for (int m = 0; m < 8; ++m) { cg[m] = ng[m]; cq[m] = nq[m]; ck[m] = nk[m]; }
        }
        *(f32x2*)(DEC + (size_t)it * 512 + c) = (f32x2){__expf(c0), __expf(c1)};
    }
}

constexpr int QP = 136, MP = 72;
constexpr int L_Q = 0, L_K = L_Q + 64 * QP * 2, L_KD = L_K + 64 * QP * 2, L_VT = L_KD + 128 * MP * 2, L_A = L_VT + 32 * MP * 2, L_ST = L_A + 64 * MP * 2, L_SCAN_END = L_ST + 2 * 32 * QP * 2;
static_assert(L_SCAN_END <= XCH_OFF, "scan LDS");
__device__ __forceinline__ bf16x8 ldfrag(const LAS unsigned char* p) { return *(const LAS bf16x8*)p; }
__device__ __forceinline__ void gla_scan(LAS unsigned char* lds, const bf16* H, const bf16* KDT, const float* DEC, bf16* O, int wg, int nwg, int tid) {
    const int wave = __builtin_amdgcn_readfirstlane(tid >> 6), lane = tid & 63, l16 = lane & 15, lq = lane >> 4;
    for (int item = wg; item < 256; item += nwg) {
        const int x = item & 7, j = item >> 3, bh = x * 4 + (j >> 3), vs = j & 7, b = bh >> 2, h = bh & 3;
        __syncthreads();
        for (int i = tid; i < 2 * 32 * QP / 2; i += NTHR) ((LAS unsigned*)(lds + L_ST))[i] = 0u;
        f32x4 S[2] = {(f32x4){0.f, 0.f, 0.f, 0.f}, (f32x4){0.f, 0.f, 0.f, 0.f}};
        const int r0 = tid >> 4, c16 = tid & 15, hk0 = tid >> 3, c8k = tid & 7, mv = (tid & 255) >> 2, c8v = tid & 3;
        const bf16* pq = H + ((size_t)b * SEQ + r0) * NGLA + h * 128 + c16 * 8;
        const bf16* pkd = KDT + (((size_t)(b * 64)) * 512 + h * 128 + hk0) * 64 + c8k * 8;
        const bf16* pv = H + ((size_t)b * SEQ + mv) * NGLA + 1024 + h * 256 + vs * 32 + c8v * 8;
        const float* pdec = DEC + ((size_t)(b * 64)) * 512 + h * 128 + 16 * wave + 4 * lq;
        v4u rq0 = *(const v4u*)pq, rq1 = *(const v4u*)(pq + (size_t)32 * NGLA), rk0 = *(const v4u*)(pq + 512), rk1 = *(const v4u*)(pq + (size_t)32 * NGLA + 512);
        v4u rd0 = *(const v4u*)pkd, rd1 = *(const v4u*)(pkd + 64 * 64), rv = *(const v4u*)pv;
        f32x4 rdec = *(const f32x4*)pdec;
        for (int n = 0; n < 64; ++n) {
            const size_t row0 = (size_t)b * SEQ + n * 64;
            *(LAS v4u*)(lds + L_Q + (r0 * QP + c16 * 8) * 2) = rq0; *(LAS v4u*)(lds + L_Q + ((r0 + 32) * QP + c16 * 8) * 2) = rq1;
            *(LAS v4u*)(lds + L_K + (r0 * QP + c16 * 8) * 2) = rk0; *(LAS v4u*)(lds + L_K + ((r0 + 32) * QP + c16 * 8) * 2) = rk1;
            *(LAS v4u*)(lds + L_KD + (hk0 * MP + c8k * 8) * 2) = rd0; *(LAS v4u*)(lds + L_KD + ((hk0 + 64) * MP + c8k * 8) * 2) = rd1;
            if (tid < 256) { LAS bf16* vt = (LAS bf16*)(lds + L_VT) + (c8v * 8) * MP + mv;
                vt[0 * MP] = (bf16)(rv.x & 0xffff); vt[1 * MP] = (bf16)(rv.x >> 16); vt[2 * MP] = (bf16)(rv.y & 0xffff); vt[3 * MP] = (bf16)(rv.y >> 16);
                vt[4 * MP] = (bf16)(rv.z & 0xffff); vt[5 * MP] = (bf16)(rv.z >> 16); vt[6 * MP] = (bf16)(rv.w & 0xffff); vt[7 * MP] = (bf16)(rv.w >> 16); }
            const f32x4 dec = rdec;
            __syncthreads();
            if (n + 1 < 64) {
                pq += (size_t)64 * NGLA; pkd += 512 * 64; pv += (size_t)64 * NGLA; pdec += 512;
                rq0 = *(const v4u*)pq; rq1 = *(const v4u*)(pq + (size_t)32 * NGLA); rk0 = *(const v4u*)(pq + 512); rk1 = *(const v4u*)(pq + (size_t)32 * NGLA + 512);
                rd0 = *(const v4u*)pkd; rd1 = *(const v4u*)(pkd + 64 * 64); rv = *(const v4u*)pv; rdec = *(const f32x4*)pdec;
            }
            { const int qi = wave >> 1, jv = wave & 1; f32x4 o = (f32x4){0.f, 0.f, 0.f, 0.f};
#pragma unroll
              for (int t = 0; t < 2; ++t) if (2 * t <= qi) {
                  f32x4 a0 = (f32x4){0.f, 0.f, 0.f, 0.f}, a1 = a0;
#pragma unroll
                  for (int kk = 0; kk < 4; ++kk) a0 = __builtin_amdgcn_mfma_f32_16x16x32_bf16(ldfrag(lds + L_K + ((32 * t + l16) * QP + kk * 32 + lq * 8) * 2), ldfrag(lds + L_Q + ((16 * qi + l16) * QP + kk * 32 + lq * 8) * 2), a0, 0, 0, 0);
                  if (2 * t == qi) {
#pragma unroll
                      for (int ii = 0; ii < 4; ++ii) if (4 * lq + ii > l16) a0[ii] = 0.f; }
                  if (2 * t + 1 <= qi) {
#pragma unroll
                      for (int kk = 0; kk < 4; ++kk) a1 = __builtin_amdgcn_mfma_f32_16x16x32_bf16(ldfrag(lds + L_K + ((32 * t + 16 + l16) * QP + kk * 32 + lq * 8) * 2), ldfrag(lds + L_Q + ((16 * qi + l16) * QP + kk * 32 + lq * 8) * 2), a1, 0, 0, 0);
                      if (2 * t + 1 == qi) {
#pragma unroll
                          for (int ii = 0; ii < 4; ++ii) if (4 * lq + ii > l16) a1[ii] = 0.f; } }
                  const v4u bw = (v4u){pk2(a0[0], a0[1]), pk2(a0[2], a0[3]), pk2(a1[0], a1[1]), pk2(a1[2], a1[3])};
                  const v2u v0 = *(const LAS v2u*)(lds + L_VT + ((16 * jv + l16) * MP + 32 * t + 4 * lq) * 2), v1 = *(const LAS v2u*)(lds + L_VT + ((16 * jv + l16) * MP + 32 * t + 16 + 4 * lq) * 2);
                  const v4u aw = (v4u){v0.x, v0.y, v1.x, v1.y};
                  o = __builtin_amdgcn_mfma_f32_16x16x32_bf16(__builtin_bit_cast(bf16x8, aw), __builtin_bit_cast(bf16x8, bw), o, 0, 0, 0); }
#pragma unroll
              for (int kk = 0; kk < 4; ++kk) o = __builtin_amdgcn_mfma_f32_16x16x32_bf16(ldfrag(lds + L_ST + ((n & 1) * 32 * QP + (16 * jv + l16) * QP + kk * 32 + lq * 8) * 2), ldfrag(lds + L_Q + ((16 * qi + l16) * QP + kk * 32 + lq * 8) * 2), o, 0, 0, 0);
              *(v2u*)(O + (row0 + 16 * qi + l16) * D + h * 256 + vs * 32 + 16 * jv + 4 * lq) = (v2u){pk2(o[0], o[1]), pk2(o[2], o[3])}; }
#pragma unroll
            for (int jv = 0; jv < 2; ++jv) {
#pragma unroll
                for (int kk = 0; kk < 2; ++kk) S[jv] = __builtin_amdgcn_mfma_f32_16x16x32_bf16(ldfrag(lds + L_KD + ((16 * wave + l16) * MP + kk * 32 + lq * 8) * 2), ldfrag(lds + L_VT + ((16 * jv + l16) * MP + kk * 32 + lq * 8) * 2), S[jv], 0, 0, 0);
                S[jv] = S[jv] * dec;
                *(LAS v2u*)(lds + L_ST + (((n + 1) & 1) * 32 * QP + (16 * jv + l16) * QP + 16 * wave + 4 * lq) * 2) = (v2u){pk2(S[jv][0], S[jv][1]), pk2(S[jv][2], S[jv][3])}; }
            __syncthreads();
        }
    }
}
__device__ __forceinline__ void gla_post(const bf16* O, const bf16* H, bf16* CAT, const float* gnorm, int gw, int ngw, int lane) {
    const int hs = lane >> 5, cl = (lane & 31) * 8;
    float gn[8];
#pragma unroll
    for (int e = 0; e < 8; ++e) gn[e] = gnorm[cl + e];
#pragma unroll 2
    for (int m = gw; m < M; m += ngw) {
        v4u ow[2], rw[2];
#pragma unroll
        for (int p = 0; p < 2; ++p) { ow[p] = *(const v4u*)(O + (size_t)m * D + (hs + 2 * p) * 256 + cl); rw[p] = *(const v4u*)(H + (size_t)m * NGLA + 2048 + (hs + 2 * p) * 256 + cl); }
#pragma unroll
        for (int p = 0; p < 2; ++p) { float o[8], r[8], y[8]; unpack8(ow[p], o); unpack8(rw[p], r);
            float ss = 0.f;
#pragma unroll
            for (int e = 0; e < 8; ++e) ss += o[e] * o[e];
#pragma unroll
            for (int sh = 1; sh < 32; sh <<= 1) ss += __shfl_xor(ss, sh);
            const float rs = rsqrtf(ss * (1.f / 256.f) + EPS);
#pragma unroll
            for (int e = 0; e < 8; ++e) y[e] = o[e] * rs * gn[e] * (r[e] / (1.f + __expf(-r[e])));
            *(v4u*)(CAT + (size_t)m * D + (hs + 2 * p) * 256 + cl) = (v4u){pk2(y[0], y[1]), pk2(y[2], y[3]), pk2(y[4], y[5]), pk2(y[6], y[7])}; }
    }
}

#define XB_TMO      128
#define XB_XCNT(j)  (256  + 64 * (j))
#define XB_XSUB(j)  (1280 + 64 * (j))
#define XB_XGEN(j)  (2304 + 64 * (j))
#define XB_TOP      3328
#define XB_TOPGEN   3392
#define XCD_BAR_WORDS 3456
#define XB_SPIN_CAP (1u << 18)

__device__ __forceinline__ unsigned xb_ld(unsigned* p)              { return __hip_atomic_load(p, __ATOMIC_RELAXED, __HIP_MEMORY_SCOPE_AGENT); }
__device__ __forceinline__ unsigned xb_add(unsigned* p, unsigned v) { return __hip_atomic_fetch_add(p, v, __ATOMIC_RELAXED, __HIP_MEMORY_SCOPE_AGENT); }
__device__ __forceinline__ unsigned xb_xcc_id() { return (unsigned)__builtin_amdgcn_s_getreg((3 << 11) | 20) & 0xFu; }
#define XB_SPIN(cond, bar) do { unsigned _sp = 0; while (cond) { __builtin_amdgcn_s_sleep(1); \
    if ((++_sp & 255u) == 0u) { if (xb_ld(&(bar)[XB_TMO])) break; if (_sp > XB_SPIN_CAP) { atomicAdd(&(bar)[XB_TMO], 1u); break; } } } } while (0)

struct XcdBarrier {
    unsigned* bar; unsigned x;
    volatile LAS unsigned* st;
};

__device__ __forceinline__ XcdBarrier xcd_barrier_post(unsigned* bar, volatile LAS unsigned* st) {
    XcdBarrier b; b.bar = bar; b.x = xb_xcc_id(); b.st = st;
    if (threadIdx.x == 0) (void)xb_add(&bar[XB_XCNT(b.x)], 1u);
    return b;
}
__device__ __forceinline__ void xcd_barrier_complete(unsigned* bar, unsigned x, unsigned& nloc, unsigned& nx) {
    const unsigned G = gridDim.x * gridDim.y * gridDim.z;
    unsigned sum, cnt, mine, sp = 0u;
    for (;;) {
        sum = 0u; cnt = 0u; mine = 0u;
#pragma unroll
        for (unsigned j = 0; j < 16; ++j) { const unsigned c = xb_ld(&bar[XB_XCNT(j)]); sum += c; cnt += (c > 0u) ? 1u : 0u; mine = (j == x) ? c : mine; }
        if (sum == G) break;
        __builtin_amdgcn_s_sleep(1);
        if ((++sp & 255u) == 0u) { if (xb_ld(&bar[XB_TMO])) break; if (sp > XB_SPIN_CAP) { atomicAdd(&bar[XB_TMO], 1u); break; } }
    }
    nloc = mine > 0u ? mine : 1u; nx = cnt > 0u ? cnt : 1u;
}

__device__ __forceinline__ void xcd_barrier(const XcdBarrier& b) {
    asm volatile("s_waitcnt vmcnt(0)" ::: "memory");
    __syncthreads();
    if (threadIdx.x == 0) {
        unsigned* bar = b.bar;
        __builtin_amdgcn_s_waitcnt(0);
        unsigned nloc = b.st[0], nx = b.st[1];
        if (nloc == 0u) { xcd_barrier_complete(bar, b.x, nloc, nx); b.st[0] = nloc; b.st[1] = nx; }
        const unsigned old = xb_add(&bar[XB_XSUB(b.x)], 1u);
        const unsigned gen = old / nloc;
        if (old + 1u == (gen + 1u) * nloc) {
            __builtin_amdgcn_fence(__ATOMIC_RELEASE, "agent");
            asm volatile("s_waitcnt vmcnt(0)" ::: "memory");
            const unsigned og = xb_add(&bar[XB_TOP], 1u);
            const unsigned tg = og / nx;
            if (og + 1u == (tg + 1u) * nx) xb_add(&bar[XB_TOPGEN], 1u);
            else XB_SPIN(xb_ld(&bar[XB_TOPGEN]) == tg, bar);
            __builtin_amdgcn_fence(__ATOMIC_ACQUIRE, "agent");
            xb_add(&bar[XB_XGEN(b.x)], 1u);
            asm volatile("s_waitcnt vmcnt(0)" ::: "memory");
        } else {
            XB_SPIN(xb_ld(&bar[XB_XGEN(b.x)]) == gen, bar);
            __builtin_amdgcn_fence(__ATOMIC_ACQUIRE, "agent");
            asm volatile("s_waitcnt vmcnt(0)" ::: "memory");
        }
    }
    __syncthreads();
}

#define GRID_SYNC() do { XcdBarrier b_; b_.bar = (unsigned*)(GAS unsigned*)karg(21); b_.x = xb_xcc_id(); b_.st = (volatile LAS unsigned*)(lds + MISC_OFF); xcd_barrier(b_); } while (0)
constexpr int MISC_OFF = XCH_OFF + 8192;
#define GAS __attribute__((address_space(1)))
typedef const __attribute__((address_space(4))) unsigned long long* kaptr_t;
__device__ __forceinline__ unsigned long long karg(int k) { kaptr_t p = (kaptr_t)__builtin_amdgcn_kernarg_segment_ptr(); asm volatile("" : "+s"(p)); return p[k]; }
#define INF(k) ((const float*)(const GAS float*)karg(k))
#define XOUT() ((float*)(GAS float*)karg(20))
#define WSB(off) ((bf16*)(GAS bf16*)(karg(21) + (off)))
#define WSF(off) ((float*)(GAS float*)(karg(21) + (off)))
#define RSSP(i) WSF(60 * MiB + (size_t)(i) * 524288)
__global__ void __launch_bounds__(NTHR, 2) fwd_megakernel(Args args) {
    extern __shared__ __attribute__((aligned(16))) unsigned char lds_raw[];
    cg::grid_group grid = cg::this_grid();
    LAS unsigned char* lds = (LAS unsigned char*)lds_raw;
    { const int tid = threadIdx.x; if (tid < 2) ((LAS unsigned*)(lds + MISC_OFF))[tid] = 0u; }
    __syncthreads();
    grid.sync();
    (void)xcd_barrier_post((unsigned*)(GAS unsigned*)karg(21), (volatile LAS unsigned*)(lds + MISC_OFF));
    (void)args;
#define WAVE_IDS() const int tid_ = fresh_tid(), lane = tid_ & 63, wave = __builtin_amdgcn_readfirstlane(tid_ >> 6), G = gridDim.x, wg = blockIdx.x, gw = wg * NWAVES + wave, ngw = G * NWAVES

    {
        WAVE_IDS();
        LAS float* scr = (LAS float*)(lds + wave * 16384);
        constexpr int I_ABIN = 16 * 48, I_ABOUT = 16 * 32, I_GLAIN = 16 * 96, I_GLAOUT = 16 * 32, I_UP = 16 * 176, I_DN = 44 * 32;
        constexpr int NITEMS = I_ABIN + I_ABOUT + I_GLAIN + I_GLAOUT + 2 * I_UP + 2 * I_DN;
        for (int it = gw; it < NITEMS; it += ngw) {
            int r = it;
            if (r < I_ABIN) { const int kb = r / 48, nb = r % 48; transpose_item(INF(3), NAB, D, WSB(WS_WABIN), kb * 64, 512 + nb * 32, 512 + nb * 32, scr, lane, INF(1)); continue; } r -= I_ABIN;
            if (r < I_ABOUT) { const int kb = r / 32, nb = r % 32; transpose_item(INF(9), D, D, WSB(WS_WABOUT), kb * 64, nb * 32, nb * 32, scr, lane); continue; } r -= I_ABOUT;
            if (r < I_GLAIN) { const int kb = r / 96, nb = r % 96; transpose_item(INF(10), GLA_SRC_N, D, WSB(WS_WGLAIN), kb * 64, nb * 32, nb * 32, scr, lane, INF(1) + D); continue; } r -= I_GLAIN;
            if (r < I_GLAOUT) { const int kb = r / 32, nb = r % 32; transpose_item(INF(14), D, D, WSB(WS_WGLAOUT), kb * 64, nb * 32, nb * 32, scr, lane); continue; } r -= I_GLAOUT;
            if (r < 2 * I_UP) { const int l = r / I_UP, q = r % I_UP, kb = q / 176, nb = q % 176, n0 = nb * 32, isv = n0 >= FFD, ch = isv ? n0 - FFD : n0;
                transpose_item(INF(15) + (size_t)l * D * NUP, NUP, D, WSB(WS_WUP) + (size_t)l * NUP * D, kb * 64, n0, (ch >> 7) * 256 + isv * 128 + (ch & 127), scr, lane, INF(2) + (size_t)l * D); continue; } r -= 2 * I_UP;
            { const int l = r / I_DN, q = r % I_DN, kb = q / 32, nb = q % 32;
                transpose_item(INF(18) + (size_t)l * FFD * D, D, FFD, WSB(WS_WDN) + (size_t)l * D * FFD, kb * 64, nb * 32, nb * 32, scr, lane); }
        }
        { const float* abin = INF(3); const float* poolw = INF(4); const float* glain = INF(10); const float* wg2 = INF(11); const float* mn1 = INF(1) + D; const float* mn0 = INF(1); bf16* W_ABIN = WSB(WS_WABIN); bf16* W_GLAIN = WSB(WS_WGLAIN);
        for (int idx = wg * NTHR + tid_; idx < 256 * 512; idx += G * NTHR) {
            const int k4 = idx >> 9, n = idx & 511, g = n >> 7, nn = n & 127;
            const float* wi = abin + (size_t)(4 * k4) * NAB + g * 128; const float* pw = poolw + (size_t)g * 128 * 128 + nn;
            float s0 = 0.f, s1 = 0.f, s2 = 0.f, s3 = 0.f;
#pragma unroll 8
            for (int c = 0; c < 128; ++c) { const float w = pw[c * 128]; s0 += wi[c] * w; s1 += wi[NAB + c] * w; s2 += wi[2 * NAB + c] * w; s3 += wi[3 * NAB + c] * w; }
            { const f32x4 m0 = *(const f32x4*)(mn0 + 4 * k4); *(v2u*)(W_ABIN + (size_t)n * D + 4 * k4) = (v2u){pk2(s0 * m0[0], s1 * m0[1]), pk2(s2 * m0[2], s3 * m0[3])}; }
            const float* gi = glain + (size_t)(4 * k4) * GLA_SRC_N + 3072; const float* g2 = wg2 + n;
            float t0 = 0.f, t1 = 0.f, t2 = 0.f, t3 = 0.f;
#pragma unroll
            for (int r = 0; r < 16; ++r) { const float w = g2[r * 512]; t0 += gi[r] * w; t1 += gi[GLA_SRC_N + r] * w; t2 += gi[2 * GLA_SRC_N + r] * w; t3 += gi[3 * GLA_SRC_N + r] * w; }
            const f32x4 mg = *(const f32x4*)(mn1 + 4 * k4);
            *(v2u*)(W_GLAIN + (size_t)(3072 + n) * D + 4 * k4) = (v2u){pk2(t0 * mg[0], t1 * mg[1]), pk2(t2 * mg[2], t3 * mg[3])};
        } }
        convert_rows(INF(0), WSB(WS_XS), RSSP(4), gw, ngw, lane);
    }
    GRID_SYNC();

    for (int l = 0; l < 2; ++l) {
        { const int N = (l == 0) ? NAB : NGLA;
          pg8::Gemm g{WSB(WS_XS), (l == 0) ? WSB(WS_WABIN) : WSB(WS_WGLAIN), M, N, D}; pg8::StaticOrder S; S.init(M, N, gridDim.x, blockIdx.x);
          pg8::EpiBf16P E{WSB(WS_H), N, (l == 0) ? (const float*)RSSP(4) : (const float*)RSSP(1)};
          if (PHM & 1) pg8::gemm_phase<pg8::EpiBf16P, pg8::StaticOrder, true, true>(lds, g, S, E); }
        GRID_SYNC();
        if (l == 0) {
            if (PHM & 2) ab_mixer(WSB(WS_H), WSB(WS_CAT), INF(5), INF(6), INF(7), INF(8), blockIdx.x, gridDim.x, fresh_tid());
        } else {
            if (PHM & 4) gla_prep(WSB(WS_H), WSB(WS_CAT), WSF(WS_DEC), INF(12), blockIdx.x, gridDim.x, fresh_tid());
            GRID_SYNC();
            if (PHM & 8) gla_scan(lds, WSB(WS_H), WSB(WS_CAT), WSF(WS_DEC), WSB(WS_XN), blockIdx.x, gridDim.x, fresh_tid());
            GRID_SYNC();
            { WAVE_IDS(); if (PHM & 16) gla_post(WSB(WS_XN), WSB(WS_H), WSB(WS_CAT), INF(13), gw, ngw, lane); }
        }
        GRID_SYNC();
        { pg8::Gemm g{WSB(WS_CAT), (l == 0) ? WSB(WS_WABOUT) : WSB(WS_WGLAOUT), M, D, D}; pg8::StaticOrder S; S.init(M, D, gridDim.x, blockIdx.x);
          pg8::EpiRes E{(const float*)nullptr, WSB(WS_XS), D, RSSP(2 * l), (LAS float*)(lds + XCH_OFF)};
          if (PHM & 32) pg8::gemm_phase<pg8::EpiRes, pg8::StaticOrder, true, true>(lds, g, S, E); }
        GRID_SYNC();
        { pg8::Gemm g{WSB(WS_XS), WSB(WS_WUP) + (size_t)l * NUP * D, M, NUP, D}; pg8::StaticOrder S; S.init(M, NUP, gridDim.x, blockIdx.x);
          pg8::EpiFfnUp E{WSB(WS_H), INF(16) + (size_t)l * 3 * FFD, INF(17) + (size_t)l * FFD, WSF(WS_ULAST), WSF(WS_UFIRST), WSF(WS_VFIRST), (LAS f32x4*)(lds + XCH_OFF), RSSP(2 * l)};
          if (PHM & 64) pg8::gemm_phase<pg8::EpiFfnUp, pg8::StaticOrder, true, true, true>(lds, g, S, E); }
        GRID_SYNC();
        { pg8::Gemm g{WSB(WS_H), WSB(WS_WDN) + (size_t)l * D * FFD, M, D, FFD}; pg8::StaticOrder S; S.init(M, D, gridDim.x, blockIdx.x);
          if (PHM & 256) {
          const float* cw = INF(16) + (size_t)l * 3 * FFD; const float* cb = INF(17) + (size_t)l * FFD;
          const float* ULAST = WSF(WS_ULAST); const float* UFIRST = WSF(WS_UFIRST); const float* VFIRST = WSF(WS_VFIRST); bf16* ACT = WSB(WS_H);
          pg8::Unit u;
          for (int i = 0; S.next(i, u); ++i) {
              if ((u.pm & 15) == 0) continue;
              for (int c4 = fresh_tid(); c4 < FFD / 4; c4 += NTHR) {
                  const int ch = 4 * c4;
                  const f32x4 uf0 = *(const f32x4*)(UFIRST + (size_t)(u.pm * 2) * FFD + ch), uf1 = *(const f32x4*)(UFIRST + (size_t)(u.pm * 2 + 1) * FFD + ch);
                  const f32x4 ul0 = *(const f32x4*)(ULAST + (size_t)((u.pm - 1) * 2) * FFD + ch), ul1 = *(const f32x4*)(ULAST + (size_t)((u.pm - 1) * 2 + 1) * FFD + ch);
                  const f32x4 vf0 = *(const f32x4*)(VFIRST + (size_t)(u.pm * 2) * FFD + ch), vf1 = *(const f32x4*)(VFIRST + (size_t)(u.pm * 2 + 1) * FFD + ch);
                  const f32x4 a0 = *(const f32x4*)(cw + ch), a1 = *(const f32x4*)(cw + FFD + ch), a2 = *(const f32x4*)(cw + 2 * FFD + ch), bb = *(const f32x4*)(cb + ch);
                  const f32x4 u0 = bb + a0 * ul0 + a1 * ul1 + a2 * uf0, u1 = bb + a0 * ul1 + a1 * uf0 + a2 * uf1;
                  const f32x2 g00 = pg8::gelu_pk((f32x2){u0[0], u0[1]}), g01 = pg8::gelu_pk((f32x2){u0[2], u0[3]}), g10 = pg8::gelu_pk((f32x2){u1[0], u1[1]}), g11 = pg8::gelu_pk((f32x2){u1[2], u1[3]});
                  *(v2u*)(ACT + (size_t)(u.pm * 256) * FFD + ch) = (v2u){pk2(g00.x * vf0[0], g00.y * vf0[1]), pk2(g01.x * vf0[2], g01.y * vf0[3])};
                  *(v2u*)(ACT + (size_t)(u.pm * 256 + 1) * FFD + ch) = (v2u){pk2(g10.x * vf1[0], g10.y * vf1[1]), pk2(g11.x * vf1[2], g11.y * vf1[3])};
              }
          }
          asm volatile("s_waitcnt vmcnt(0)" ::: "memory"); __syncthreads();
          }
          if (l == 0 || gridDim.x != 256) { pg8::EpiRes E{(const float*)nullptr, WSB(WS_XS), D, RSSP(2 * l + 1), (LAS float*)(lds + XCH_OFF)};
              pg8::gemm_phase<pg8::EpiRes, pg8::StaticOrder, true, true>(lds, g, S, E); }
          else { pg8::EpiResFinal E{WSB(WS_XS), XOUT(), D, RSSP(3), INF(19), (unsigned*)(GAS unsigned*)(karg(21) + 16384), (LAS float*)(lds + XCH_OFF)};
              pg8::gemm_phase<pg8::EpiResFinal, pg8::StaticOrder, true, true>(lds, g, S, E); } }
        if (l == 0) GRID_SYNC();
    }
    if (gridDim.x != 256) { GRID_SYNC(); WAVE_IDS(); final_norm_rows(WSB(WS_XS), XOUT(), INF(19), RSSP(3), gw, ngw, lane); }
}

extern "C" void kernel_launch(void* const* d_in, const int* in_sizes, int n_in, void* d_out, int out_size, void* d_ws, size_t ws_size, hipStream_t stream) {
    static int grid_blocks = 0;
    if (grid_blocks == 0) {
        if (n_in != 20 || out_size != M * D || ws_size < WS_END) { fprintf(stderr, "kernel_launch: unexpected shapes (n_in %d out %d ws %zu)\n", n_in, out_size, ws_size); grid_blocks = -1; return; }
        int dev = 0, cus = 0, per_cu = 0;
        hipGetDevice(&dev); hipDeviceGetAttribute(&cus, hipDeviceAttributeMultiprocessorCount, dev);
        if (hipFuncSetAttribute((const void*)fwd_megakernel, hipFuncAttributeMaxDynamicSharedMemorySize, LDS_BYTES) != hipSuccess) fprintf(stderr, "kernel_launch: hipFuncSetAttribute failed\n");
        if (hipOccupancyMaxActiveBlocksPerMultiprocessor(&per_cu, (const void*)fwd_megakernel, NTHR, LDS_BYTES) != hipSuccess || per_cu < 1) { fprintf(stderr, "kernel_launch: occupancy query says %d\n", per_cu); per_cu = 1; }
        (void)hipGetLastError();
        grid_blocks = cus * per_cu;
    }
    if (grid_blocks < 0) return;
    if (hipMemsetAsync(d_ws, 0, 65536, stream) != hipSuccess) { fprintf(stderr, "kernel_launch: memset failed\n"); return; }
    Args a{};
    for (int i = 0; i < 20; ++i) a.in[i] = (const float*)d_in[i];
    a.out = (float*)d_out; a.ws = (unsigned char*)d_ws;
    void* kargs[] = {&a};
    hipError_t e = hipLaunchCooperativeKernel((const void*)fwd_megakernel, dim3(grid_blocks), dim3(NTHR), kargs, LDS_BYTES, stream);
    if (e != hipSuccess) fprintf(stderr, "cooperative launch failed: %s (grid %d)\n", hipGetErrorString(e), grid_blocks);
}
```

```cpp
#include <hip/hip_runtime.h>
#include <hip/hip_cooperative_groups.h>
#include <cstdio>
#include <cstdint>
namespace cg = cooperative_groups;
__device__ __forceinline__ int fresh_tid() { int t = threadIdx.x; asm volatile("" : "+v"(t)); return t; }
namespace pg8 {
#define PG8_LAS __attribute__((address_space(3)))
typedef unsigned short bf16_t;
typedef short bf16x8 __attribute__((ext_vector_type(8)));
typedef float f32x4 __attribute__((ext_vector_type(4)));
typedef unsigned u32x4 __attribute__((ext_vector_type(4)));
constexpr int BM = 256, BK = 64, HALF = 128, HTB = HALF * BK * 2  , STAGE_BYTES = 8 * HTB, NXCD = 8, WGM = 8;

__host__ __device__ __forceinline__ int lds_byte(int r, int c) { const int st = (r >> 4) * 2 + (c >> 5), rr = r & 15, cc = c & 31, ob = rr * 64 + cc * 2; return st * 1024 + (ob ^ (((ob >> 9) & 1) << 5)); }
__host__ __device__ __forceinline__ void stage_rc(int b, int& R, int& C) { const int st = b / 1024, sb = b % 1024, swz = sb ^ (((sb >> 9) & 1) << 5); R = (st >> 1) * 16 + swz / 64; C = (st & 1) * 32 + (swz % 64) / 2; }
__host__ __device__ __forceinline__ int perm32(int rho) { const int n = rho >> 4, i = rho & 15; return 8 * (i >> 2) + 4 * n + (i & 3); }

struct Unit { int pm, pn; };
struct Gemm { const bf16_t* A; const bf16_t* Bt; int M, N, K; };

struct StaticOrder {
    int nM, nN, nwg, G, c;
    __host__ __device__ void init(int M, int N, int G_, int c_) { nM = M / BM; nN = N / BM; nwg = nM * nN; G = G_; c = c_; }
    __host__ __device__ bool next(int i, Unit& u) const {
        const long L = (long)i * G + c; if (L >= nwg) return false;
        int wgid = (int)L; { const int q = nwg / NXCD, r = nwg % NXCD, xcd = wgid % NXCD, off = wgid / NXCD; wgid = (xcd < r ? xcd * (q + 1) : r * (q + 1) + (xcd - r) * q) + off; }
        const int nig = WGM * nN, gid = wgid / nig, fm = gid * WGM, gsz = (nM - fm) < WGM ? (nM - fm) : WGM;
        u.pm = fm + ((wgid % nig) % gsz); u.pn = (wgid % nig) / gsz; return true;
    }
    __device__ __forceinline__ void a_ready(const Unit&) const {}
    __device__ __forceinline__ void done(const Unit&) const {}
};

typedef float f32x2c_t __attribute__((ext_vector_type(2))); typedef __bf16 bf16x2c_t __attribute__((ext_vector_type(2)));
__device__ __forceinline__ unsigned cvt_pk_bf16(float lo, float hi) { const f32x2c_t v = {lo, hi}; const bf16x2c_t b = __builtin_convertvector(v, bf16x2c_t); return __builtin_bit_cast(unsigned, b); }
typedef float f32x2 __attribute__((ext_vector_type(2)));
__device__ __forceinline__ f32x2 gelu_pk(f32x2 v) {
    const f32x2 av = __builtin_elementwise_abs(v), d = av * 0.2316418882f + 1.0f;
    f32x2 t; t.x = __builtin_amdgcn_rcpf(d.x); t.y = __builtin_amdgcn_rcpf(d.y);
    f32x2 q = t * 0.5307027145f + (-0.7265760135f); q = q * t + 0.7107068705f; q = q * t + (-0.142248368f); q = q * t + 0.127414796f; q = q * t;
    const f32x2 s = (v * v) * (-0.72134752044f);
    f32x2 e; e.x = __builtin_amdgcn_exp2f(s.x); e.y = __builtin_amdgcn_exp2f(s.y);
    const f32x2 m = av * (q * e);
    return __builtin_elementwise_max(v, (f32x2){0.f, 0.f}) - m;
}
}
namespace pg8 {
template <class Epi, class Sched, bool ALIGN_EPI = false, bool SP2 = false, bool APERM = false  >
__device__ __forceinline__ void gemm_phase(PG8_LAS unsigned char* lds, const Gemm g, const Sched& S, const Epi& E) {
    const int tid = fresh_tid(), wid = __builtin_amdgcn_readfirstlane(tid >> 6), lane = tid & 63, wr = wid >> 2, wc = wid & 3, fr = lane & 15, fq = lane >> 4;
    const int K = g.K, nt = K / BK;
    unsigned voffA[2], voffB[2];
#pragma unroll
    for (int i = 0; i < 2; ++i) { int R, C; stage_rc(tid * 16 + i * 8192, R, C); const int Rb = Epi::PERM ? ((R & ~31) + perm32(R & 31)) : R;
        const int Ra = APERM ? ((R & ~63) + 4 * (R & 15) + ((R >> 4) & 3)) : R;
        voffA[i] = (unsigned)(Ra * K + C) * 2u; voffB[i] = (unsigned)(Rb * K + C) * 2u; }
    const size_t kstep = (size_t)(BK * 2);
    const size_t hstep = (size_t)HALF * K * 2;
    const size_t tstep = 2 * hstep;
    const unsigned ldsw = (unsigned)wid * 1024u;
    const int aoff = lds_byte(wr * 64 + fr, fq * 8), boff = lds_byte(wc * 32 + fr, fq * 8);
#define PG8_SA(b, h) (((b) * 2 + (h)) * HTB)
#define PG8_SB(b, h) ((4 + (b) * 2 + (h)) * HTB)
#define PG8_STAGE(bufoff, gbase, voff) do { _Pragma("unroll") for (int _i = 0; _i < 2; ++_i) \
        __builtin_amdgcn_global_load_lds((const unsigned*)((const char*)(gbase) + (voff)[_i]), (PG8_LAS unsigned*)(lds + (bufoff) + ldsw + _i * 8192), 16, 0, 0); } while (0)
#define PG8_LDA(dst, b, h) do { _Pragma("unroll") for (int m = 0; m < 4; ++m) _Pragma("unroll") for (int k = 0; k < 2; ++k) dst[m][k] = *(const PG8_LAS bf16x8*)(lds + PG8_SA(b, h) + aoff + m * 2048 + k * 1024); } while (0)
#define PG8_LDB(dst, b, h) do { _Pragma("unroll") for (int n = 0; n < 2; ++n) _Pragma("unroll") for (int k = 0; k < 2; ++k) dst[n][k] = *(const PG8_LAS bf16x8*)(lds + PG8_SB(b, h) + boff + n * 2048 + k * 1024); } while (0)
#define PG8_MMA(ai, bj, At, Bt) do { __builtin_amdgcn_s_setprio(1); _Pragma("unroll") for (int m = 0; m < 4; ++m) _Pragma("unroll") for (int n = 0; n < 2; ++n) _Pragma("unroll") for (int k = 0; k < 2; ++k) \
        acc[ai][bj][m][n] = __builtin_amdgcn_mfma_f32_16x16x32_bf16(Bt[n][k], At[m][k], acc[ai][bj][m][n], 0, 0, 0); __builtin_amdgcn_s_setprio(0); } while (0)
#define PG8_WAIT_V(n) asm volatile("s_waitcnt vmcnt(" #n ")" ::: "memory")
#define PG8_WAIT_L(n) asm volatile("s_waitcnt lgkmcnt(" #n ")" ::: "memory")
#define PG8_BAR __builtin_amdgcn_s_barrier()
#define PG8_SCHED __builtin_amdgcn_sched_barrier(0)
    Unit cur, nxt; int ui = 0;
    if (!S.next(0, cur)) return;
    f32x4 acc[2][2][4][2];
#pragma unroll
    for (int a = 0; a < 2; ++a)
#pragma unroll
        for (int b = 0; b < 2; ++b)
#pragma unroll
            for (int m = 0; m < 4; ++m)
#pragma unroll
                for (int n = 0; n < 2; ++n) acc[a][b][m][n] = (f32x4){0.f, 0.f, 0.f, 0.f};
    bf16x8 At[4][2], B0[2][2], B1[2][2];
    const char* cA = (const char*)g.A + (size_t)cur.pm * tstep; const char* cB = (const char*)g.Bt + (size_t)cur.pn * tstep;
    S.a_ready(cur);
    if constexpr (SP2) {
        PG8_STAGE(PG8_SB(0, 0), cB, voffB); PG8_STAGE(PG8_SB(0, 1), cB + hstep, voffB); PG8_STAGE(PG8_SA(0, 0), cA, voffA); PG8_STAGE(PG8_SA(0, 1), cA + hstep, voffA);
        if (wr == 1) PG8_BAR;
        PG8_WAIT_V(2); PG8_BAR;
        PG8_STAGE(PG8_SB(1, 0), cB + kstep, voffB); PG8_STAGE(PG8_SA(1, 0), cA + kstep, voffA); PG8_STAGE(PG8_SB(1, 1), cB + hstep + kstep, voffB);
        PG8_WAIT_V(6); PG8_BAR;
    } else {
        PG8_STAGE(PG8_SB(0, 0), cB, voffB); PG8_STAGE(PG8_SA(0, 0), cA, voffA); PG8_STAGE(PG8_SB(0, 1), cB + hstep, voffB); PG8_STAGE(PG8_SA(0, 1), cA + hstep, voffA);
        if (wr == 1) PG8_BAR;
        PG8_WAIT_V(4); PG8_BAR;
        PG8_STAGE(PG8_SB(1, 0), cB + kstep, voffB); PG8_STAGE(PG8_SA(1, 0), cA + kstep, voffA); PG8_STAGE(PG8_SB(1, 1), cB + hstep + kstep, voffB);
        PG8_WAIT_V(6); PG8_BAR;
    }
    for (;;) {
        const bool has_next = S.next(ui + 1, nxt);
        const char* nA = has_next ? (const char*)g.A + (size_t)nxt.pm * tstep : cA; const char* nB = has_next ? (const char*)g.Bt + (size_t)nxt.pn * tstep : cB;
        for (int t = 0; t < nt; t += 2) {
            const bool last = (t == nt - 2);
            const char* a1 = cA + (size_t)(t + 1) * kstep;
            const char* a2 = last ? nA : cA + (size_t)(t + 2) * kstep; const char* b2 = last ? nB : cB + (size_t)(t + 2) * kstep;
            const char* a3 = a2 + kstep; const char* b3 = b2 + kstep;
            if (last && has_next) S.a_ready(nxt);
            if constexpr (SP2) {
            PG8_LDB(B0, 0, 0); PG8_LDB(B1, 0, 1); PG8_SCHED; PG8_LDA(At, 0, 0); PG8_STAGE(PG8_SA(1, 1), a1 + hstep, voffA);
            PG8_WAIT_V(8); PG8_WAIT_L(0); PG8_BAR; PG8_MMA(0, 0, At, B0); PG8_MMA(0, 1, At, B1); PG8_BAR; PG8_SCHED;
            PG8_LDA(At, 0, 1); PG8_STAGE(PG8_SB(0, 0), b2, voffB); PG8_STAGE(PG8_SB(0, 1), b2 + hstep, voffB); PG8_STAGE(PG8_SA(0, 0), a2, voffA);
            PG8_WAIT_V(8); PG8_WAIT_L(0); PG8_BAR; PG8_MMA(1, 0, At, B0); PG8_MMA(1, 1, At, B1); PG8_BAR; PG8_SCHED;
            PG8_LDB(B0, 1, 0); PG8_LDB(B1, 1, 1); PG8_SCHED; PG8_LDA(At, 1, 0); PG8_STAGE(PG8_SA(0, 1), a2 + hstep, voffA);
            PG8_WAIT_V(8); PG8_WAIT_L(0); PG8_BAR; PG8_MMA(0, 0, At, B0); PG8_MMA(0, 1, At, B1); PG8_BAR; PG8_SCHED;
            PG8_LDA(At, 1, 1); PG8_STAGE(PG8_SB(1, 0), b3, voffB); PG8_STAGE(PG8_SB(1, 1), b3 + hstep, voffB); PG8_STAGE(PG8_SA(1, 0), a3, voffA);
            PG8_WAIT_V(8); PG8_WAIT_L(0); PG8_BAR; PG8_MMA(1, 0, At, B0); PG8_MMA(1, 1, At, B1); PG8_BAR; PG8_SCHED;
            } else {
            PG8_LDB(B0, 0, 0); PG8_SCHED; PG8_LDA(At, 0, 0); PG8_STAGE(PG8_SA(1, 1), a1 + hstep, voffA);
            PG8_WAIT_L(8); PG8_BAR; PG8_WAIT_L(0); PG8_MMA(0, 0, At, B0); PG8_BAR; PG8_SCHED;
            PG8_LDB(B1, 0, 1); PG8_STAGE(PG8_SB(0, 0), b2, voffB);
            PG8_BAR; PG8_WAIT_L(0); PG8_MMA(0, 1, At, B1); PG8_BAR;
            PG8_LDA(At, 0, 1); PG8_STAGE(PG8_SA(0, 0), a2, voffA);
            PG8_BAR; PG8_WAIT_L(0); PG8_MMA(1, 0, At, B0); PG8_BAR; PG8_SCHED;
            PG8_STAGE(PG8_SB(0, 1), b2 + hstep, voffB);
            PG8_WAIT_V(6); PG8_BAR; PG8_MMA(1, 1, At, B1); PG8_BAR;
            PG8_LDB(B0, 1, 0); PG8_SCHED; PG8_LDA(At, 1, 0); PG8_STAGE(PG8_SA(0, 1), a2 + hstep, voffA);
            PG8_WAIT_L(8); PG8_BAR; PG8_WAIT_L(0); PG8_MMA(0, 0, At, B0); PG8_BAR; PG8_SCHED;
            PG8_LDB(B1, 1, 1); PG8_STAGE(PG8_SB(1, 0), b3, voffB);
            PG8_BAR; PG8_WAIT_L(0); PG8_MMA(0, 1, At, B1); PG8_BAR;
            PG8_LDA(At, 1, 1); PG8_STAGE(PG8_SA(1, 0), a3, voffA);
            PG8_BAR; PG8_WAIT_L(0); PG8_MMA(1, 0, At, B0); PG8_BAR; PG8_SCHED;
            PG8_STAGE(PG8_SB(1, 1), b3 + hstep, voffB);
            PG8_WAIT_V(6); PG8_BAR; PG8_MMA(1, 1, At, B1); PG8_BAR;
            }
        }
        if constexpr (ALIGN_EPI) { if (wr == 0) PG8_BAR; }
        if constexpr (!Epi::AFTER_DRAIN) { E(acc, cur, wr, wc, fr, fq); S.done(cur); }
        if (!has_next) break;
#pragma unroll
        for (int a = 0; a < 2; ++a)
#pragma unroll
            for (int b = 0; b < 2; ++b)
#pragma unroll
                for (int m = 0; m < 4; ++m)
#pragma unroll
                    for (int n = 0; n < 2; ++n) acc[a][b][m][n] = (f32x4){0.f, 0.f, 0.f, 0.f};
        cur = nxt; cA = nA; cB = nB; ++ui;
        if constexpr (ALIGN_EPI) { if (wr == 1) PG8_BAR; }
    }
    PG8_WAIT_V(0);
    if constexpr (!ALIGN_EPI) { if (wr == 0) PG8_BAR; }
    PG8_BAR;
    if constexpr (Epi::AFTER_DRAIN) { E.fused(acc, cur, wr, wc, fr, fq, lds, wid, lane); S.done(cur); }
#undef PG8_SA
#undef PG8_SB
#undef PG8_STAGE
#undef PG8_LDA
#undef PG8_LDB
#undef PG8_MMA
#undef PG8_WAIT_V
#undef PG8_WAIT_L
#undef PG8_BAR
#undef PG8_SCHED
}
}
namespace pg8 {
template <int CTRL> __device__ __forceinline__ float dppf(float v) { return __builtin_bit_cast(float, __builtin_amdgcn_update_dpp(0, __builtin_bit_cast(int, v), CTRL, 0xf, 0xf, false)); }

template <int CTRL> __device__ __forceinline__ float dppo(float old, float v) { return __builtin_bit_cast(float, __builtin_amdgcn_update_dpp(__builtin_bit_cast(int, old), __builtin_bit_cast(int, v), CTRL, 0xf, 0xf, false)); }
struct EpiBf16P {
    static constexpr bool PERM = true, AFTER_DRAIN = false;
    bf16_t* O; int ldc; const float* rss; PG8_LAS float* tab;
    __device__ __forceinline__ void operator()(const f32x4 (&acc)[2][2][4][2], const Unit& u, int wr, int wc, int fr, int fq) const {
        const int row0 = u.pm * BM + wr * 64 + fr, col0 = u.pn * BM + wc * 32 + 8 * fq;
        if (wr == 0) { const int trow = wc * 64 + fq * 16 + fr, r_ = u.pm * BM + trow;
            tab[trow] = __builtin_amdgcn_rsqf(((rss[r_] + rss[32768 + r_]) + (rss[65536 + r_] + rss[98304 + r_])) * (1.f / 1024.f) + 1e-6f); }
        asm volatile("s_waitcnt lgkmcnt(0)" ::: "memory"); __builtin_amdgcn_s_barrier(); asm volatile("" ::: "memory");
#pragma unroll
        for (int ai = 0; ai < 2; ++ai)
#pragma unroll
            for (int m = 0; m < 4; ++m) { const int row = row0 + ai * HALF + m * 16; bf16_t* rowp = O + (size_t)row * ldc + col0;
                const float rs = tab[wr * 64 + fr + ai * HALF + m * 16];
#pragma unroll
                for (int bj = 0; bj < 2; ++bj) { const f32x4 v0 = acc[ai][bj][m][0] * rs, v1 = acc[ai][bj][m][1] * rs;
                    u32x4 w; w.x = cvt_pk_bf16(v0[0], v0[1]); w.y = cvt_pk_bf16(v0[2], v0[3]); w.z = cvt_pk_bf16(v1[0], v1[1]); w.w = cvt_pk_bf16(v1[2], v1[3]);
                    *(u32x4*)(rowp + bj * HALF) = w; } }
    }
};
struct EpiRes {
    static constexpr bool PERM = true, AFTER_DRAIN = false;
    const float* base32; bf16_t* xs; int ldc; float* rssp; PG8_LAS float* red;
    __device__ __forceinline__ void operator()(const f32x4 (&acc)[2][2][4][2], const Unit& u, int wr, int wc, int fr, int fq) const {
        const int col0 = u.pn * BM + wc * 32 + 8 * fq;
        const size_t off0 = (size_t)(u.pm * BM + wr * 64 + fr) * ldc + col0;
#pragma unroll
        for (int ai = 0; ai < 2; ++ai) {
            u32x4 bv[4][2];
#pragma unroll
            for (int m = 0; m < 4; ++m)
#pragma unroll
                for (int bj = 0; bj < 2; ++bj) bv[m][bj] = *(const u32x4*)(xs + off0 + (size_t)(ai * HALF + m * 16) * ldc + bj * HALF);
#pragma unroll
            for (int m = 0; m < 4; ++m) { float ss = 0.f;
#pragma unroll
                for (int bj = 0; bj < 2; ++bj) { const size_t off = off0 + (size_t)(ai * HALF + m * 16) * ldc + bj * HALF; const u32x4 b = bv[m][bj];
                    f32x4 o0 = (f32x4){__builtin_bit_cast(float, b.x << 16), __builtin_bit_cast(float, b.x & 0xffff0000u), __builtin_bit_cast(float, b.y << 16), __builtin_bit_cast(float, b.y & 0xffff0000u)};
                    f32x4 o1 = (f32x4){__builtin_bit_cast(float, b.z << 16), __builtin_bit_cast(float, b.z & 0xffff0000u), __builtin_bit_cast(float, b.w << 16), __builtin_bit_cast(float, b.w & 0xffff0000u)};
                    o0 = o0 + acc[ai][bj][m][0]; o1 = o1 + acc[ai][bj][m][1];
                    ss += ((o0[0] * o0[0] + o0[1] * o0[1]) + (o0[2] * o0[2] + o0[3] * o0[3])) + ((o1[0] * o1[0] + o1[1] * o1[1]) + (o1[2] * o1[2] + o1[3] * o1[3]));
                    u32x4 w; w.x = cvt_pk_bf16(o0[0], o0[1]); w.y = cvt_pk_bf16(o0[2], o0[3]); w.z = cvt_pk_bf16(o1[0], o1[1]); w.w = cvt_pk_bf16(o1[2], o1[3]); *(u32x4*)(xs + off) = w; }
                ss += __shfl_xor(ss, 16); ss += __shfl_xor(ss, 32);
                if (fq == 0) red[wc * 256 + ai * HALF + wr * 64 + m * 16 + fr] = ss; }
            asm volatile("" ::: "memory"); }
        asm volatile("s_waitcnt lgkmcnt(0)" ::: "memory"); __builtin_amdgcn_s_barrier(); asm volatile("" ::: "memory");
        if (wr == 0) { const int row = wc * 64 + fq * 16 + fr;
            rssp[(size_t)u.pn * 32768 + u.pm * BM + row] = (red[row] + red[256 + row]) + (red[512 + row] + red[768 + row]); }
    }
};
struct EpiResFinal {
    static constexpr bool PERM = true, AFTER_DRAIN = false;
    const bf16_t* xs; float* out; int ldc; float* rssp; const float* g; unsigned* cnt; PG8_LAS float* red;
    __device__ __forceinline__ void operator()(const f32x4 (&acc_)[2][2][4][2], const Unit& u, int wr, int wc, int fr, int fq) const {
        f32x4 (&acc)[2][2][4][2] = const_cast<f32x4 (&)[2][2][4][2]>(acc_);
        const int col0 = u.pn * BM + wc * 32 + 8 * fq;
        const size_t off0 = (size_t)(u.pm * BM + wr * 64 + fr) * ldc + col0;
#pragma unroll
        for (int ai = 0; ai < 2; ++ai) {
          u32x4 bv[4][2];
#pragma unroll
          for (int m = 0; m < 4; ++m)
#pragma unroll
              for (int bj = 0; bj < 2; ++bj) bv[m][bj] = *(const u32x4*)(xs + off0 + (size_t)(ai * HALF + m * 16) * ldc + bj * HALF);
#pragma unroll
            for (int m = 0; m < 4; ++m) { float ss = 0.f;
#pragma unroll
                for (int bj = 0; bj < 2; ++bj) {
                    const u32x4 b = bv[m][bj];
                    const f32x4 o0 = (f32x4){__builtin_bit_cast(float, b.x << 16), __builtin_bit_cast(float, b.x & 0xffff0000u), __builtin_bit_cast(float, b.y << 16), __builtin_bit_cast(float, b.y & 0xffff0000u)} + acc[ai][bj][m][0];
                    const f32x4 o1 = (f32x4){__builtin_bit_cast(float, b.z << 16), __builtin_bit_cast(float, b.z & 0xffff0000u), __builtin_bit_cast(float, b.w << 16), __builtin_bit_cast(float, b.w & 0xffff0000u)} + acc[ai][bj][m][1];
                    ss += ((o0[0] * o0[0] + o0[1] * o0[1]) + (o0[2] * o0[2] + o0[3] * o0[3])) + ((o1[0] * o1[0] + o1[1] * o1[1]) + (o1[2] * o1[2] + o1[3] * o1[3]));
                    acc[ai][bj][m][0] = o0; acc[ai][bj][m][1] = o1; }
                ss += __shfl_xor(ss, 16); ss += __shfl_xor(ss, 32);
                if (fq == 0) red[wc * 256 + ai * HALF + wr * 64 + m * 16 + fr] = ss;
                asm volatile("" ::: "memory"); } }
        asm volatile("s_waitcnt lgkmcnt(0)" ::: "memory"); __builtin_amdgcn_s_barrier(); asm volatile("" ::: "memory");
        const int trow = wc * 64 + fq * 16 + fr;
        float* slot = rssp + (size_t)u.pm * BM + trow;
        if (wr == 0) __hip_atomic_store(slot + (size_t)u.pn * 32768, (red[trow] + red[256 + trow]) + (red[512 + trow] + red[768 + trow]), __ATOMIC_RELAXED, __HIP_MEMORY_SCOPE_AGENT);
        asm volatile("s_waitcnt vmcnt(0)" ::: "memory"); __builtin_amdgcn_s_barrier(); asm volatile("" ::: "memory");
        if (wr == 0 && wc == 0 && fq == 0 && fr == 0) {
            unsigned* c = cnt + 64 * u.pm; __hip_atomic_fetch_add(c, 1u, __ATOMIC_RELAXED, __HIP_MEMORY_SCOPE_AGENT);
            unsigned spins = 0; while (__hip_atomic_load(c, __ATOMIC_RELAXED, __HIP_MEMORY_SCOPE_AGENT) < 4u && ++spins < (1u << 22)) __builtin_amdgcn_s_sleep(1);
        }
        asm volatile("s_waitcnt vmcnt(0)" ::: "memory"); __builtin_amdgcn_s_barrier(); asm volatile("" ::: "memory");
        if (wr == 0) { const float t = (__hip_atomic_load(slot, __ATOMIC_RELAXED, __HIP_MEMORY_SCOPE_AGENT) + __hip_atomic_load(slot + 32768, __ATOMIC_RELAXED, __HIP_MEMORY_SCOPE_AGENT))
                                     + (__hip_atomic_load(slot + 65536, __ATOMIC_RELAXED, __HIP_MEMORY_SCOPE_AGENT) + __hip_atomic_load(slot + 98304, __ATOMIC_RELAXED, __HIP_MEMORY_SCOPE_AGENT));
            red[1024 + trow] = __builtin_amdgcn_rsqf(t * (1.f / 1024.f) + 1e-6f); }
        asm volatile("s_waitcnt lgkmcnt(0)" ::: "memory"); __builtin_amdgcn_s_barrier(); asm volatile("" ::: "memory");
#pragma unroll
        for (int bj = 0; bj < 2; ++bj) { const f32x4 g0 = *(const f32x4*)(g + col0 + bj * HALF), g1 = *(const f32x4*)(g + col0 + bj * HALF + 4);
#pragma unroll
            for (int ai = 0; ai < 2; ++ai)
#pragma unroll
                for (int m = 0; m < 4; ++m) { const float rs = red[1024 + ai * HALF + wr * 64 + m * 16 + fr]; const size_t off = off0 + (size_t)(ai * HALF + m * 16) * ldc + bj * HALF;
                    *(f32x4*)(out + off) = acc[ai][bj][m][0] * rs * g0; *(f32x4*)(out + off + 4) = acc[ai][bj][m][1] * rs * g1; } }
    }
};
struct EpiFfnUp {
    static constexpr bool PERM = true, AFTER_DRAIN = false;
    static constexpr int FFD = 2816;
    bf16_t* act; const float* cw; const float* cb; float* ulast; float* ufirst; float* vfirst; PG8_LAS f32x4* xch; const float* rss;
    __device__ __forceinline__ void operator()(const f32x4 (&acc)[2][2][4][2], const Unit& u, int wr, int wc, int fr, int fq) const {
        const int ch0 = u.pn * 128 + wc * 32 + 8 * fq;
        f32x4 w0[2], w1[2], w2[2], bb[2];
#pragma unroll
        for (int n = 0; n < 2; ++n) { w0[n] = *(const f32x4*)(cw + ch0 + 4 * n); w1[n] = *(const f32x4*)(cw + FFD + ch0 + 4 * n); w2[n] = *(const f32x4*)(cw + 2 * FFD + ch0 + 4 * n); bb[n] = *(const f32x4*)(cb + ch0 + 4 * n); }
        PG8_LAS float* tab = (PG8_LAS float*)(xch + 256);
#define RSTD4(r_) __builtin_amdgcn_rsqf(((rss[(r_)] + rss[32768 + (r_)]) + (rss[65536 + (r_)] + rss[98304 + (r_)])) * (1.f / 1024.f) + 1e-6f)
        if (wr == 0) { const int trow = wc * 64 + fq * 16 + fr; tab[trow] = RSTD4(u.pm * BM + trow); }
        const int rl = wr * 64 + 4 * fr;
        if (fr == 15) {
#pragma unroll
            for (int ai = 0; ai < 2; ++ai)
#pragma unroll
                for (int q = 0; q < 2; ++q) { PG8_LAS f32x4* s = xch + (((((ai * 2 + wr) * 4 + wc) * 4 + fq) * 2 + q) * 2); s[0] = acc[ai][0][2 + q][0]; s[1] = acc[ai][0][2 + q][1]; }
        }
        asm volatile("s_waitcnt lgkmcnt(0)" ::: "memory"); __builtin_amdgcn_s_barrier(); asm volatile("" ::: "memory");
        if (fr == 15 && wr == 1) {
#pragma unroll
            for (int q = 0; q < 2; ++q) { const float r3 = tab[rl + HALF + 2 + q]; float* g = ulast + (size_t)(u.pm * 2 + q) * FFD + ch0; *(f32x4*)g = acc[1][0][2 + q][0] * r3; *(f32x4*)(g + 4) = acc[1][0][2 + q][1] * r3; } }
        if (fr == 0 && wr == 0) {
#pragma unroll
            for (int q = 0; q < 2; ++q) { const float r0 = tab[q]; float* g = ufirst + (size_t)(u.pm * 2 + q) * FFD + ch0; *(f32x4*)g = acc[0][0][q][0] * r0; *(f32x4*)(g + 4) = acc[0][0][q][1] * r0;
                float* h = vfirst + (size_t)(u.pm * 2 + q) * FFD + ch0; *(f32x4*)h = acc[0][1][q][0] * r0; *(f32x4*)(h + 4) = acc[0][1][q][1] * r0; } }
#pragma unroll
        for (int ai = 0; ai < 2; ++ai) {
            f32x4 h2[2] = {(f32x4){0.f, 0.f, 0.f, 0.f}, (f32x4){0.f, 0.f, 0.f, 0.f}}, h3[2] = {h2[0], h2[0]};
            if (wr == 1 || ai == 1) { const int sai = (wr == 1) ? ai : 0, swr = (wr == 1) ? 0 : 1;
                const PG8_LAS f32x4* s = xch + ((((sai * 2 + swr) * 4 + wc) * 4 + fq) * 2) * 2; const float ra = tab[sai * HALF + swr * 64 + 62], rb = tab[sai * HALF + swr * 64 + 63];
                h2[0] = s[0] * ra; h2[1] = s[1] * ra; h3[0] = s[2] * rb; h3[1] = s[3] * rb; }
            const f32x4 rs4 = *(const PG8_LAS f32x4*)(tab + rl + ai * HALF);
            f32x4 us[4][2];
#pragma unroll
            for (int m = 0; m < 4; ++m) { us[m][0] = acc[ai][0][m][0] * rs4[m]; us[m][1] = acc[ai][0][m][1] * rs4[m]; }
            f32x4 s2[2], s3[2];
#pragma unroll
            for (int n = 0; n < 2; ++n)
#pragma unroll
                for (int e = 0; e < 4; ++e) { s2[n][e] = dppo<0x111>(h2[n][e], us[2][n][e]); s3[n][e] = dppo<0x111>(h3[n][e], us[3][n][e]); }
#pragma unroll
            for (int m = 0; m < 4; ++m) {
                f32x4 uc[2];
#pragma unroll
                for (int n = 0; n < 2; ++n) { const f32x4 um1 = (m == 0) ? s3[n] : us[m - 1][n], um2 = (m == 0) ? s2[n] : (m == 1) ? s3[n] : us[m - 2][n];
                    uc[n] = bb[n] + w0[n] * um2 + w1[n] * um1 + w2[n] * us[m][n]; }
                const f32x4 v0 = acc[ai][1][m][0] * rs4[m], v1 = acc[ai][1][m][1] * rs4[m];
                const f32x2 a = gelu_pk((f32x2){uc[0][0], uc[0][1]}), b = gelu_pk((f32x2){uc[0][2], uc[0][3]}), c = gelu_pk((f32x2){uc[1][0], uc[1][1]}), d = gelu_pk((f32x2){uc[1][2], uc[1][3]});
                u32x4 w; w.x = cvt_pk_bf16(a.x * v0[0], a.y * v0[1]); w.y = cvt_pk_bf16(b.x * v0[2], b.y * v0[3]); w.z = cvt_pk_bf16(c.x * v1[0], c.y * v1[1]); w.w = cvt_pk_bf16(d.x * v1[2], d.y * v1[3]);
                *(u32x4*)(act + (size_t)(u.pm * BM + ai * HALF + rl + m) * FFD + ch0) = w;
            }
        }
    }
};
}
#define LAS __attribute__((address_space(3)))
typedef unsigned short bf16;
typedef unsigned v4u __attribute__((ext_vector_type(4)));
typedef unsigned v2u __attribute__((ext_vector_type(2)));
typedef float f32x4 __attribute__((ext_vector_type(4)));
typedef float f32x2 __attribute__((ext_vector_type(2)));
typedef short bf16x8 __attribute__((ext_vector_type(8)));
constexpr int NWAVES = 8, NTHR = 512;
constexpr int BATCH = 8, SEQ = 4096, D = 1024, M = BATCH * SEQ, FFD = 2816, NUP = 2 * FFD, NAB = 2048, NGLA = 3584, GLA_SRC_N = 3088;
constexpr float EPS = 1e-6f;
constexpr size_t MiB = 1u << 20;
constexpr size_t WS_DEC = 1 * MiB, WS_ULAST = 2 * MiB, WS_UFIRST = 5 * MiB, WS_VFIRST = 8 * MiB;
constexpr size_t WS_WABIN = 12 * MiB, WS_WABOUT = 16 * MiB, WS_WGLAIN = 18 * MiB, WS_WGLAOUT = 25 * MiB, WS_WUP = 27 * MiB  , WS_WDN = 49 * MiB  ;
constexpr size_t WS_XN = 64 * MiB, WS_CAT = 128 * MiB, WS_H = 192 * MiB, WS_XS = 416 * MiB  , WS_END = 480 * MiB;
constexpr int LDS_BYTES = 147456, XCH_OFF = 131072;
#ifndef PHM
#define PHM 0xffff
#endif

__device__ __forceinline__ float bflo(unsigned w) { return __builtin_bit_cast(float, w << 16); }
__device__ __forceinline__ float bfhi(unsigned w) { return __builtin_bit_cast(float, w & 0xffff0000u); }
__device__ __forceinline__ unsigned pk2(float lo, float hi) { return pg8::cvt_pk_bf16(lo, hi); }
__device__ __forceinline__ float wave_sum(float v) {
#pragma unroll
    for (int o = 1; o < 64; o <<= 1) v += __shfl_xor(v, o);
    return v;
}
#define LDS_WAIT() asm volatile("s_waitcnt lgkmcnt(0)" ::: "memory")

__device__ __forceinline__ void transpose_item(const float* W, int ldw, int K, bf16* WT, int k0, int n0, int trow0, LAS float* scr, int lane, const float* g = nullptr) {
    float tv[32];
#pragma unroll
    for (int i = 0; i < 32; ++i) { const int kk = 2 * i + (lane >> 5); tv[i] = W[(size_t)(k0 + kk) * ldw + n0 + (lane & 31)]; }
#pragma unroll
    for (int i = 0; i < 32; ++i) { const int kk = 2 * i + (lane >> 5); scr[kk * 33 + (lane & 31)] = tv[i] * (g ? g[k0 + kk] : 1.f); }
    LDS_WAIT(); asm volatile("" ::: "memory");
    const int c = lane & 7;
#pragma unroll
    for (int j = 0; j < 4; ++j) { const int n = (lane >> 3) + 8 * j; const LAS float* s = scr + (8 * c) * 33 + n;
        v4u o; o.x = pk2(s[0 * 33], s[1 * 33]); o.y = pk2(s[2 * 33], s[3 * 33]); o.z = pk2(s[4 * 33], s[5 * 33]); o.w = pk2(s[6 * 33], s[7 * 33]);
        *(v4u*)(WT + (size_t)(trow0 + n) * K + k0 + 8 * c) = o; }
    LDS_WAIT(); asm volatile("" ::: "memory");
}

struct Args { const float* in[20]; float* out; unsigned char* ws; };

__device__ __forceinline__ void convert_rows(const float* X, bf16* XS, float* rss, int gw, int ngw, int lane) {
#pragma unroll 2
    for (int m = gw; m < M; m += ngw) {
        const f32x4* xr = (const f32x4*)(X + (size_t)m * D) + lane;
        f32x4 v[4]; float s = 0.f;
#pragma unroll
        for (int j = 0; j < 4; ++j) { v[j] = xr[64 * j]; s += (v[j].x * v[j].x + v[j].y * v[j].y) + (v[j].z * v[j].z + v[j].w * v[j].w); }
        s = wave_sum(s);
        unsigned long long* o8 = (unsigned long long*)(XS + (size_t)m * D) + lane;
#pragma unroll
        for (int j = 0; j < 4; ++j) o8[64 * j] = (unsigned long long)pk2(v[j].x, v[j].y) | ((unsigned long long)pk2(v[j].z, v[j].w) << 32);
        if (lane < 4) rss[(size_t)lane * 32768 + m] = lane == 0 ? s : 0.f;
    }
}
__device__ __forceinline__ void final_norm_rows(const bf16* XS, float* OUT, const float* g, const float* rss, int gw, int ngw, int lane) {
    f32x4 gv[4];
#pragma unroll
    for (int j = 0; j < 4; ++j) gv[j] = ((const f32x4*)g)[lane + 64 * j];
#pragma unroll 4
    for (int m = gw; m < M; m += ngw) {
        const v2u* xr = (const v2u*)(XS + (size_t)m * D) + lane; f32x4* orow = (f32x4*)(OUT + (size_t)m * D) + lane;
        const float rstd = rsqrtf(((rss[m] + rss[32768 + m]) + (rss[65536 + m] + rss[98304 + m])) * (1.f / D) + EPS);
#pragma unroll
        for (int j = 0; j < 4; ++j) { const v2u w = xr[64 * j]; orow[64 * j] = (f32x4){bflo(w.x), bfhi(w.x), bflo(w.y), bfhi(w.y)} * rstd * gv[j]; }
    }
}

__device__ __forceinline__ void unpack8(const v4u w, float (&f)[8]) {
    f[0] = bflo(w.x); f[1] = bfhi(w.x); f[2] = bflo(w.y); f[3] = bfhi(w.y); f[4] = bflo(w.z); f[5] = bfhi(w.z); f[6] = bflo(w.w); f[7] = bfhi(w.w);
}
__device__ __forceinline__ void ab_mixer(const bf16* H, bf16* CAT, const float* pool_b, const float* pool_scale, const float* scw, const float* scb, int wg, int nwg, int tid) {
    const int cv = tid & 127, sub = tid >> 7;
    float pa[8], pb[8], pc[8], pd[8];
    if (cv < 64) {
#pragma unroll
        for (int e = 0; e < 8; ++e) { pa[e] = pool_b[cv * 8 + e]; pb[e] = pool_scale[cv * 8 + e]; pc[e] = 0.f; pd[e] = 0.f; }
    } else {
        const int c = (cv - 64) * 8;
#pragma unroll
        for (int e = 0; e < 8; ++e) { pa[e] = scw[c + e]; pb[e] = scw[512 + c + e]; pc[e] = scw[1024 + c + e]; pd[e] = scb[c + e]; }
    }
    for (int chunk = wg * 4 + sub; chunk < M / 32; chunk += nwg * 4) {
        const int r0 = chunk * 32, t0 = r0 & (SEQ - 1);
        bf16* outp = CAT + (size_t)r0 * D + cv * 8;
        if (cv < 64) {
            const int win = 2 << (cv >> 4);
            const bf16* p = H + (size_t)r0 * NAB + cv * 8;
            float s[8], f[8];
#pragma unroll
            for (int e = 0; e < 8; ++e) s[e] = 0.f;
            if (t0 > 0) for (int i = 1; i < win; ++i) { unpack8(*(const v4u*)(p - (size_t)i * NAB), f);
#pragma unroll
                for (int e = 0; e < 8; ++e) s[e] += f[e]; }
#pragma unroll 4
            for (int jr = 0; jr < 32; ++jr) {
                const int t = t0 + jr; float cur[8], y[8];
                unpack8(*(const v4u*)(p + (size_t)jr * NAB), cur);
                if (jr >= 1 && t >= win) { unpack8(*(const v4u*)(p + (ptrdiff_t)(jr - win) * NAB), f);
#pragma unroll
                    for (int e = 0; e < 8; ++e) s[e] -= f[e]; }
#pragma unroll
                for (int e = 0; e < 8; ++e) s[e] += cur[e];
                const float inv = 1.f / (float)((t + 1) < win ? (t + 1) : win);
#pragma unroll
                for (int e = 0; e < 8; ++e) y[e] = (s[e] * inv - cur[e] + pa[e]) * pb[e];
                v4u o; o.x = pk2(y[0], y[1]); o.y = pk2(y[2], y[3]); o.z = pk2(y[4], y[5]); o.w = pk2(y[6], y[7]);
                *(v4u*)(outp + (size_t)jr * D) = o;
            }
        } else {
            const bf16* p = H + (size_t)r0 * NAB + (cv - 64) * 8;
            float p1[8], p2[8], a[8], b[8];
#pragma unroll
            for (int e = 0; e < 8; ++e) { p1[e] = 0.f; p2[e] = 0.f; }
            if (t0 > 0) { unpack8(*(const v4u*)(p - NAB + 1024), a); unpack8(*(const v4u*)(p - NAB + 1536), b);
#pragma unroll
                for (int e = 0; e < 8; ++e) p1[e] = a[e] * b[e];
                unpack8(*(const v4u*)(p - 2 * NAB + 1024), a); unpack8(*(const v4u*)(p - 2 * NAB + 1536), b);
#pragma unroll
                for (int e = 0; e < 8; ++e) p2[e] = a[e] * b[e]; }
#pragma unroll 4
            for (int jr = 0; jr < 32; ++jr) {
                float sb[8], y[8];
                unpack8(*(const v4u*)(p + (size_t)jr * NAB + 512), sb); unpack8(*(const v4u*)(p + (size_t)jr * NAB + 1024), a); unpack8(*(const v4u*)(p + (size_t)jr * NAB + 1536), b);
#pragma unroll
                for (int e = 0; e < 8; ++e) { const float pr = a[e] * b[e]; y[e] = sb[e] * (pd[e] + pc[e] * pr + pb[e] * p1[e] + pa[e] * p2[e]); p2[e] = p1[e]; p1[e] = pr; }
                v4u o; o.x = pk2(y[0], y[1]); o.y = pk2(y[2], y[3]); o.z = pk2(y[4], y[5]); o.w = pk2(y[6], y[7]);
                *(v4u*)(outp + (size_t)jr * D) = o;
            }
        }
    }
}

__device__ __forceinline__ float gate_log(float z) { return (fminf(z, 0.f) - __logf(1.f + __expf(-fabsf(z)))) * (1.f / 16.f); }
__device__ __forceinline__ void gla_prep(bf16* H, bf16* KDT, float* DEC, const float* b_g, int wg, int nwg, int tid) {
    const int half = tid >> 8, cp = tid & 255, c = 2 * cp;
    const float bg0 = b_g[c], bg1 = b_g[c + 1];
    const float QS = 0.08838834764831845f;
    for (int it = wg * 2 + half; it < BATCH * 64; it += nwg * 2) {
        bf16* base = H + (size_t)it * 64 * NGLA + c;
        unsigned cg[8], cq[8], ck[8], ng[8], nq[8], nk[8];
#pragma unroll
        for (int m = 0; m < 8; ++m) { const bf16* rp = base + (size_t)m * NGLA; cg[m] = *(const unsigned*)(rp + 3072); cq[m] = *(const unsigned*)rp; ck[m] = *(const unsigned*)(rp + 512); }
        float c0 = 0.f, c1 = 0.f;
        v4u* o0 = (v4u*)(KDT + ((size_t)it * 512 + c) * 64); v4u* o1 = o0 + 8;
        for (int g = 0; g < 8; ++g) {
            bf16* gb = base + (size_t)(g * 8) * NGLA;
            if (g < 7) {
#pragma unroll
                for (int m = 0; m < 8; ++m) { const bf16* rp = gb + (size_t)(8 + m) * NGLA; ng[m] = *(const unsigned*)(rp + 3072); nq[m] = *(const unsigned*)rp; nk[m] = *(const unsigned*)(rp + 512); }
            }
            unsigned kd0[4], kd1[4]; float h0 = 0.f, h1 = 0.f;
#pragma unroll
            for (int m = 0; m < 8; ++m) { bf16* rp = gb + (size_t)m * NGLA;
                c0 += gate_log(bflo(cg[m]) + bg0); c1 += gate_log(bfhi(cg[m]) + bg1);
                const float d0 = bflo(ck[m]) * __expf(-c0), d1 = bfhi(ck[m]) * __expf(-c1);
                *(unsigned*)rp = pk2(bflo(cq[m]) * QS * __expf(c0), bfhi(cq[m]) * QS * __expf(c1));
                *(unsigned*)(rp + 512) = pk2(d0, d1);
                if (m & 1) { kd0[m >> 1] = pk2(h0, d0); kd1[m >> 1] = pk2(h1, d1); } else { h0 = d0; h1 = d1; } }
            o0[g] = (v4u){kd0[0], kd0[1], kd0[2], kd0[3]}; o1[g] = (v4u){kd1[0], kd1[1], kd1[2], kd1[3]};
#pragma unroll
            for (int m = 0; m < 8; ++m) { cg[m] = ng[m]; cq[m] = nq[m]; ck[m] = nk[m]; }
        }
        *(f32x2*)(DEC + (size_t)it * 512 + c) = (f32x2){__expf(c0), __expf(c1)};
    }
}

constexpr int QP = 136, MP = 72;
constexpr int L_Q = 0, L_K = L_Q + 64 * QP * 2, L_KD = L_K + 64 * QP * 2, L_VT = L_KD + 128 * MP * 2, L_A = L_VT + 32 * MP * 2, L_ST = L_A + 64 * MP * 2, L_SCAN_END = L_ST + 2 * 32 * QP * 2;
static_assert(L_SCAN_END <= XCH_OFF, "scan LDS");
__device__ __forceinline__ bf16x8 ldfrag(const LAS unsigned char* p) { return *(const LAS bf16x8*)p; }
__device__ __forceinline__ void gla_scan(LAS unsigned char* lds, const bf16* H, const bf16* KDT, const float* DEC, bf16* O, int wg, int nwg, int tid) {
    const int wave = __builtin_amdgcn_readfirstlane(tid >> 6), lane = tid & 63, l16 = lane & 15, lq = lane >> 4;
    for (int item = wg; item < 256; item += nwg) {
        const int x = item & 7, j = item >> 3, bh = x * 4 + (j >> 3), vs = j & 7, b = bh >> 2, h = bh & 3;
        __syncthreads();
        for (int i = tid; i < 2 * 32 * QP / 2; i += NTHR) ((LAS unsigned*)(lds + L_ST))[i] = 0u;
        f32x4 S[2] = {(f32x4){0.f, 0.f, 0.f, 0.f}, (f32x4){0.f, 0.f, 0.f, 0.f}};
        const int r0 = tid >> 4, c16 = tid & 15, hk0 = tid >> 3, c8k = tid & 7, mv = (tid & 255) >> 2, c8v = tid & 3;
        const bf16* pq = H + ((size_t)b * SEQ + r0) * NGLA + h * 128 + c16 * 8;
        const bf16* pkd = KDT + (((size_t)(b * 64)) * 512 + h * 128 + hk0) * 64 + c8k * 8;
        const bf16* pv = H + ((size_t)b * SEQ + mv) * NGLA + 1024 + h * 256 + vs * 32 + c8v * 8;
        const float* pdec = DEC + ((size_t)(b * 64)) * 512 + h * 128 + 16 * wave + 4 * lq;
        v4u rq0 = *(const v4u*)pq, rq1 = *(const v4u*)(pq + (size_t)32 * NGLA), rk0 = *(const v4u*)(pq + 512), rk1 = *(const v4u*)(pq + (size_t)32 * NGLA + 512);
        v4u rd0 = *(const v4u*)pkd, rd1 = *(const v4u*)(pkd + 64 * 64), rv = *(const v4u*)pv;
        f32x4 rdec = *(const f32x4*)pdec;
        for (int n = 0; n < 64; ++n) {
            const size_t row0 = (size_t)b * SEQ + n * 64;
            *(LAS v4u*)(lds + L_Q + (r0 * QP + c16 * 8) * 2) = rq0; *(LAS v4u*)(lds + L_Q + ((r0 + 32) * QP + c16 * 8) * 2) = rq1;
            *(LAS v4u*)(lds + L_K + (r0 * QP + c16 * 8) * 2) = rk0; *(LAS v4u*)(lds + L_K + ((r0 + 32) * QP + c16 * 8) * 2) = rk1;
            *(LAS v4u*)(lds + L_KD + (hk0 * MP + c8k * 8) * 2) = rd0; *(LAS v4u*)(lds + L_KD + ((hk0 + 64) * MP + c8k * 8) * 2) = rd1;
            if (tid < 256) { LAS bf16* vt = (LAS bf16*)(lds + L_VT) + (c8v * 8) * MP + mv;
                vt[0 * MP] = (bf16)(rv.x & 0xffff); vt[1 * MP] = (bf16)(rv.x >> 16); vt[2 * MP] = (bf16)(rv.y & 0xffff); vt[3 * MP] = (bf16)(rv.y >> 16);
                vt[4 * MP] = (bf16)(rv.z & 0xffff); vt[5 * MP] = (bf16)(rv.z >> 16); vt[6 * MP] = (bf16)(rv.w & 0xffff); vt[7 * MP] = (bf16)(rv.w >> 16); }
            const f32x4 dec = rdec;
            __syncthreads();
            if (n + 1 < 64) {
                pq += (size_t)64 * NGLA; pkd += 512 * 64; pv += (size_t)64 * NGLA; pdec += 512;
                rq0 = *(const v4u*)pq; rq1 = *(const v4u*)(pq + (size_t)32 * NGLA); rk0 = *(const v4u*)(pq + 512); rk1 = *(const v4u*)(pq + (size_t)32 * NGLA + 512);
                rd0 = *(const v4u*)pkd; rd1 = *(const v4u*)(pkd + 64 * 64); rv = *(const v4u*)pv; rdec = *(const f32x4*)pdec;
            }
            { const int qi = wave >> 1, jv = wave & 1; f32x4 o = (f32x4){0.f, 0.f, 0.f, 0.f};
#pragma unroll
              for (int t = 0; t < 2; ++t) if (2 * t <= qi) {
                  f32x4 a0 = (f32x4){0.f, 0.f, 0.f, 0.f}, a1 = a0;
#pragma unroll
                  for (int kk = 0; kk < 4; ++kk) a0 = __builtin_amdgcn_mfma_f32_16x16x32_bf16(ldfrag(lds + L_K + ((32 * t + l16) * QP + kk * 32 + lq * 8) * 2), ldfrag(lds + L_Q + ((16 * qi + l16) * QP + kk * 32 + lq * 8) * 2), a0, 0, 0, 0);
                  if (2 * t == qi) {
#pragma unroll
                      for (int ii = 0; ii < 4; ++ii) if (4 * lq + ii > l16) a0[ii] = 0.f; }
                  if (2 * t + 1 <= qi) {
#pragma unroll
                      for (int kk = 0; kk < 4; ++kk) a1 = __builtin_amdgcn_mfma_f32_16x16x32_bf16(ldfrag(lds + L_K + ((32 * t + 16 + l16) * QP + kk * 32 + lq * 8) * 2), ldfrag(lds + L_Q + ((16 * qi + l16) * QP + kk * 32 + lq * 8) * 2), a1, 0, 0, 0);
                      if (2 * t + 1 == qi) {
#pragma unroll
                          for (int ii = 0; ii < 4; ++ii) if (4 * lq + ii > l16) a1[ii] = 0.f; } }
                  const v4u bw = (v4u){pk2(a0[0], a0[1]), pk2(a0[2], a0[3]), pk2(a1[0], a1[1]), pk2(a1[2], a1[3])};
                  const v2u v0 = *(const LAS v2u*)(lds + L_VT + ((16 * jv + l16) * MP + 32 * t + 4 * lq) * 2), v1 = *(const LAS v2u*)(lds + L_VT + ((16 * jv + l16) * MP + 32 * t + 16 + 4 * lq) * 2);
                  const v4u aw = (v4u){v0.x, v0.y, v1.x, v1.y};
                  o = __builtin_amdgcn_mfma_f32_16x16x32_bf16(__builtin_bit_cast(bf16x8, aw), __builtin_bit_cast(bf16x8, bw), o, 0, 0, 0); }
#pragma unroll
              for (int kk = 0; kk < 4; ++kk) o = __builtin_amdgcn_mfma_f32_16x16x32_bf16(ldfrag(lds + L_ST + ((n & 1) * 32 * QP + (16 * jv + l16) * QP + kk * 32 + lq * 8) * 2), ldfrag(lds + L_Q + ((16 * qi + l16) * QP + kk * 32 + lq * 8) * 2), o, 0, 0, 0);
              *(v2u*)(O + (row0 + 16 * qi + l16) * D + h * 256 + vs * 32 + 16 * jv + 4 * lq) = (v2u){pk2(o[0], o[1]), pk2(o[2], o[3])}; }
#pragma unroll
            for (int jv = 0; jv < 2; ++jv) {
#pragma unroll
                for (int kk = 0; kk < 2; ++kk) S[jv] = __builtin_amdgcn_mfma_f32_16x16x32_bf16(ldfrag(lds + L_KD + ((16 * wave + l16) * MP + kk * 32 + lq * 8) * 2), ldfrag(lds + L_VT + ((16 * jv + l16) * MP + kk * 32 + lq * 8) * 2), S[jv], 0, 0, 0);
                S[jv] = S[jv] * dec;
                *(LAS v2u*)(lds + L_ST + (((n + 1) & 1) * 32 * QP + (16 * jv + l16) * QP + 16 * wave + 4 * lq) * 2) = (v2u){pk2(S[jv][0], S[jv][1]), pk2(S[jv][2], S[jv][3])}; }
            __syncthreads();
        }
    }
}
__device__ __forceinline__ void gla_post(const bf16* O, const bf16* H, bf16* CAT, const float* gnorm, int gw, int ngw, int lane) {
    const int hs = lane >> 5, cl = (lane & 31) * 8;
    float gn[8];
#pragma unroll
    for (int e = 0; e < 8; ++e) gn[e] = gnorm[cl + e];
#pragma unroll 2
    for (int m = gw; m < M; m += ngw) {
        v4u ow[2], rw[2];
#pragma unroll
        for (int p = 0; p < 2; ++p) { ow[p] = *(const v4u*)(O + (size_t)m * D + (hs + 2 * p) * 256 + cl); rw[p] = *(const v4u*)(H + (size_t)m * NGLA + 2048 + (hs + 2 * p) * 256 + cl); }
#pragma unroll
        for (int p = 0; p < 2; ++p) { float o[8], r[8], y[8]; unpack8(ow[p], o); unpack8(rw[p], r);
            float ss = 0.f;
#pragma unroll
            for (int e = 0; e < 8; ++e) ss += o[e] * o[e];
#pragma unroll
            for (int sh = 1; sh < 32; sh <<= 1) ss += __shfl_xor(ss, sh);
            const float rs = rsqrtf(ss * (1.f / 256.f) + EPS);
#pragma unroll
            for (int e = 0; e < 8; ++e) y[e] = o[e] * rs * gn[e] * (r[e] / (1.f + __expf(-r[e])));
            *(v4u*)(CAT + (size_t)m * D + (hs + 2 * p) * 256 + cl) = (v4u){pk2(y[0], y[1]), pk2(y[2], y[3]), pk2(y[4], y[5]), pk2(y[6], y[7])}; }
    }
}

#define XB_TMO      128
#define XB_XCNT(j)  (256  + 64 * (j))
#define XB_XSUB(j)  (1280 + 64 * (j))
#define XB_XGEN(j)  (2304 + 64 * (j))
#define XB_TOP      3328
#define XB_TOPGEN   3392
#define XCD_BAR_WORDS 3456
#define XB_SPIN_CAP (1u << 18)

__device__ __forceinline__ unsigned xb_ld(unsigned* p)              { return __hip_atomic_load(p, __ATOMIC_RELAXED, __HIP_MEMORY_SCOPE_AGENT); }
__device__ __forceinline__ unsigned xb_add(unsigned* p, unsigned v) { return __hip_atomic_fetch_add(p, v, __ATOMIC_RELAXED, __HIP_MEMORY_SCOPE_AGENT); }
__device__ __forceinline__ unsigned xb_xcc_id() { return (unsigned)__builtin_amdgcn_s_getreg((3 << 11) | 20) & 0xFu; }
#define XB_SPIN(cond, bar) do { unsigned _sp = 0; while (cond) { __builtin_amdgcn_s_sleep(1); \
    if ((++_sp & 255u) == 0u) { if (xb_ld(&(bar)[XB_TMO])) break; if (_sp > XB_SPIN_CAP) { atomicAdd(&(bar)[XB_TMO], 1u); break; } } } } while (0)

struct XcdBarrier {
    unsigned* bar; unsigned x;
    volatile LAS unsigned* st;
};

__device__ __forceinline__ XcdBarrier xcd_barrier_post(unsigned* bar, volatile LAS unsigned* st) {
    XcdBarrier b; b.bar = bar; b.x = xb_xcc_id(); b.st = st;
    if (threadIdx.x == 0) (void)xb_add(&bar[XB_XCNT(b.x)], 1u);
    return b;
}
__device__ __forceinline__ void xcd_barrier_complete(unsigned* bar, unsigned x, unsigned& nloc, unsigned& nx) {
    const unsigned G = gridDim.x * gridDim.y * gridDim.z;
    unsigned sum, cnt, mine, sp = 0u;
    for (;;) {
        sum = 0u; cnt = 0u; mine = 0u;
#pragma unroll
        for (unsigned j = 0; j < 16; ++j) { const unsigned c = xb_ld(&bar[XB_XCNT(j)]); sum += c; cnt += (c > 0u) ? 1u : 0u; mine = (j == x) ? c : mine; }
        if (sum == G) break;
        __builtin_amdgcn_s_sleep(1);
        if ((++sp & 255u) == 0u) { if (xb_ld(&bar[XB_TMO])) break; if (sp > XB_SPIN_CAP) { atomicAdd(&bar[XB_TMO], 1u); break; } }
    }
    nloc = mine > 0u ? mine : 1u; nx = cnt > 0u ? cnt : 1u;
}

__device__ __forceinline__ void xcd_barrier(const XcdBarrier& b) {
    asm volatile("s_waitcnt vmcnt(0)" ::: "memory");
    __syncthreads();
    if (threadIdx.x == 0) {
        unsigned* bar = b.bar;
        __builtin_amdgcn_s_waitcnt(0);
        unsigned nloc = b.st[0], nx = b.st[1];
        if (nloc == 0u) { xcd_barrier_complete(bar, b.x, nloc, nx); b.st[0] = nloc; b.st[1] = nx; }
        const unsigned old = xb_add(&bar[XB_XSUB(b.x)], 1u);
        const unsigned gen = old / nloc;
        if (old + 1u == (gen + 1u) * nloc) {
            __builtin_amdgcn_fence(__ATOMIC_RELEASE, "agent");
            asm volatile("s_waitcnt vmcnt(0)" ::: "memory");
            const unsigned og = xb_add(&bar[XB_TOP], 1u);
            const unsigned tg = og / nx;
            if (og + 1u == (tg + 1u) * nx) xb_add(&bar[XB_TOPGEN], 1u);
            else XB_SPIN(xb_ld(&bar[XB_TOPGEN]) == tg, bar);
            __builtin_amdgcn_fence(__ATOMIC_ACQUIRE, "agent");
            xb_add(&bar[XB_XGEN(b.x)], 1u);
            asm volatile("s_waitcnt vmcnt(0)" ::: "memory");
        } else {
            XB_SPIN(xb_ld(&bar[XB_XGEN(b.x)]) == gen, bar);
            __builtin_amdgcn_fence(__ATOMIC_ACQUIRE, "agent");
            asm volatile("s_waitcnt vmcnt(0)" ::: "memory");
        }
    }
    __syncthreads();
}

#define GRID_SYNC() do { XcdBarrier b_; b_.bar = (unsigned*)(GAS unsigned*)karg(21); b_.x = xb_xcc_id(); b_.st = (volatile LAS unsigned*)(lds + MISC_OFF); xcd_barrier(b_); } while (0)
constexpr int MISC_OFF = XCH_OFF + 8192;
#define GAS __attribute__((address_space(1)))
typedef const __attribute__((address_space(4))) unsigned long long* kaptr_t;
__device__ __forceinline__ unsigned long long karg(int k) { kaptr_t p = (kaptr_t)__builtin_amdgcn_kernarg_segment_ptr(); asm volatile("" : "+s"(p)); return p[k]; }
#define INF(k) ((const float*)(const GAS float*)karg(k))
#define XOUT() ((float*)(GAS float*)karg(20))
#define WSB(off) ((bf16*)(GAS bf16*)(karg(21) + (off)))
#define WSF(off) ((float*)(GAS float*)(karg(21) + (off)))
#define RSSP(i) WSF(60 * MiB + (size_t)(i) * 524288)
__global__ void __launch_bounds__(NTHR, 2) fwd_megakernel(Args args) {
    extern __shared__ __attribute__((aligned(16))) unsigned char lds_raw[];
    cg::grid_group grid = cg::this_grid();
    LAS unsigned char* lds = (LAS unsigned char*)lds_raw;
    { const int tid = threadIdx.x; if (tid < 2) ((LAS unsigned*)(lds + MISC_OFF))[tid] = 0u; }
    __syncthreads();
    grid.sync();
    (void)xcd_barrier_post((unsigned*)(GAS unsigned*)karg(21), (volatile LAS unsigned*)(lds + MISC_OFF));
    (void)args;
#define WAVE_IDS() const int tid_ = fresh_tid(), lane = tid_ & 63, wave = __builtin_amdgcn_readfirstlane(tid_ >> 6), G = gridDim.x, wg = blockIdx.x, gw = wg * NWAVES + wave, ngw = G * NWAVES

    {
        WAVE_IDS();
        LAS float* scr = (LAS float*)(lds + wave * 16384);
        constexpr int I_ABIN = 16 * 48, I_ABOUT = 16 * 32, I_GLAIN = 16 * 96, I_GLAOUT = 16 * 32, I_UP = 16 * 176, I_DN = 44 * 32;
        constexpr int NITEMS = I_ABIN + I_ABOUT + I_GLAIN + I_GLAOUT + 2 * I_UP + 2 * I_DN;
        for (int it = gw; it < NITEMS; it += ngw) {
            int r = it;
            if (r < I_ABIN) { const int kb = r / 48, nb = r % 48; transpose_item(INF(3), NAB, D, WSB(WS_WABIN), kb * 64, 512 + nb * 32, 512 + nb * 32, scr, lane, INF(1)); continue; } r -= I_ABIN;
            if (r < I_ABOUT) { const int kb = r / 32, nb = r % 32; transpose_item(INF(9), D, D, WSB(WS_WABOUT), kb * 64, nb * 32, nb * 32, scr, lane); continue; } r -= I_ABOUT;
            if (r < I_GLAIN) { const int kb = r / 96, nb = r % 96; transpose_item(INF(10), GLA_SRC_N, D, WSB(WS_WGLAIN), kb * 64, nb * 32, nb * 32, scr, lane, INF(1) + D); continue; } r -= I_GLAIN;
            if (r < I_GLAOUT) { const int kb = r / 32, nb = r % 32; transpose_item(INF(14), D, D, WSB(WS_WGLAOUT), kb * 64, nb * 32, nb * 32, scr, lane); continue; } r -= I_GLAOUT;
            if (r < 2 * I_UP) { const int l = r / I_UP, q = r % I_UP, kb = q / 176, nb = q % 176, n0 = nb * 32, isv = n0 >= FFD, ch = isv ? n0 - FFD : n0;
                transpose_item(INF(15) + (size_t)l * D * NUP, NUP, D, WSB(WS_WUP) + (size_t)l * NUP * D, kb * 64, n0, (ch >> 7) * 256 + isv * 128 + (ch & 127), scr, lane, INF(2) + (size_t)l * D); continue; } r -= 2 * I_UP;
            { const int l = r / I_DN, q = r % I_DN, kb = q / 32, nb = q % 32;
                transpose_item(INF(18) + (size_t)l * FFD * D, D, FFD, WSB(WS_WDN) + (size_t)l * D * FFD, kb * 64, nb * 32, nb * 32, scr, lane); }
        }
        { const float* abin = INF(3); const float* poolw = INF(4); const float* glain = INF(10); const float* wg2 = INF(11); const float* mn1 = INF(1) + D; const float* mn0 = INF(1); bf16* W_ABIN = WSB(WS_WABIN); bf16* W_GLAIN = WSB(WS_WGLAIN);
        for (int idx = wg * NTHR + tid_; idx < 256 * 512; idx += G * NTHR) {
            const int k4 = idx >> 9, n = idx & 511, g = n >> 7, nn = n & 127;
            const float* wi = abin + (size_t)(4 * k4) * NAB + g * 128; const float* pw = poolw + (size_t)g * 128 * 128 + nn;
            float s0 = 0.f, s1 = 0.f, s2 = 0.f, s3 = 0.f;
#pragma unroll 8
            for (int c = 0; c < 128; ++c) { const float w = pw[c * 128]; s0 += wi[c] * w; s1 += wi[NAB + c] * w; s2 += wi[2 * NAB + c] * w; s3 += wi[3 * NAB + c] * w; }
            { const f32x4 m0 = *(const f32x4*)(mn0 + 4 * k4); *(v2u*)(W_ABIN + (size_t)n * D + 4 * k4) = (v2u){pk2(s0 * m0[0], s1 * m0[1]), pk2(s2 * m0[2], s3 * m0[3])}; }
            const float* gi = glain + (size_t)(4 * k4) * GLA_SRC_N + 3072; const float* g2 = wg2 + n;
            float t0 = 0.f, t1 = 0.f, t2 = 0.f, t3 = 0.f;
#pragma unroll
            for (int r = 0; r < 16; ++r) { const float w = g2[r * 512]; t0 += gi[r] * w; t1 += gi[GLA_SRC_N + r] * w; t2 += gi[2 * GLA_SRC_N + r] * w; t3 += gi[3 * GLA_SRC_N + r] * w; }
            const f32x4 mg = *(const f32x4*)(mn1 + 4 * k4);
            *(v2u*)(W_GLAIN + (size_t)(3072 + n) * D + 4 * k4) = (v2u){pk2(t0 * mg[0], t1 * mg[1]), pk2(t2 * mg[2], t3 * mg[3])};
        } }
        convert_rows(INF(0), WSB(WS_XS), RSSP(4), gw, ngw, lane);
    }
    GRID_SYNC();

    for (int l = 0; l < 2; ++l) {
        { const int N = (l == 0) ? NAB : NGLA;
          pg8::Gemm g{WSB(WS_XS), (l == 0) ? WSB(WS_WABIN) : WSB(WS_WGLAIN), M, N, D}; pg8::StaticOrder S; S.init(M, N, gridDim.x, blockIdx.x);
          pg8::EpiBf16P E{WSB(WS_H), N, (l == 0) ? (const float*)RSSP(4) : (const float*)RSSP(1), (LAS float*)(lds + XCH_OFF)};
          if (PHM & 1) pg8::gemm_phase<pg8::EpiBf16P, pg8::StaticOrder, true, true>(lds, g, S, E); }
        GRID_SYNC();
        if (l == 0) {
            if (PHM & 2) ab_mixer(WSB(WS_H), WSB(WS_CAT), INF(5), INF(6), INF(7), INF(8), blockIdx.x, gridDim.x, fresh_tid());
        } else {
            if (PHM & 4) gla_prep(WSB(WS_H), WSB(WS_CAT), WSF(WS_DEC), INF(12), blockIdx.x, gridDim.x, fresh_tid());
            GRID_SYNC();
            if (PHM & 8) gla_scan(lds, WSB(WS_H), WSB(WS_CAT), WSF(WS_DEC), WSB(WS_XN), blockIdx.x, gridDim.x, fresh_tid());
            GRID_SYNC();
            { WAVE_IDS(); if (PHM & 16) gla_post(WSB(WS_XN), WSB(WS_H), WSB(WS_CAT), INF(13), gw, ngw, lane); }
        }
        GRID_SYNC();
        { pg8::Gemm g{WSB(WS_CAT), (l == 0) ? WSB(WS_WABOUT) : WSB(WS_WGLAOUT), M, D, D}; pg8::StaticOrder S; S.init(M, D, gridDim.x, blockIdx.x);
          pg8::EpiRes E{(const float*)nullptr, WSB(WS_XS), D, RSSP(2 * l), (LAS float*)(lds + XCH_OFF)};
          if (PHM & 32) pg8::gemm_phase<pg8::EpiRes, pg8::StaticOrder, true, true>(lds, g, S, E); }
        GRID_SYNC();
        { pg8::Gemm g{WSB(WS_XS), WSB(WS_WUP) + (size_t)l * NUP * D, M, NUP, D}; pg8::StaticOrder S; S.init(M, NUP, gridDim.x, blockIdx.x);
          pg8::EpiFfnUp E{WSB(WS_H), INF(16) + (size_t)l * 3 * FFD, INF(17) + (size_t)l * FFD, WSF(WS_ULAST), WSF(WS_UFIRST), WSF(WS_VFIRST), (LAS f32x4*)(lds + XCH_OFF), RSSP(2 * l)};
          if (PHM & 64) pg8::gemm_phase<pg8::EpiFfnUp, pg8::StaticOrder, true, true, true>(lds, g, S, E); }
        GRID_SYNC();
        { pg8::Gemm g{WSB(WS_H), WSB(WS_WDN) + (size_t)l * D * FFD, M, D, FFD}; pg8::StaticOrder S; S.init(M, D, gridDim.x, blockIdx.x);
          if (PHM & 256) {
          const float* cw = INF(16) + (size_t)l * 3 * FFD; const float* cb = INF(17) + (size_t)l * FFD;
          const float* ULAST = WSF(WS_ULAST); const float* UFIRST = WSF(WS_UFIRST); const float* VFIRST = WSF(WS_VFIRST); bf16* ACT = WSB(WS_H);
          pg8::Unit u;
          for (int i = 0; S.next(i, u); ++i) {
              if ((u.pm & 15) == 0) continue;
              for (int c4 = fresh_tid(); c4 < FFD / 4; c4 += NTHR) {
                  const int ch = 4 * c4;
                  const f32x4 uf0 = *(const f32x4*)(UFIRST + (size_t)(u.pm * 2) * FFD + ch), uf1 = *(const f32x4*)(UFIRST + (size_t)(u.pm * 2 + 1) * FFD + ch);
                  const f32x4 ul0 = *(const f32x4*)(ULAST + (size_t)((u.pm - 1) * 2) * FFD + ch), ul1 = *(const f32x4*)(ULAST + (size_t)((u.pm - 1) * 2 + 1) * FFD + ch);
                  const f32x4 vf0 = *(const f32x4*)(VFIRST + (size_t)(u.pm * 2) * FFD + ch), vf1 = *(const f32x4*)(VFIRST + (size_t)(u.pm * 2 + 1) * FFD + ch);
                  const f32x4 a0 = *(const f32x4*)(cw + ch), a1 = *(const f32x4*)(cw + FFD + ch), a2 = *(const f32x4*)(cw + 2 * FFD + ch), bb = *(const f32x4*)(cb + ch);
                  const f32x4 u0 = bb + a0 * ul0 + a1 * ul1 + a2 * uf0, u1 = bb + a0 * ul1 + a1 * uf0 + a2 * uf1;
                  const f32x2 g00 = pg8::gelu_pk((f32x2){u0[0], u0[1]}), g01 = pg8::gelu_pk((f32x2){u0[2], u0[3]}), g10 = pg8::gelu_pk((f32x2){u1[0], u1[1]}), g11 = pg8::gelu_pk((f32x2){u1[2], u1[3]});
                  *(v2u*)(ACT + (size_t)(u.pm * 256) * FFD + ch) = (v2u){pk2(g00.x * vf0[0], g00.y * vf0[1]), pk2(g01.x * vf0[2], g01.y * vf0[3])};
                  *(v2u*)(ACT + (size_t)(u.pm * 256 + 1) * FFD + ch) = (v2u){pk2(g10.x * vf1[0], g10.y * vf1[1]), pk2(g11.x * vf1[2], g11.y * vf1[3])};
              }
          }
          asm volatile("s_waitcnt vmcnt(0)" ::: "memory"); __syncthreads();
          }
          if (l == 0 || gridDim.x != 256) { pg8::EpiRes E{(const float*)nullptr, WSB(WS_XS), D, RSSP(2 * l + 1), (LAS float*)(lds + XCH_OFF)};
              pg8::gemm_phase<pg8::EpiRes, pg8::StaticOrder, true, true>(lds, g, S, E); }
          else { pg8::EpiResFinal E{WSB(WS_XS), XOUT(), D, RSSP(3), INF(19), (unsigned*)(GAS unsigned*)(karg(21) + 16384), (LAS float*)(lds + XCH_OFF)};
              pg8::gemm_phase<pg8::EpiResFinal, pg8::StaticOrder, true, true>(lds, g, S, E); } }
        if (l == 0) GRID_SYNC();
    }
    if (gridDim.x != 256) { GRID_SYNC(); WAVE_IDS(); final_norm_rows(WSB(WS_XS), XOUT(), INF(19), RSSP(3), gw, ngw, lane); }
}

extern "C" void kernel_launch(void* const* d_in, const int* in_sizes, int n_in, void* d_out, int out_size, void* d_ws, size_t ws_size, hipStream_t stream) {
    static int grid_blocks = 0;
    if (grid_blocks == 0) {
        if (n_in != 20 || out_size != M * D || ws_size < WS_END) { fprintf(stderr, "kernel_launch: unexpected shapes (n_in %d out %d ws %zu)\n", n_in, out_size, ws_size); grid_blocks = -1; return; }
        int dev = 0, cus = 0, per_cu = 0;
        hipGetDevice(&dev); hipDeviceGetAttribute(&cus, hipDeviceAttributeMultiprocessorCount, dev);
        if (hipFuncSetAttribute((const void*)fwd_megakernel, hipFuncAttributeMaxDynamicSharedMemorySize, LDS_BYTES) != hipSuccess) fprintf(stderr, "kernel_launch: hipFuncSetAttribute failed\n");
        if (hipOccupancyMaxActiveBlocksPerMultiprocessor(&per_cu, (const void*)fwd_megakernel, NTHR, LDS_BYTES) != hipSuccess || per_cu < 1) { fprintf(stderr, "kernel_launch: occupancy query says %d\n", per_cu); per_cu = 1; }
        (void)hipGetLastError();
        grid_blocks = cus * per_cu;
    }
    if (grid_blocks < 0) return;
    if (hipMemsetAsync(d_ws, 0, 65536, stream) != hipSuccess) { fprintf(stderr, "kernel_launch: memset failed\n"); return; }
    Args a{};
    for (int i = 0; i < 20; ++i) a.in[i] = (const float*)d_in[i];
    a.out = (float*)d_out; a.ws = (unsigned char*)d_ws;
    void* kargs[] = {&a};
    hipError_t e = hipLaunchCooperativeKernel((const void*)fwd_megakernel, dim3(grid_blocks), dim3(NTHR), kargs, LDS_BYTES, stream);
    if (e != hipSuccess) fprintf(stderr, "cooperative launch failed: %s (grid %d)\n", hipGetErrorString(e), grid_blocks);
}
```

```cpp
#include <hip/hip_runtime.h>
#include <hip/hip_cooperative_groups.h>
#include <cstdio>
#include <cstdint>
namespace cg = cooperative_groups;
__device__ __forceinline__ int fresh_tid() { int t = threadIdx.x; asm volatile("" : "+v"(t)); return t; }
namespace pg8 {
#define PG8_LAS __attribute__((address_space(3)))
typedef unsigned short bf16_t;
typedef short bf16x8 __attribute__((ext_vector_type(8)));
typedef float f32x4 __attribute__((ext_vector_type(4)));
typedef unsigned u32x4 __attribute__((ext_vector_type(4)));
constexpr int BM = 256, BK = 64, HALF = 128, HTB = HALF * BK * 2  , STAGE_BYTES = 8 * HTB, NXCD = 8, WGM = 8;

__host__ __device__ __forceinline__ int lds_byte(int r, int c) { const int st = (r >> 4) * 2 + (c >> 5), rr = r & 15, cc = c & 31, ob = rr * 64 + cc * 2; return st * 1024 + (ob ^ (((ob >> 9) & 1) << 5)); }
__host__ __device__ __forceinline__ void stage_rc(int b, int& R, int& C) { const int st = b / 1024, sb = b % 1024, swz = sb ^ (((sb >> 9) & 1) << 5); R = (st >> 1) * 16 + swz / 64; C = (st & 1) * 32 + (swz % 64) / 2; }
__host__ __device__ __forceinline__ int perm32(int rho) { const int n = rho >> 4, i = rho & 15; return 8 * (i >> 2) + 4 * n + (i & 3); }

struct Unit { int pm, pn; };
struct Gemm { const bf16_t* A; const bf16_t* Bt; int M, N, K; };

struct StaticOrder {
    int nM, nN, nwg, G, c;
    __host__ __device__ void init(int M, int N, int G_, int c_) { nM = M / BM; nN = N / BM; nwg = nM * nN; G = G_; c = c_; }
    __host__ __device__ bool next(int i, Unit& u) const {
        const long L = (long)i * G + c; if (L >= nwg) return false;
        int wgid = (int)L; { const int q = nwg / NXCD, r = nwg % NXCD, xcd = wgid % NXCD, off = wgid / NXCD; wgid = (xcd < r ? xcd * (q + 1) : r * (q + 1) + (xcd - r) * q) + off; }
        const int nig = WGM * nN, gid = wgid / nig, fm = gid * WGM, gsz = (nM - fm) < WGM ? (nM - fm) : WGM;
        u.pm = fm + ((wgid % nig) % gsz); u.pn = (wgid % nig) / gsz; return true;
    }
    __device__ __forceinline__ void a_ready(const Unit&) const {}
    __device__ __forceinline__ void done(const Unit&) const {}
};

typedef float f32x2c_t __attribute__((ext_vector_type(2))); typedef __bf16 bf16x2c_t __attribute__((ext_vector_type(2)));
__device__ __forceinline__ unsigned cvt_pk_bf16(float lo, float hi) { const f32x2c_t v = {lo, hi}; const bf16x2c_t b = __builtin_convertvector(v, bf16x2c_t); return __builtin_bit_cast(unsigned, b); }
typedef float f32x2 __attribute__((ext_vector_type(2)));
__device__ __forceinline__ f32x2 gelu_pk(f32x2 v) {
    const f32x2 av = __builtin_elementwise_abs(v), d = av * 0.2316418882f + 1.0f;
    f32x2 t; t.x = __builtin_amdgcn_rcpf(d.x); t.y = __builtin_amdgcn_rcpf(d.y);
    f32x2 q = t * 0.5307027145f + (-0.7265760135f); q = q * t + 0.7107068705f; q = q * t + (-0.142248368f); q = q * t + 0.127414796f; q = q * t;
    const f32x2 s = (v * v) * (-0.72134752044f);
    f32x2 e; e.x = __builtin_amdgcn_exp2f(s.x); e.y = __builtin_amdgcn_exp2f(s.y);
    const f32x2 m = av * (q * e);
    return __builtin_elementwise_max(v, (f32x2){0.f, 0.f}) - m;
}
}
namespace pg8 {
template <class Epi, class Sched, bool ALIGN_EPI = false, bool SP2 = false, bool APERM = false  >
__device__ __forceinline__ void gemm_phase(PG8_LAS unsigned char* lds, const Gemm g, const Sched& S, const Epi& E) {
    const int tid = fresh_tid(), wid = __builtin_amdgcn_readfirstlane(tid >> 6), lane = tid & 63, wr = wid >> 2, wc = wid & 3, fr = lane & 15, fq = lane >> 4;
    const int K = g.K, nt = K / BK;
    unsigned voffA[2], voffB[2];
#pragma unroll
    for (int i = 0; i < 2; ++i) { int R, C; stage_rc(tid * 16 + i * 8192, R, C); const int Rb = Epi::PERM ? ((R & ~31) + perm32(R & 31)) : R;
        const int Ra = APERM ? ((R & ~63) + 4 * (R & 15) + ((R >> 4) & 3)) : R;
        voffA[i] = (unsigned)(Ra * K + C) * 2u; voffB[i] = (unsigned)(Rb * K + C) * 2u; }
    const size_t kstep = (size_t)(BK * 2);
    const size_t hstep = (size_t)HALF * K * 2;
    const size_t tstep = 2 * hstep;
    const unsigned ldsw = (unsigned)wid * 1024u;
    const int aoff = lds_byte(wr * 64 + fr, fq * 8), boff = lds_byte(wc * 32 + fr, fq * 8);
#define PG8_SA(b, h) (((b) * 2 + (h)) * HTB)
#define PG8_SB(b, h) ((4 + (b) * 2 + (h)) * HTB)
#define PG8_STAGE(bufoff, gbase, voff) do { _Pragma("unroll") for (int _i = 0; _i < 2; ++_i) \
        __builtin_amdgcn_global_load_lds((const unsigned*)((const char*)(gbase) + (voff)[_i]), (PG8_LAS unsigned*)(lds + (bufoff) + ldsw + _i * 8192), 16, 0, 0); } while (0)
#define PG8_LDA(dst, b, h) do { _Pragma("unroll") for (int m = 0; m < 4; ++m) _Pragma("unroll") for (int k = 0; k < 2; ++k) dst[m][k] = *(const PG8_LAS bf16x8*)(lds + PG8_SA(b, h) + aoff + m * 2048 + k * 1024); } while (0)
#define PG8_LDB(dst, b, h) do { _Pragma("unroll") for (int n = 0; n < 2; ++n) _Pragma("unroll") for (int k = 0; k < 2; ++k) dst[n][k] = *(const PG8_LAS bf16x8*)(lds + PG8_SB(b, h) + boff + n * 2048 + k * 1024); } while (0)
#define PG8_MMA(ai, bj, At, Bt) do { __builtin_amdgcn_s_setprio(1); _Pragma("unroll") for (int m = 0; m < 4; ++m) _Pragma("unroll") for (int n = 0; n < 2; ++n) _Pragma("unroll") for (int k = 0; k < 2; ++k) \
        acc[ai][bj][m][n] = __builtin_amdgcn_mfma_f32_16x16x32_bf16(Bt[n][k], At[m][k], acc[ai][bj][m][n], 0, 0, 0); __builtin_amdgcn_s_setprio(0); } while (0)
#define PG8_WAIT_V(n) asm volatile("s_waitcnt vmcnt(" #n ")" ::: "memory")
#define PG8_WAIT_L(n) asm volatile("s_waitcnt lgkmcnt(" #n ")" ::: "memory")
#define PG8_BAR __builtin_amdgcn_s_barrier()
#define PG8_SCHED __builtin_amdgcn_sched_barrier(0)
    Unit cur, nxt; int ui = 0;
    if (!S.next(0, cur)) return;
    f32x4 acc[2][2][4][2];
#pragma unroll
    for (int a = 0; a < 2; ++a)
#pragma unroll
        for (int b = 0; b < 2; ++b)
#pragma unroll
            for (int m = 0; m < 4; ++m)
#pragma unroll
                for (int n = 0; n < 2; ++n) acc[a][b][m][n] = (f32x4){0.f, 0.f, 0.f, 0.f};
    bf16x8 At[4][2], B0[2][2], B1[2][2];
    const char* cA = (const char*)g.A + (size_t)cur.pm * tstep; const char* cB = (const char*)g.Bt + (size_t)cur.pn * tstep;
    S.a_ready(cur);
    if constexpr (SP2) {
        PG8_STAGE(PG8_SB(0, 0), cB, voffB); PG8_STAGE(PG8_SB(0, 1), cB + hstep, voffB); PG8_STAGE(PG8_SA(0, 0), cA, voffA); PG8_STAGE(PG8_SA(0, 1), cA + hstep, voffA);
        if (wr == 1) PG8_BAR;
        PG8_WAIT_V(2); PG8_BAR;
        PG8_STAGE(PG8_SB(1, 0), cB + kstep, voffB); PG8_STAGE(PG8_SA(1, 0), cA + kstep, voffA); PG8_STAGE(PG8_SB(1, 1), cB + hstep + kstep, voffB);
        PG8_WAIT_V(6); PG8_BAR;
    } else {
        PG8_STAGE(PG8_SB(0, 0), cB, voffB); PG8_STAGE(PG8_SA(0, 0), cA, voffA); PG8_STAGE(PG8_SB(0, 1), cB + hstep, voffB); PG8_STAGE(PG8_SA(0, 1), cA + hstep, voffA);
        if (wr == 1) PG8_BAR;
        PG8_WAIT_V(4); PG8_BAR;
        PG8_STAGE(PG8_SB(1, 0), cB + kstep, voffB); PG8_STAGE(PG8_SA(1, 0), cA + kstep, voffA); PG8_STAGE(PG8_SB(1, 1), cB + hstep + kstep, voffB);
        PG8_WAIT_V(6); PG8_BAR;
    }
    for (;;) {
        const bool has_next = S.next(ui + 1, nxt);
        const char* nA = has_next ? (const char*)g.A + (size_t)nxt.pm * tstep : cA; const char* nB = has_next ? (const char*)g.Bt + (size_t)nxt.pn * tstep : cB;
        for (int t = 0; t < nt; t += 2) {
            const bool last = (t == nt - 2);
            const char* a1 = cA + (size_t)(t + 1) * kstep;
            const char* a2 = last ? nA : cA + (size_t)(t + 2) * kstep; const char* b2 = last ? nB : cB + (size_t)(t + 2) * kstep;
            const char* a3 = a2 + kstep; const char* b3 = b2 + kstep;
            if (last && has_next) S.a_ready(nxt);
            if constexpr (SP2) {
            PG8_LDB(B0, 0, 0); PG8_LDB(B1, 0, 1); PG8_SCHED; PG8_LDA(At, 0, 0); PG8_STAGE(PG8_SA(1, 1), a1 + hstep, voffA);
            PG8_WAIT_V(8); PG8_WAIT_L(0); PG8_BAR; PG8_MMA(0, 0, At, B0); PG8_MMA(0, 1, At, B1); PG8_BAR; PG8_SCHED;
            PG8_LDA(At, 0, 1); PG8_STAGE(PG8_SB(0, 0), b2, voffB); PG8_STAGE(PG8_SB(0, 1), b2 + hstep, voffB); PG8_STAGE(PG8_SA(0, 0), a2, voffA);
            PG8_WAIT_V(8); PG8_WAIT_L(0); PG8_BAR; PG8_MMA(1, 0, At, B0); PG8_MMA(1, 1, At, B1); PG8_BAR; PG8_SCHED;
            PG8_LDB(B0, 1, 0); PG8_LDB(B1, 1, 1); PG8_SCHED; PG8_LDA(At, 1, 0); PG8_STAGE(PG8_SA(0, 1), a2 + hstep, voffA);
            PG8_WAIT_V(8); PG8_WAIT_L(0); PG8_BAR; PG8_MMA(0, 0, At, B0); PG8_MMA(0, 1, At, B1); PG8_BAR; PG8_SCHED;
            PG8_LDA(At, 1, 1); PG8_STAGE(PG8_SB(1, 0), b3, voffB); PG8_STAGE(PG8_SB(1, 1), b3 + hstep, voffB); PG8_STAGE(PG8_SA(1, 0), a3, voffA);
            PG8_WAIT_V(8); PG8_WAIT_L(0); PG8_BAR; PG8_MMA(1, 0, At, B0); PG8_MMA(1, 1, At, B1); PG8_BAR; PG8_SCHED;
            } else {
            PG8_LDB(B0, 0, 0); PG8_SCHED; PG8_LDA(At, 0, 0); PG8_STAGE(PG8_SA(1, 1), a1 + hstep, voffA);
            PG8_WAIT_L(8); PG8_BAR; PG8_WAIT_L(0); PG8_MMA(0, 0, At, B0); PG8_BAR; PG8_SCHED;
            PG8_LDB(B1, 0, 1); PG8_STAGE(PG8_SB(0, 0), b2, voffB);
            PG8_BAR; PG8_WAIT_L(0); PG8_MMA(0, 1, At, B1); PG8_BAR;
            PG8_LDA(At, 0, 1); PG8_STAGE(PG8_SA(0, 0), a2, voffA);
            PG8_BAR; PG8_WAIT_L(0); PG8_MMA(1, 0, At, B0); PG8_BAR; PG8_SCHED;
            PG8_STAGE(PG8_SB(0, 1), b2 + hstep, voffB);
            PG8_WAIT_V(6); PG8_BAR; PG8_MMA(1, 1, At, B1); PG8_BAR;
            PG8_LDB(B0, 1, 0); PG8_SCHED; PG8_LDA(At, 1, 0); PG8_STAGE(PG8_SA(0, 1), a2 + hstep, voffA);
            PG8_WAIT_L(8); PG8_BAR; PG8_WAIT_L(0); PG8_MMA(0, 0, At, B0); PG8_BAR; PG8_SCHED;
            PG8_LDB(B1, 1, 1); PG8_STAGE(PG8_SB(1, 0), b3, voffB);
            PG8_BAR; PG8_WAIT_L(0); PG8_MMA(0, 1, At, B1); PG8_BAR;
            PG8_LDA(At, 1, 1); PG8_STAGE(PG8_SA(1, 0), a3, voffA);
            PG8_BAR; PG8_WAIT_L(0); PG8_MMA(1, 0, At, B0); PG8_BAR; PG8_SCHED;
            PG8_STAGE(PG8_SB(1, 1), b3 + hstep, voffB);
            PG8_WAIT_V(6); PG8_BAR; PG8_MMA(1, 1, At, B1); PG8_BAR;
            }
        }
        if constexpr (ALIGN_EPI) { if (wr == 0) PG8_BAR; }
        if constexpr (!Epi::AFTER_DRAIN) { E(acc, cur, wr, wc, fr, fq); S.done(cur); }
        if (!has_next) break;
#pragma unroll
        for (int a = 0; a < 2; ++a)
#pragma unroll
            for (int b = 0; b < 2; ++b)
#pragma unroll
                for (int m = 0; m < 4; ++m)
#pragma unroll
                    for (int n = 0; n < 2; ++n) acc[a][b][m][n] = (f32x4){0.f, 0.f, 0.f, 0.f};
        cur = nxt; cA = nA; cB = nB; ++ui;
        if constexpr (ALIGN_EPI) { if (wr == 1) PG8_BAR; }
    }
    PG8_WAIT_V(0);
    if constexpr (!ALIGN_EPI) { if (wr == 0) PG8_BAR; }
    PG8_BAR;
    if constexpr (Epi::AFTER_DRAIN) { E.fused(acc, cur, wr, wc, fr, fq, lds, wid, lane); S.done(cur); }
#undef PG8_SA
#undef PG8_SB
#undef PG8_STAGE
#undef PG8_LDA
#undef PG8_LDB
#undef PG8_MMA
#undef PG8_WAIT_V
#undef PG8_WAIT_L
#undef PG8_BAR
#undef PG8_SCHED
}
}
namespace pg8 {
template <int CTRL> __device__ __forceinline__ float dppf(float v) { return __builtin_bit_cast(float, __builtin_amdgcn_update_dpp(0, __builtin_bit_cast(int, v), CTRL, 0xf, 0xf, false)); }

template <int CTRL> __device__ __forceinline__ float dppo(float old, float v) { return __builtin_bit_cast(float, __builtin_amdgcn_update_dpp(__builtin_bit_cast(int, old), __builtin_bit_cast(int, v), CTRL, 0xf, 0xf, false)); }
struct EpiBf16P {
    static constexpr bool PERM = true, AFTER_DRAIN = false;
    bf16_t* O; int ldc; const float* rss; PG8_LAS float* tab;
    __device__ __forceinline__ void operator()(const f32x4 (&acc)[2][2][4][2], const Unit& u, int wr, int wc, int fr, int fq) const {
        const int row0 = u.pm * BM + wr * 64 + fr, col0 = u.pn * BM + wc * 32 + 8 * fq;
        if (wr == 0) { const int trow = wc * 64 + fq * 16 + fr, r_ = u.pm * BM + trow;
            tab[trow] = __builtin_amdgcn_rsqf(((rss[r_] + rss[32768 + r_]) + (rss[65536 + r_] + rss[98304 + r_])) * (1.f / 1024.f) + 1e-6f); }
        asm volatile("s_waitcnt lgkmcnt(0)" ::: "memory"); __builtin_amdgcn_s_barrier(); asm volatile("" ::: "memory");
#pragma unroll
        for (int ai = 0; ai < 2; ++ai)
#pragma unroll
            for (int m = 0; m < 4; ++m) { const int row = row0 + ai * HALF + m * 16; bf16_t* rowp = O + (size_t)row * ldc + col0;
                const float rs = tab[wr * 64 + fr + ai * HALF + m * 16];
#pragma unroll
                for (int bj = 0; bj < 2; ++bj) { const f32x4 v0 = acc[ai][bj][m][0] * rs, v1 = acc[ai][bj][m][1] * rs;
                    u32x4 w; w.x = cvt_pk_bf16(v0[0], v0[1]); w.y = cvt_pk_bf16(v0[2], v0[3]); w.z = cvt_pk_bf16(v1[0], v1[1]); w.w = cvt_pk_bf16(v1[2], v1[3]);
                    *(u32x4*)(rowp + bj * HALF) = w; } }
    }
};
struct EpiRes {
    static constexpr bool PERM = true, AFTER_DRAIN = false;
    const float* base32; bf16_t* xs; int ldc; float* rssp; PG8_LAS float* red;
    __device__ __forceinline__ void operator()(const f32x4 (&acc)[2][2][4][2], const Unit& u, int wr, int wc, int fr, int fq) const {
        const int col0 = u.pn * BM + wc * 32 + 8 * fq;
        const size_t off0 = (size_t)(u.pm * BM + wr * 64 + fr) * ldc + col0;
#pragma unroll
        for (int ai = 0; ai < 2; ++ai) {
            u32x4 bv[4][2];
#pragma unroll
            for (int m = 0; m < 4; ++m)
#pragma unroll
                for (int bj = 0; bj < 2; ++bj) bv[m][bj] = *(const u32x4*)(xs + off0 + (size_t)(ai * HALF + m * 16) * ldc + bj * HALF);
#pragma unroll
            for (int m = 0; m < 4; ++m) { float ss = 0.f;
#pragma unroll
                for (int bj = 0; bj < 2; ++bj) { const size_t off = off0 + (size_t)(ai * HALF + m * 16) * ldc + bj * HALF; const u32x4 b = bv[m][bj];
                    f32x4 o0 = (f32x4){__builtin_bit_cast(float, b.x << 16), __builtin_bit_cast(float, b.x & 0xffff0000u), __builtin_bit_cast(float, b.y << 16), __builtin_bit_cast(float, b.y & 0xffff0000u)};
                    f32x4 o1 = (f32x4){__builtin_bit_cast(float, b.z << 16), __builtin_bit_cast(float, b.z & 0xffff0000u), __builtin_bit_cast(float, b.w << 16), __builtin_bit_cast(float, b.w & 0xffff0000u)};
                    o0 = o0 + acc[ai][bj][m][0]; o1 = o1 + acc[ai][bj][m][1];
                    ss += ((o0[0] * o0[0] + o0[1] * o0[1]) + (o0[2] * o0[2] + o0[3] * o0[3])) + ((o1[0] * o1[0] + o1[1] * o1[1]) + (o1[2] * o1[2] + o1[3] * o1[3]));
                    u32x4 w; w.x = cvt_pk_bf16(o0[0], o0[1]); w.y = cvt_pk_bf16(o0[2], o0[3]); w.z = cvt_pk_bf16(o1[0], o1[1]); w.w = cvt_pk_bf16(o1[2], o1[3]); *(u32x4*)(xs + off) = w; }
                ss += __shfl_xor(ss, 16); ss += __shfl_xor(ss, 32);
                if (fq == 0) red[wc * 256 + ai * HALF + wr * 64 + m * 16 + fr] = ss; }
            asm volatile("" ::: "memory"); }
        asm volatile("s_waitcnt lgkmcnt(0)" ::: "memory"); __builtin_amdgcn_s_barrier(); asm volatile("" ::: "memory");
        if (wr == 0) { const int row = wc * 64 + fq * 16 + fr;
            rssp[(size_t)u.pn * 32768 + u.pm * BM + row] = (red[row] + red[256 + row]) + (red[512 + row] + red[768 + row]); }
    }
};
struct EpiResFinal {
    static constexpr bool PERM = true, AFTER_DRAIN = false;
    const bf16_t* xs; float* out; int ldc; float* rssp; const float* g; unsigned* cnt; PG8_LAS float* red;
    __device__ __forceinline__ void operator()(const f32x4 (&acc_)[2][2][4][2], const Unit& u, int wr, int wc, int fr, int fq) const {
        f32x4 (&acc)[2][2][4][2] = const_cast<f32x4 (&)[2][2][4][2]>(acc_);
        const int col0 = u.pn * BM + wc * 32 + 8 * fq;
        const size_t off0 = (size_t)(u.pm * BM + wr * 64 + fr) * ldc + col0;
#pragma unroll
        for (int ai = 0; ai < 2; ++ai) {
          u32x4 bv[4][2];
#pragma unroll
          for (int m = 0; m < 4; ++m)
#pragma unroll
              for (int bj = 0; bj < 2; ++bj) bv[m][bj] = *(const u32x4*)(xs + off0 + (size_t)(ai * HALF + m * 16) * ldc + bj * HALF);
#pragma unroll
            for (int m = 0; m < 4; ++m) { float ss = 0.f;
#pragma unroll
                for (int bj = 0; bj < 2; ++bj) {
                    const u32x4 b = bv[m][bj];
                    const f32x4 o0 = (f32x4){__builtin_bit_cast(float, b.x << 16), __builtin_bit_cast(float, b.x & 0xffff0000u), __builtin_bit_cast(float, b.y << 16), __builtin_bit_cast(float, b.y & 0xffff0000u)} + acc[ai][bj][m][0];
                    const f32x4 o1 = (f32x4){__builtin_bit_cast(float, b.z << 16), __builtin_bit_cast(float, b.z & 0xffff0000u), __builtin_bit_cast(float, b.w << 16), __builtin_bit_cast(float, b.w & 0xffff0000u)} + acc[ai][bj][m][1];
                    ss += ((o0[0] * o0[0] + o0[1] * o0[1]) + (o0[2] * o0[2] + o0[3] * o0[3])) + ((o1[0] * o1[0] + o1[1] * o1[1]) + (o1[2] * o1[2] + o1[3] * o1[3]));
                    acc[ai][bj][m][0] = o0; acc[ai][bj][m][1] = o1; }
                ss += __shfl_xor(ss, 16); ss += __shfl_xor(ss, 32);
                if (fq == 0) red[wc * 256 + ai * HALF + wr * 64 + m * 16 + fr] = ss;
                asm volatile("" ::: "memory"); } }
        asm volatile("s_waitcnt lgkmcnt(0)" ::: "memory"); __builtin_amdgcn_s_barrier(); asm volatile("" ::: "memory");
        const int trow = wc * 64 + fq * 16 + fr;
        float* slot = rssp + (size_t)u.pm * BM + trow;
        if (wr == 0) __hip_atomic_store(slot + (size_t)u.pn * 32768, (red[trow] + red[256 + trow]) + (red[512 + trow] + red[768 + trow]), __ATOMIC_RELAXED, __HIP_MEMORY_SCOPE_AGENT);
        asm volatile("s_waitcnt vmcnt(0)" ::: "memory"); __builtin_amdgcn_s_barrier(); asm volatile("" ::: "memory");
        if (wr == 0 && wc == 0 && fq == 0 && fr == 0) {
            unsigned* c = cnt + 64 * u.pm; __hip_atomic_fetch_add(c, 1u, __ATOMIC_RELAXED, __HIP_MEMORY_SCOPE_AGENT);
            unsigned spins = 0; while (__hip_atomic_load(c, __ATOMIC_RELAXED, __HIP_MEMORY_SCOPE_AGENT) < 4u && ++spins < (1u << 22)) __builtin_amdgcn_s_sleep(1);
        }
        asm volatile("s_waitcnt vmcnt(0)" ::: "memory"); __builtin_amdgcn_s_barrier(); asm volatile("" ::: "memory");
        if (wr == 0) { const float t = (__hip_atomic_load(slot, __ATOMIC_RELAXED, __HIP_MEMORY_SCOPE_AGENT) + __hip_atomic_load(slot + 32768, __ATOMIC_RELAXED, __HIP_MEMORY_SCOPE_AGENT))
                                     + (__hip_atomic_load(slot + 65536, __ATOMIC_RELAXED, __HIP_MEMORY_SCOPE_AGENT) + __hip_atomic_load(slot + 98304, __ATOMIC_RELAXED, __HIP_MEMORY_SCOPE_AGENT));
            red[1024 + trow] = __builtin_amdgcn_rsqf(t * (1.f / 1024.f) + 1e-6f); }
        asm volatile("s_waitcnt lgkmcnt(0)" ::: "memory"); __builtin_amdgcn_s_barrier(); asm volatile("" ::: "memory");
#pragma unroll
        for (int bj = 0; bj < 2; ++bj) { const f32x4 g0 = *(const f32x4*)(g + col0 + bj * HALF), g1 = *(const f32x4*)(g + col0 + bj * HALF + 4);
#pragma unroll
            for (int ai = 0; ai < 2; ++ai)
#pragma unroll
                for (int m = 0; m < 4; ++m) { const float rs = red[1024 + ai * HALF + wr * 64 + m * 16 + fr]; const size_t off = off0 + (size_t)(ai * HALF + m * 16) * ldc + bj * HALF;
                    *(f32x4*)(out + off) = acc[ai][bj][m][0] * rs * g0; *(f32x4*)(out + off + 4) = acc[ai][bj][m][1] * rs * g1; } }
    }
};
struct EpiFfnUp {
    static constexpr bool PERM = true, AFTER_DRAIN = false;
    static constexpr int FFD = 2816;
    bf16_t* act; const float* cw; const float* cb; float* ulast; float* ufirst; float* vfirst; PG8_LAS f32x4* xch; const float* rss;
    __device__ __forceinline__ void operator()(const f32x4 (&acc)[2][2][4][2], const Unit& u, int wr, int wc, int fr, int fq) const {
        const int ch0 = u.pn * 128 + wc * 32 + 8 * fq;
        f32x4 w0[2], w1[2], w2[2], bb[2];
#pragma unroll
        for (int n = 0; n < 2; ++n) { w0[n] = *(const f32x4*)(cw + ch0 + 4 * n); w1[n] = *(const f32x4*)(cw + FFD + ch0 + 4 * n); w2[n] = *(const f32x4*)(cw + 2 * FFD + ch0 + 4 * n); bb[n] = *(const f32x4*)(cb + ch0 + 4 * n); }
        PG8_LAS float* tab = (PG8_LAS float*)(xch + 256);
#define RSTD4(r_) __builtin_amdgcn_rsqf(((rss[(r_)] + rss[32768 + (r_)]) + (rss[65536 + (r_)] + rss[98304 + (r_)])) * (1.f / 1024.f) + 1e-6f)
        if (wr == 0) { const int trow = wc * 64 + fq * 16 + fr; tab[trow] = RSTD4(u.pm * BM + trow); }
        const int rl = wr * 64 + 4 * fr;
        if (fr == 15) {
#pragma unroll
            for (int ai = 0; ai < 2; ++ai)
#pragma unroll
                for (int q = 0; q < 2; ++q) { PG8_LAS f32x4* s = xch + (((((ai * 2 + wr) * 4 + wc) * 4 + fq) * 2 + q) * 2); s[0] = acc[ai][0][2 + q][0]; s[1] = acc[ai][0][2 + q][1]; }
        }
        asm volatile("s_waitcnt lgkmcnt(0)" ::: "memory"); __builtin_amdgcn_s_barrier(); asm volatile("" ::: "memory");
        if (fr == 15 && wr == 1) {
#pragma unroll
            for (int q = 0; q < 2; ++q) { const float r3 = tab[rl + HALF + 2 + q]; float* g = ulast + (size_t)(u.pm * 2 + q) * FFD + ch0; *(f32x4*)g = acc[1][0][2 + q][0] * r3; *(f32x4*)(g + 4) = acc[1][0][2 + q][1] * r3; } }
        if (fr == 0 && wr == 0) {
#pragma unroll
            for (int q = 0; q < 2; ++q) { const float r0 = tab[q]; float* g = ufirst + (size_t)(u.pm * 2 + q) * FFD + ch0; *(f32x4*)g = acc[0][0][q][0] * r0; *(f32x4*)(g + 4) = acc[0][0][q][1] * r0;
                float* h = vfirst + (size_t)(u.pm * 2 + q) * FFD + ch0; *(f32x4*)h = acc[0][1][q][0] * r0; *(f32x4*)(h + 4) = acc[0][1][q][1] * r0; } }
#pragma unroll
        for (int ai = 0; ai < 2; ++ai) {
            f32x4 h2[2] = {(f32x4){0.f, 0.f, 0.f, 0.f}, (f32x4){0.f, 0.f, 0.f, 0.f}}, h3[2] = {h2[0], h2[0]};
            if (wr == 1 || ai == 1) { const int sai = (wr == 1) ? ai : 0, swr = (wr == 1) ? 0 : 1;
                const PG8_LAS f32x4* s = xch + ((((sai * 2 + swr) * 4 + wc) * 4 + fq) * 2) * 2; const float ra = tab[sai * HALF + swr * 64 + 62], rb = tab[sai * HALF + swr * 64 + 63];
                h2[0] = s[0] * ra; h2[1] = s[1] * ra; h3[0] = s[2] * rb; h3[1] = s[3] * rb; }
            const f32x4 rs4 = *(const PG8_LAS f32x4*)(tab + rl + ai * HALF);
            f32x4 us[4][2];
#pragma unroll
            for (int m = 0; m < 4; ++m) { us[m][0] = acc[ai][0][m][0] * rs4[m]; us[m][1] = acc[ai][0][m][1] * rs4[m]; }
            f32x4 s2[2], s3[2];
#pragma unroll
            for (int n = 0; n < 2; ++n)
#pragma unroll
                for (int e = 0; e < 4; ++e) { s2[n][e] = dppo<0x111>(h2[n][e], us[2][n][e]); s3[n][e] = dppo<0x111>(h3[n][e], us[3][n][e]); }
#pragma unroll
            for (int m = 0; m < 4; ++m) {
                f32x4 uc[2];
#pragma unroll
                for (int n = 0; n < 2; ++n) { const f32x4 um1 = (m == 0) ? s3[n] : us[m - 1][n], um2 = (m == 0) ? s2[n] : (m == 1) ? s3[n] : us[m - 2][n];
                    uc[n] = bb[n] + w0[n] * um2 + w1[n] * um1 + w2[n] * us[m][n]; }
                const f32x4 v0 = acc[ai][1][m][0] * rs4[m], v1 = acc[ai][1][m][1] * rs4[m];
                const f32x2 a = gelu_pk((f32x2){uc[0][0], uc[0][1]}), b = gelu_pk((f32x2){uc[0][2], uc[0][3]}), c = gelu_pk((f32x2){uc[1][0], uc[1][1]}), d = gelu_pk((f32x2){uc[1][2], uc[1][3]});
                u32x4 w; w.x = cvt_pk_bf16(a.x * v0[0], a.y * v0[1]); w.y = cvt_pk_bf16(b.x * v0[2], b.y * v0[3]); w.z = cvt_pk_bf16(c.x * v1[0], c.y * v1[1]); w.w = cvt_pk_bf16(d.x * v1[2], d.y * v1[3]);
                *(u32x4*)(act + (size_t)(u.pm * BM + ai * HALF + rl + m) * FFD + ch0) = w;
            }
        }
    }
};
}
#define LAS __attribute__((address_space(3)))
typedef unsigned short bf16;
typedef unsigned v4u __attribute__((ext_vector_type(4)));
typedef unsigned v2u __attribute__((ext_vector_type(2)));
typedef float f32x4 __attribute__((ext_vector_type(4)));
typedef float f32x2 __attribute__((ext_vector_type(2)));
typedef short bf16x8 __attribute__((ext_vector_type(8)));
constexpr int NWAVES = 8, NTHR = 512;
constexpr int BATCH = 8, SEQ = 4096, D = 1024, M = BATCH * SEQ, FFD = 2816, NUP = 2 * FFD, NAB = 2048, NGLA = 3584, GLA_SRC_N = 3088;
constexpr float EPS = 1e-6f;
constexpr size_t MiB = 1u << 20;
constexpr size_t WS_DEC = 1 * MiB, WS_ULAST = 2 * MiB, WS_UFIRST = 5 * MiB, WS_VFIRST = 8 * MiB;
constexpr size_t WS_WABIN = 12 * MiB, WS_WABOUT = 16 * MiB, WS_WGLAIN = 18 * MiB, WS_WGLAOUT = 25 * MiB, WS_WUP = 27 * MiB  , WS_WDN = 49 * MiB  ;
constexpr size_t WS_XN = 64 * MiB, WS_CAT = 128 * MiB, WS_H = 192 * MiB, WS_XS = 416 * MiB  , WS_END = 480 * MiB;
constexpr int LDS_BYTES = 147456, XCH_OFF = 131072;
#ifndef PHM
#define PHM 0xffff
#endif

__device__ __forceinline__ float bflo(unsigned w) { return __builtin_bit_cast(float, w << 16); }
__device__ __forceinline__ float bfhi(unsigned w) { return __builtin_bit_cast(float, w & 0xffff0000u); }
__device__ __forceinline__ unsigned pk2(float lo, float hi) { return pg8::cvt_pk_bf16(lo, hi); }
__device__ __forceinline__ float wave_sum(float v) {
#pragma unroll
    for (int o = 1; o < 64; o <<= 1) v += __shfl_xor(v, o);
    return v;
}
#define LDS_WAIT() asm volatile("s_waitcnt lgkmcnt(0)" ::: "memory")

__device__ __forceinline__ void transpose_item(const float* W, int ldw, int K, bf16* WT, int k0, int n0, int trow0, LAS float* scr, int lane, const float* g = nullptr) {
    float tv[32];
#pragma unroll
    for (int i = 0; i < 32; ++i) { const int kk = 2 * i + (lane >> 5); tv[i] = W[(size_t)(k0 + kk) * ldw + n0 + (lane & 31)]; }
#pragma unroll
    for (int i = 0; i < 32; ++i) { const int kk = 2 * i + (lane >> 5); scr[kk * 33 + (lane & 31)] = tv[i] * (g ? g[k0 + kk] : 1.f); }
    LDS_WAIT(); asm volatile("" ::: "memory");
    const int c = lane & 7;
#pragma unroll
    for (int j = 0; j < 4; ++j) { const int n = (lane >> 3) + 8 * j; const LAS float* s = scr + (8 * c) * 33 + n;
        v4u o; o.x = pk2(s[0 * 33], s[1 * 33]); o.y = pk2(s[2 * 33], s[3 * 33]); o.z = pk2(s[4 * 33], s[5 * 33]); o.w = pk2(s[6 * 33], s[7 * 33]);
        *(v4u*)(WT + (size_t)(trow0 + n) * K + k0 + 8 * c) = o; }
    LDS_WAIT(); asm volatile("" ::: "memory");
}

struct Args { const float* in[20]; float* out; unsigned char* ws; };

__device__ __forceinline__ void convert_rows(const float* X, bf16* XS, float* rss, int gw, int ngw, int lane) {
#pragma unroll 2
    for (int m = gw; m < M; m += ngw) {
        const f32x4* xr = (const f32x4*)(X + (size_t)m * D) + lane;
        f32x4 v[4]; float s = 0.f;
#pragma unroll
        for (int j = 0; j < 4; ++j) { v[j] = xr[64 * j]; s += (v[j].x * v[j].x + v[j].y * v[j].y) + (v[j].z * v[j].z + v[j].w * v[j].w); }
        s = wave_sum(s);
        unsigned long long* o8 = (unsigned long long*)(XS + (size_t)m * D) + lane;
#pragma unroll
        for (int j = 0; j < 4; ++j) o8[64 * j] = (unsigned long long)pk2(v[j].x, v[j].y) | ((unsigned long long)pk2(v[j].z, v[j].w) << 32);
        if (lane < 4) rss[(size_t)lane * 32768 + m] = lane == 0 ? s : 0.f;
    }
}
__device__ __forceinline__ void final_norm_rows(const bf16* XS, float* OUT, const float* g, const float* rss, int gw, int ngw, int lane) {
    f32x4 gv[4];
#pragma unroll
    for (int j = 0; j < 4; ++j) gv[j] = ((const f32x4*)g)[lane + 64 * j];
#pragma unroll 4
    for (int m = gw; m < M; m += ngw) {
        const v2u* xr = (const v2u*)(XS + (size_t)m * D) + lane; f32x4* orow = (f32x4*)(OUT + (size_t)m * D) + lane;
        const float rstd = rsqrtf(((rss[m] + rss[32768 + m]) + (rss[65536 + m] + rss[98304 + m])) * (1.f / D) + EPS);
#pragma unroll
        for (int j = 0; j < 4; ++j) { const v2u w = xr[64 * j]; orow[64 * j] = (f32x4){bflo(w.x), bfhi(w.x), bflo(w.y), bfhi(w.y)} * rstd * gv[j]; }
    }
}

__device__ __forceinline__ void unpack8(const v4u w, float (&f)[8]) {
    f[0] = bflo(w.x); f[1] = bfhi(w.x); f[2] = bflo(w.y); f[3] = bfhi(w.y); f[4] = bflo(w.z); f[5] = bfhi(w.z); f[6] = bflo(w.w); f[7] = bfhi(w.w);
}
__device__ __forceinline__ void ab_mixer(const bf16* H, bf16* CAT, const float* pool_b, const float* pool_scale, const float* scw, const float* scb, int wg, int nwg, int tid) {
    const int cv = tid & 127, sub = tid >> 7;
    float pa[8], pb[8], pc[8], pd[8];
    if (cv < 64) {
#pragma unroll
        for (int e = 0; e < 8; ++e) { pa[e] = pool_b[cv * 8 + e]; pb[e] = pool_scale[cv * 8 + e]; pc[e] = 0.f; pd[e] = 0.f; }
    } else {
        const int c = (cv - 64) * 8;
#pragma unroll
        for (int e = 0; e < 8; ++e) { pa[e] = scw[c + e]; pb[e] = scw[512 + c + e]; pc[e] = scw[1024 + c + e]; pd[e] = scb[c + e]; }
    }
    for (int chunk = wg * 4 + sub; chunk < M / 32; chunk += nwg * 4) {
        const int r0 = chunk * 32, t0 = r0 & (SEQ - 1);
        bf16* outp = CAT + (size_t)r0 * D + cv * 8;
        if (cv < 64) {
            const int win = 2 << (cv >> 4);
            const bf16* p = H + (size_t)r0 * NAB + cv * 8;
            float s[8], f[8];
#pragma unroll
            for (int e = 0; e < 8; ++e) s[e] = 0.f;
            if (t0 > 0) for (int i = 1; i < win; ++i) { unpack8(*(const v4u*)(p - (size_t)i * NAB), f);
#pragma unroll
                for (int e = 0; e < 8; ++e) s[e] += f[e]; }
#pragma unroll 4
            for (int jr = 0; jr < 32; ++jr) {
                const int t = t0 + jr; float cur[8], y[8];
                unpack8(*(const v4u*)(p + (size_t)jr * NAB), cur);
                if (jr >= 1 && t >= win) { unpack8(*(const v4u*)(p + (ptrdiff_t)(jr - win) * NAB), f);
#pragma unroll
                    for (int e = 0; e < 8; ++e) s[e] -= f[e]; }
#pragma unroll
                for (int e = 0; e < 8; ++e) s[e] += cur[e];
                const float inv = 1.f / (float)((t + 1) < win ? (t + 1) : win);
#pragma unroll
                for (int e = 0; e < 8; ++e) y[e] = (s[e] * inv - cur[e] + pa[e]) * pb[e];
                v4u o; o.x = pk2(y[0], y[1]); o.y = pk2(y[2], y[3]); o.z = pk2(y[4], y[5]); o.w = pk2(y[6], y[7]);
                *(v4u*)(outp + (size_t)jr * D) = o;
            }
        } else {
            const bf16* p = H + (size_t)r0 * NAB + (cv - 64) * 8;
            float p1[8], p2[8], a[8], b[8];
#pragma unroll
            for (int e = 0; e < 8; ++e) { p1[e] = 0.f; p2[e] = 0.f; }
            if (t0 > 0) { unpack8(*(const v4u*)(p - NAB + 1024), a); unpack8(*(const v4u*)(p - NAB + 1536), b);
#pragma unroll
                for (int e = 0; e < 8; ++e) p1[e] = a[e] * b[e];
                unpack8(*(const v4u*)(p - 2 * NAB + 1024), a); unpack8(*(const v4u*)(p - 2 * NAB + 1536), b);
#pragma unroll
                for (int e = 0; e < 8; ++e) p2[e] = a[e] * b[e]; }
#pragma unroll 4
            for (int jr = 0; jr < 32; ++jr) {
                float sb[8], y[8];
                unpack8(*(const v4u*)(p + (size_t)jr * NAB + 512), sb); unpack8(*(const v4u*)(p + (size_t)jr * NAB + 1024), a); unpack8(*(const v4u*)(p + (size_t)jr * NAB + 1536), b);
#pragma unroll
                for (int e = 0; e < 8; ++e) { const float pr = a[e] * b[e]; y[e] = sb[e] * (pd[e] + pc[e] * pr + pb[e] * p1[e] + pa[e] * p2[e]); p2[e] = p1[e]; p1[e] = pr; }
                v4u o; o.x = pk2(y[0], y[1]); o.y = pk2(y[2], y[3]); o.z = pk2(y[4], y[5]); o.w = pk2(y[6], y[7]);
                *(v4u*)(outp + (size_t)jr * D) = o;
            }
        }
    }
}

__device__ __forceinline__ float gate_log(float z) { return (fminf(z, 0.f) - __logf(1.f + __expf(-fabsf(z)))) * (1.f / 16.f); }
__device__ __forceinline__ void gla_prep(bf16* H, bf16* KDT, float* DEC, const float* b_g, int wg, int nwg, int tid) {
    const int half = tid >> 8, cp = tid & 255, c = 2 * cp;
    const float bg0 = b_g[c], bg1 = b_g[c + 1];
    const float QS = 0.08838834764831845f;
    for (int it = wg * 2 + half; it < BATCH * 64; it += nwg * 2) {
        bf16* base = H + (size_t)it * 64 * NGLA + c;
        unsigned cg[8], cq[8], ck[8], ng[8], nq[8], nk[8];
#pragma unroll
        for (int m = 0; m < 8; ++m) { const bf16* rp = base + (size_t)m * NGLA; cg[m] = *(const unsigned*)(rp + 3072); cq[m] = *(const unsigned*)rp; ck[m] = *(const unsigned*)(rp + 512); }
        float c0 = 0.f, c1 = 0.f;
        for (int g = 0; g < 8; ++g) {
            bf16* gb = base + (size_t)(g * 8) * NGLA;
            if (g < 7) {
#pragma unroll
                for (int m = 0; m < 8; ++m) { const bf16* rp = gb + (size_t)(8 + m) * NGLA; ng[m] = *(const unsigned*)(rp + 3072); nq[m] = *(const unsigned*)rp; nk[m] = *(const unsigned*)(rp + 512); }
            }
#pragma unroll
            for (int m = 0; m < 8; ++m) { bf16* rp = gb + (size_t)m * NGLA;
                c0 += gate_log(bflo(cg[m]) + bg0); c1 += gate_log(bfhi(cg[m]) + bg1);
                const float d0 = bflo(ck[m]) * __expf(-c0), d1 = bfhi(ck[m]) * __expf(-c1);
                *(unsigned*)rp = pk2(bflo(cq[m]) * QS * __expf(c0), bfhi(cq[m]) * QS * __expf(c1));
                *(unsigned*)(rp + 512) = pk2(d0, d1);
            }
#pragma unroll
            for (int m = 0; m < 8; ++m) { cg[m] = ng[m]; cq[m] = nq[m]; ck[m] = nk[m]; }
        }
        *(f32x2*)(DEC + (size_t)it * 512 + c) = (f32x2){__expf(c0), __expf(c1)};
    }
}

constexpr int QP = 136, VP = 40;
constexpr int L_Q = 0, L_K = L_Q + 64 * QP * 2, L_V = L_K + 64 * QP * 2, L_ST = L_V + 64 * VP * 2, L_SCAN_END = L_ST + 2 * 32 * QP * 2;
static_assert(L_SCAN_END <= XCH_OFF, "scan LDS");
typedef short v4i16_t __attribute__((ext_vector_type(4)));
__device__ __forceinline__ bf16x8 ldfrag(const LAS unsigned char* p) { return *(const LAS bf16x8*)p; }
__device__ __forceinline__ v4i16_t ldtr(const LAS unsigned char* img, int pitch, int row0, int col0, int l16) {
    return __builtin_amdgcn_ds_read_tr16_b64_v4i16((LAS v4i16_t*)(img + (row0 + (l16 >> 2)) * pitch + (col0 + 4 * (l16 & 3)) * 2)); }
__device__ __forceinline__ bf16x8 cat8(v4i16_t a, v4i16_t b) { return __builtin_shufflevector(a, b, 0, 1, 2, 3, 4, 5, 6, 7); }
__device__ __forceinline__ void gla_scan(LAS unsigned char* lds, const bf16* H, const float* DEC, bf16* O, int wg, int nwg, int tid) {
    const int wave = __builtin_amdgcn_readfirstlane(tid >> 6), lane = tid & 63, l16 = lane & 15, lq = lane >> 4;
    for (int item = wg; item < 256; item += nwg) {
        const int x = item & 7, j = item >> 3, bh = x * 4 + (j >> 3), vs = j & 7, b = bh >> 2, h = bh & 3;
        __syncthreads();
        for (int i = tid; i < 2 * 32 * QP / 2; i += NTHR) ((LAS unsigned*)(lds + L_ST))[i] = 0u;
        f32x4 S[2] = {(f32x4){0.f, 0.f, 0.f, 0.f}, (f32x4){0.f, 0.f, 0.f, 0.f}};
        const int r0 = tid >> 4, c16 = tid & 15, mv = (tid & 255) >> 2, c8v = tid & 3;
        const bf16* pq = H + ((size_t)b * SEQ + r0) * NGLA + h * 128 + c16 * 8;
        const bf16* pv = H + ((size_t)b * SEQ + mv) * NGLA + 1024 + h * 256 + vs * 32 + c8v * 8;
        const float* pdec = DEC + ((size_t)(b * 64)) * 512 + h * 128 + 16 * wave + 4 * lq;
        v4u rq0 = *(const v4u*)pq, rq1 = *(const v4u*)(pq + (size_t)32 * NGLA), rk0 = *(const v4u*)(pq + 512), rk1 = *(const v4u*)(pq + (size_t)32 * NGLA + 512);
        v4u rv = *(const v4u*)pv;
        f32x4 rdec = *(const f32x4*)pdec;
        for (int n = 0; n < 64; ++n) {
            const size_t row0 = (size_t)b * SEQ + n * 64;
            *(LAS v4u*)(lds + L_Q + (r0 * QP + c16 * 8) * 2) = rq0; *(LAS v4u*)(lds + L_Q + ((r0 + 32) * QP + c16 * 8) * 2) = rq1;
            *(LAS v4u*)(lds + L_K + (r0 * QP + c16 * 8) * 2) = rk0; *(LAS v4u*)(lds + L_K + ((r0 + 32) * QP + c16 * 8) * 2) = rk1;
            if (tid < 256) *(LAS v4u*)(lds + L_V + (mv * VP + c8v * 8) * 2) = rv;
            const f32x4 dec = rdec;
            __syncthreads();
            if (n + 1 < 64) {
                pq += (size_t)64 * NGLA; pv += (size_t)64 * NGLA; pdec += 512;
                rq0 = *(const v4u*)pq; rq1 = *(const v4u*)(pq + (size_t)32 * NGLA); rk0 = *(const v4u*)(pq + 512); rk1 = *(const v4u*)(pq + (size_t)32 * NGLA + 512);
                rv = *(const v4u*)pv; rdec = *(const f32x4*)pdec;
            }
            { const int qi = wave >> 1, jv = wave & 1; f32x4 o = (f32x4){0.f, 0.f, 0.f, 0.f};
#pragma unroll
              for (int t = 0; t < 2; ++t) if (2 * t <= qi) {
                  f32x4 a0 = (f32x4){0.f, 0.f, 0.f, 0.f}, a1 = a0;
#pragma unroll
                  for (int kk = 0; kk < 4; ++kk) a0 = __builtin_amdgcn_mfma_f32_16x16x32_bf16(ldfrag(lds + L_K + ((32 * t + l16) * QP + kk * 32 + lq * 8) * 2), ldfrag(lds + L_Q + ((16 * qi + l16) * QP + kk * 32 + lq * 8) * 2), a0, 0, 0, 0);
                  if (2 * t == qi) {
#pragma unroll
                      for (int ii = 0; ii < 4; ++ii) if (4 * lq + ii > l16) a0[ii] = 0.f; }
                  if (2 * t + 1 <= qi) {
#pragma unroll
                      for (int kk = 0; kk < 4; ++kk) a1 = __builtin_amdgcn_mfma_f32_16x16x32_bf16(ldfrag(lds + L_K + ((32 * t + 16 + l16) * QP + kk * 32 + lq * 8) * 2), ldfrag(lds + L_Q + ((16 * qi + l16) * QP + kk * 32 + lq * 8) * 2), a1, 0, 0, 0);
                      if (2 * t + 1 == qi) {
#pragma unroll
                          for (int ii = 0; ii < 4; ++ii) if (4 * lq + ii > l16) a1[ii] = 0.f; } }
                  const v4u bw = (v4u){pk2(a0[0], a0[1]), pk2(a0[2], a0[3]), pk2(a1[0], a1[1]), pk2(a1[2], a1[3])};
                  const bf16x8 aw = cat8(ldtr(lds + L_V, VP * 2, 32 * t + 4 * lq, 16 * jv, l16), ldtr(lds + L_V, VP * 2, 32 * t + 16 + 4 * lq, 16 * jv, l16));
                  o = __builtin_amdgcn_mfma_f32_16x16x32_bf16(aw, __builtin_bit_cast(bf16x8, bw), o, 0, 0, 0); }
#pragma unroll
              for (int kk = 0; kk < 4; ++kk) o = __builtin_amdgcn_mfma_f32_16x16x32_bf16(ldfrag(lds + L_ST + ((n & 1) * 32 * QP + (16 * jv + l16) * QP + kk * 32 + lq * 8) * 2), ldfrag(lds + L_Q + ((16 * qi + l16) * QP + kk * 32 + lq * 8) * 2), o, 0, 0, 0);
              *(v2u*)(O + (row0 + 16 * qi + l16) * D + h * 256 + vs * 32 + 16 * jv + 4 * lq) = (v2u){pk2(o[0], o[1]), pk2(o[2], o[3])}; }
#pragma unroll
            for (int kk = 0; kk < 2; ++kk) {
                const bf16x8 ka = cat8(ldtr(lds + L_K, QP * 2, 32 * kk + 8 * lq, 16 * wave, l16), ldtr(lds + L_K, QP * 2, 32 * kk + 8 * lq + 4, 16 * wave, l16));
#pragma unroll
                for (int jv = 0; jv < 2; ++jv) { const bf16x8 vb = cat8(ldtr(lds + L_V, VP * 2, 32 * kk + 8 * lq, 16 * jv, l16), ldtr(lds + L_V, VP * 2, 32 * kk + 8 * lq + 4, 16 * jv, l16));
                    S[jv] = __builtin_amdgcn_mfma_f32_16x16x32_bf16(ka, vb, S[jv], 0, 0, 0); } }
#pragma unroll
            for (int jv = 0; jv < 2; ++jv) { S[jv] = S[jv] * dec;
                *(LAS v2u*)(lds + L_ST + (((n + 1) & 1) * 32 * QP + (16 * jv + l16) * QP + 16 * wave + 4 * lq) * 2) = (v2u){pk2(S[jv][0], S[jv][1]), pk2(S[jv][2], S[jv][3])}; }
            __syncthreads();
        }
    }
}
__device__ __forceinline__ void gla_post(const bf16* O, const bf16* H, bf16* CAT, const float* gnorm, int gw, int ngw, int lane) {
    const int hs = lane >> 5, cl = (lane & 31) * 8;
    float gn[8];
#pragma unroll
    for (int e = 0; e < 8; ++e) gn[e] = gnorm[cl + e];
#pragma unroll 2
    for (int m = gw; m < M; m += ngw) {
        v4u ow[2], rw[2];
#pragma unroll
        for (int p = 0; p < 2; ++p) { ow[p] = *(const v4u*)(O + (size_t)m * D + (hs + 2 * p) * 256 + cl); rw[p] = *(const v4u*)(H + (size_t)m * NGLA + 2048 + (hs + 2 * p) * 256 + cl); }
#pragma unroll
        for (int p = 0; p < 2; ++p) { float o[8], r[8], y[8]; unpack8(ow[p], o); unpack8(rw[p], r);
            float ss = 0.f;
#pragma unroll
            for (int e = 0; e < 8; ++e) ss += o[e] * o[e];
#pragma unroll
            for (int sh = 1; sh < 32; sh <<= 1) ss += __shfl_xor(ss, sh);
            const float rs = rsqrtf(ss * (1.f / 256.f) + EPS);
#pragma unroll
            for (int e = 0; e < 8; ++e) y[e] = o[e] * rs * gn[e] * (r[e] / (1.f + __expf(-r[e])));
            *(v4u*)(CAT + (size_t)m * D + (hs + 2 * p) * 256 + cl) = (v4u){pk2(y[0], y[1]), pk2(y[2], y[3]), pk2(y[4], y[5]), pk2(y[6], y[7])}; }
    }
}

#define XB_TMO      128
#define XB_XCNT(j)  (256  + 64 * (j))
#define XB_XSUB(j)  (1280 + 64 * (j))
#define XB_XGEN(j)  (2304 + 64 * (j))
#define XB_TOP      3328
#define XB_TOPGEN   3392
#define XCD_BAR_WORDS 3456
#define XB_SPIN_CAP (1u << 18)

__device__ __forceinline__ unsigned xb_ld(unsigned* p)              { return __hip_atomic_load(p, __ATOMIC_RELAXED, __HIP_MEMORY_SCOPE_AGENT); }
__device__ __forceinline__ unsigned xb_add(unsigned* p, unsigned v) { return __hip_atomic_fetch_add(p, v, __ATOMIC_RELAXED, __HIP_MEMORY_SCOPE_AGENT); }
__device__ __forceinline__ unsigned xb_xcc_id() { return (unsigned)__builtin_amdgcn_s_getreg((3 << 11) | 20) & 0xFu; }
#define XB_SPIN(cond, bar) do { unsigned _sp = 0; while (cond) { __builtin_amdgcn_s_sleep(1); \
    if ((++_sp & 255u) == 0u) { if (xb_ld(&(bar)[XB_TMO])) break; if (_sp > XB_SPIN_CAP) { atomicAdd(&(bar)[XB_TMO], 1u); break; } } } } while (0)

struct XcdBarrier {
    unsigned* bar; unsigned x;
    volatile LAS unsigned* st;
};

__device__ __forceinline__ XcdBarrier xcd_barrier_post(unsigned* bar, volatile LAS unsigned* st) {
    XcdBarrier b; b.bar = bar; b.x = xb_xcc_id(); b.st = st;
    if (threadIdx.x == 0) (void)xb_add(&bar[XB_XCNT(b.x)], 1u);
    return b;
}
__device__ __forceinline__ void xcd_barrier_complete(unsigned* bar, unsigned x, unsigned& nloc, unsigned& nx) {
    const unsigned G = gridDim.x * gridDim.y * gridDim.z;
    unsigned sum, cnt, mine, sp = 0u;
    for (;;) {
        sum = 0u; cnt = 0u; mine = 0u;
#pragma unroll
        for (unsigned j = 0; j < 16; ++j) { const unsigned c = xb_ld(&bar[XB_XCNT(j)]); sum += c; cnt += (c > 0u) ? 1u : 0u; mine = (j == x) ? c : mine; }
        if (sum == G) break;
        __builtin_amdgcn_s_sleep(1);
        if ((++sp & 255u) == 0u) { if (xb_ld(&bar[XB_TMO])) break; if (sp > XB_SPIN_CAP) { atomicAdd(&bar[XB_TMO], 1u); break; } }
    }
    nloc = mine > 0u ? mine : 1u; nx = cnt > 0u ? cnt : 1u;
}

__device__ __forceinline__ void xcd_barrier(const XcdBarrier& b) {
    asm volatile("s_waitcnt vmcnt(0)" ::: "memory");
    __syncthreads();
    if (threadIdx.x == 0) {
        unsigned* bar = b.bar;
        __builtin_amdgcn_s_waitcnt(0);
        unsigned nloc = b.st[0], nx = b.st[1];
        if (nloc == 0u) { xcd_barrier_complete(bar, b.x, nloc, nx); b.st[0] = nloc; b.st[1] = nx; }
        const unsigned old = xb_add(&bar[XB_XSUB(b.x)], 1u);
        const unsigned gen = old / nloc;
        if (old + 1u == (gen + 1u) * nloc) {
            __builtin_amdgcn_fence(__ATOMIC_RELEASE, "agent");
            asm volatile("s_waitcnt vmcnt(0)" ::: "memory");
            const unsigned og = xb_add(&bar[XB_TOP], 1u);
            const unsigned tg = og / nx;
            if (og + 1u == (tg + 1u) * nx) xb_add(&bar[XB_TOPGEN], 1u);
            else XB_SPIN(xb_ld(&bar[XB_TOPGEN]) == tg, bar);
            __builtin_amdgcn_fence(__ATOMIC_ACQUIRE, "agent");
            xb_add(&bar[XB_XGEN(b.x)], 1u);
            asm volatile("s_waitcnt vmcnt(0)" ::: "memory");
        } else {
            XB_SPIN(xb_ld(&bar[XB_XGEN(b.x)]) == gen, bar);
            __builtin_amdgcn_fence(__ATOMIC_ACQUIRE, "agent");
            asm volatile("s_waitcnt vmcnt(0)" ::: "memory");
        }
    }
    __syncthreads();
}

#define GRID_SYNC() do { XcdBarrier b_; b_.bar = (unsigned*)(GAS unsigned*)karg(21); b_.x = xb_xcc_id(); b_.st = (volatile LAS unsigned*)(lds + MISC_OFF); xcd_barrier(b_); } while (0)
constexpr int MISC_OFF = XCH_OFF + 8192;
#define GAS __attribute__((address_space(1)))
typedef const __attribute__((address_space(4))) unsigned long long* kaptr_t;
__device__ __forceinline__ unsigned long long karg(int k) { kaptr_t p = (kaptr_t)__builtin_amdgcn_kernarg_segment_ptr(); asm volatile("" : "+s"(p)); return p[k]; }
#define INF(k) ((const float*)(const GAS float*)karg(k))
#define XOUT() ((float*)(GAS float*)karg(20))
#define WSB(off) ((bf16*)(GAS bf16*)(karg(21) + (off)))
#define WSF(off) ((float*)(GAS float*)(karg(21) + (off)))
#define RSSP(i) WSF(60 * MiB + (size_t)(i) * 524288)
__global__ void __launch_bounds__(NTHR, 2) fwd_megakernel(Args args) {
    extern __shared__ __attribute__((aligned(16))) unsigned char lds_raw[];
    cg::grid_group grid = cg::this_grid();
    LAS unsigned char* lds = (LAS unsigned char*)lds_raw;
    { const int tid = threadIdx.x; if (tid < 2) ((LAS unsigned*)(lds + MISC_OFF))[tid] = 0u; }
    __syncthreads();
    grid.sync();
    (void)xcd_barrier_post((unsigned*)(GAS unsigned*)karg(21), (volatile LAS unsigned*)(lds + MISC_OFF));
    (void)args;
#define WAVE_IDS() const int tid_ = fresh_tid(), lane = tid_ & 63, wave = __builtin_amdgcn_readfirstlane(tid_ >> 6), G = gridDim.x, wg = blockIdx.x, gw = wg * NWAVES + wave, ngw = G * NWAVES

    {
        WAVE_IDS();
        LAS float* scr = (LAS float*)(lds + wave * 16384);
        constexpr int I_ABIN = 16 * 48, I_ABOUT = 16 * 32, I_GLAIN = 16 * 96, I_GLAOUT = 16 * 32, I_UP = 16 * 176, I_DN = 44 * 32;
        constexpr int NITEMS = I_ABIN + I_ABOUT + I_GLAIN + I_GLAOUT + 2 * I_UP + 2 * I_DN;
        for (int it = gw; it < NITEMS; it += ngw) {
            int r = it;
            if (r < I_ABIN) { const int kb = r / 48, nb = r % 48; transpose_item(INF(3), NAB, D, WSB(WS_WABIN), kb * 64, 512 + nb * 32, 512 + nb * 32, scr, lane, INF(1)); continue; } r -= I_ABIN;
            if (r < I_ABOUT) { const int kb = r / 32, nb = r % 32; transpose_item(INF(9), D, D, WSB(WS_WABOUT), kb * 64, nb * 32, nb * 32, scr, lane); continue; } r -= I_ABOUT;
            if (r < I_GLAIN) { const int kb = r / 96, nb = r % 96; transpose_item(INF(10), GLA_SRC_N, D, WSB(WS_WGLAIN), kb * 64, nb * 32, nb * 32, scr, lane, INF(1) + D); continue; } r -= I_GLAIN;
            if (r < I_GLAOUT) { const int kb = r / 32, nb = r % 32; transpose_item(INF(14), D, D, WSB(WS_WGLAOUT), kb * 64, nb * 32, nb * 32, scr, lane); continue; } r -= I_GLAOUT;
            if (r < 2 * I_UP) { const int l = r / I_UP, q = r % I_UP, kb = q / 176, nb = q % 176, n0 = nb * 32, isv = n0 >= FFD, ch = isv ? n0 - FFD : n0;
                transpose_item(INF(15) + (size_t)l * D * NUP, NUP, D, WSB(WS_WUP) + (size_t)l * NUP * D, kb * 64, n0, (ch >> 7) * 256 + isv * 128 + (ch & 127), scr, lane, INF(2) + (size_t)l * D); continue; } r -= 2 * I_UP;
            { const int l = r / I_DN, q = r % I_DN, kb = q / 32, nb = q % 32;
                transpose_item(INF(18) + (size_t)l * FFD * D, D, FFD, WSB(WS_WDN) + (size_t)l * D * FFD, kb * 64, nb * 32, nb * 32, scr, lane); }
        }
        { const float* abin = INF(3); const float* poolw = INF(4); const float* glain = INF(10); const float* wg2 = INF(11); const float* mn1 = INF(1) + D; const float* mn0 = INF(1); bf16* W_ABIN = WSB(WS_WABIN); bf16* W_GLAIN = WSB(WS_WGLAIN);
        for (int idx = wg * NTHR + tid_; idx < 256 * 512; idx += G * NTHR) {
            const int k4 = idx >> 9, n = idx & 511, g = n >> 7, nn = n & 127;
            const float* wi = abin + (size_t)(4 * k4) * NAB + g * 128; const float* pw = poolw + (size_t)g * 128 * 128 + nn;
            float s0 = 0.f, s1 = 0.f, s2 = 0.f, s3 = 0.f;
#pragma unroll 8
            for (int c = 0; c < 128; ++c) { const float w = pw[c * 128]; s0 += wi[c] * w; s1 += wi[NAB + c] * w; s2 += wi[2 * NAB + c] * w; s3 += wi[3 * NAB + c] * w; }
            { const f32x4 m0 = *(const f32x4*)(mn0 + 4 * k4); *(v2u*)(W_ABIN + (size_t)n * D + 4 * k4) = (v2u){pk2(s0 * m0[0], s1 * m0[1]), pk2(s2 * m0[2], s3 * m0[3])}; }
            const float* gi = glain + (size_t)(4 * k4) * GLA_SRC_N + 3072; const float* g2 = wg2 + n;
            float t0 = 0.f, t1 = 0.f, t2 = 0.f, t3 = 0.f;
#pragma unroll
            for (int r = 0; r < 16; ++r) { const float w = g2[r * 512]; t0 += gi[r] * w; t1 += gi[GLA_SRC_N + r] * w; t2 += gi[2 * GLA_SRC_N + r] * w; t3 += gi[3 * GLA_SRC_N + r] * w; }
            const f32x4 mg = *(const f32x4*)(mn1 + 4 * k4);
            *(v2u*)(W_GLAIN + (size_t)(3072 + n) * D + 4 * k4) = (v2u){pk2(t0 * mg[0], t1 * mg[1]), pk2(t2 * mg[2], t3 * mg[3])};
        } }
        convert_rows(INF(0), WSB(WS_XS), RSSP(4), gw, ngw, lane);
    }
    GRID_SYNC();

    for (int l = 0; l < 2; ++l) {
        { const int N = (l == 0) ? NAB : NGLA;
          pg8::Gemm g{WSB(WS_XS), (l == 0) ? WSB(WS_WABIN) : WSB(WS_WGLAIN), M, N, D}; pg8::StaticOrder S; S.init(M, N, gridDim.x, blockIdx.x);
          pg8::EpiBf16P E{WSB(WS_H), N, (l == 0) ? (const float*)RSSP(4) : (const float*)RSSP(1), (LAS float*)(lds + XCH_OFF)};
          if (PHM & 1) pg8::gemm_phase<pg8::EpiBf16P, pg8::StaticOrder, true, true>(lds, g, S, E); }
        GRID_SYNC();
        if (l == 0) {
            if (PHM & 2) ab_mixer(WSB(WS_H), WSB(WS_CAT), INF(5), INF(6), INF(7), INF(8), blockIdx.x, gridDim.x, fresh_tid());
        } else {
            if (PHM & 4) gla_prep(WSB(WS_H), WSB(WS_CAT), WSF(WS_DEC), INF(12), blockIdx.x, gridDim.x, fresh_tid());
            GRID_SYNC();
            if (PHM & 8) gla_scan(lds, WSB(WS_H), WSF(WS_DEC), WSB(WS_XN), blockIdx.x, gridDim.x, fresh_tid());
            GRID_SYNC();
            { WAVE_IDS(); if (PHM & 16) gla_post(WSB(WS_XN), WSB(WS_H), WSB(WS_CAT), INF(13), gw, ngw, lane); }
        }
        GRID_SYNC();
        { pg8::Gemm g{WSB(WS_CAT), (l == 0) ? WSB(WS_WABOUT) : WSB(WS_WGLAOUT), M, D, D}; pg8::StaticOrder S; S.init(M, D, gridDim.x, blockIdx.x);
          pg8::EpiRes E{(const float*)nullptr, WSB(WS_XS), D, RSSP(2 * l), (LAS float*)(lds + XCH_OFF)};
          if (PHM & 32) pg8::gemm_phase<pg8::EpiRes, pg8::StaticOrder, true, true>(lds, g, S, E); }
        GRID_SYNC();
        { pg8::Gemm g{WSB(WS_XS), WSB(WS_WUP) + (size_t)l * NUP * D, M, NUP, D}; pg8::StaticOrder S; S.init(M, NUP, gridDim.x, blockIdx.x);
          pg8::EpiFfnUp E{WSB(WS_H), INF(16) + (size_t)l * 3 * FFD, INF(17) + (size_t)l * FFD, WSF(WS_ULAST), WSF(WS_UFIRST), WSF(WS_VFIRST), (LAS f32x4*)(lds + XCH_OFF), RSSP(2 * l)};
          if (PHM & 64) pg8::gemm_phase<pg8::EpiFfnUp, pg8::StaticOrder, true, true, true>(lds, g, S, E); }
        GRID_SYNC();
        { pg8::Gemm g{WSB(WS_H), WSB(WS_WDN) + (size_t)l * D * FFD, M, D, FFD}; pg8::StaticOrder S; S.init(M, D, gridDim.x, blockIdx.x);
          if (PHM & 256) {
          const float* cw = INF(16) + (size_t)l * 3 * FFD; const float* cb = INF(17) + (size_t)l * FFD;
          const float* ULAST = WSF(WS_ULAST); const float* UFIRST = WSF(WS_UFIRST); const float* VFIRST = WSF(WS_VFIRST); bf16* ACT = WSB(WS_H);
          pg8::Unit u;
          for (int i = 0; S.next(i, u); ++i) {
              if ((u.pm & 15) == 0) continue;
              for (int c4 = fresh_tid(); c4 < FFD / 4; c4 += NTHR) {
                  const int ch = 4 * c4;
                  const f32x4 uf0 = *(const f32x4*)(UFIRST + (size_t)(u.pm * 2) * FFD + ch), uf1 = *(const f32x4*)(UFIRST + (size_t)(u.pm * 2 + 1) * FFD + ch);
                  const f32x4 ul0 = *(const f32x4*)(ULAST + (size_t)((u.pm - 1) * 2) * FFD + ch), ul1 = *(const f32x4*)(ULAST + (size_t)((u.pm - 1) * 2 + 1) * FFD + ch);
                  const f32x4 vf0 = *(const f32x4*)(VFIRST + (size_t)(u.pm * 2) * FFD + ch), vf1 = *(const f32x4*)(VFIRST + (size_t)(u.pm * 2 + 1) * FFD + ch);
                  const f32x4 a0 = *(const f32x4*)(cw + ch), a1 = *(const f32x4*)(cw + FFD + ch), a2 = *(const f32x4*)(cw + 2 * FFD + ch), bb = *(const f32x4*)(cb + ch);
                  const f32x4 u0 = bb + a0 * ul0 + a1 * ul1 + a2 * uf0, u1 = bb + a0 * ul1 + a1 * uf0 + a2 * uf1;
                  const f32x2 g00 = pg8::gelu_pk((f32x2){u0[0], u0[1]}), g01 = pg8::gelu_pk((f32x2){u0[2], u0[3]}), g10 = pg8::gelu_pk((f32x2){u1[0], u1[1]}), g11 = pg8::gelu_pk((f32x2){u1[2], u1[3]});
                  *(v2u*)(ACT + (size_t)(u.pm * 256) * FFD + ch) = (v2u){pk2(g00.x * vf0[0], g00.y * vf0[1]), pk2(g01.x * vf0[2], g01.y * vf0[3])};
                  *(v2u*)(ACT + (size_t)(u.pm * 256 + 1) * FFD + ch) = (v2u){pk2(g10.x * vf1[0], g10.y * vf1[1]), pk2(g11.x * vf1[2], g11.y * vf1[3])};
              }
          }
          asm volatile("s_waitcnt vmcnt(0)" ::: "memory"); __syncthreads();
          }
          if (l == 0 || gridDim.x != 256) { pg8::EpiRes E{(const float*)nullptr, WSB(WS_XS), D, RSSP(2 * l + 1), (LAS float*)(lds + XCH_OFF)};
              pg8::gemm_phase<pg8::EpiRes, pg8::StaticOrder, true, true>(lds, g, S, E); }
          else { pg8::EpiResFinal E{WSB(WS_XS), XOUT(), D, RSSP(3), INF(19), (unsigned*)(GAS unsigned*)(karg(21) + 16384), (LAS float*)(lds + XCH_OFF)};
              pg8::gemm_phase<pg8::EpiResFinal, pg8::StaticOrder, true, true>(lds, g, S, E); } }
        if (l == 0) GRID_SYNC();
    }
    if (gridDim.x != 256) { GRID_SYNC(); WAVE_IDS(); final_norm_rows(WSB(WS_XS), XOUT(), INF(19), RSSP(3), gw, ngw, lane); }
}

extern "C" void kernel_launch(void* const* d_in, const int* in_sizes, int n_in, void* d_out, int out_size, void* d_ws, size_t ws_size, hipStream_t stream) {
    static int grid_blocks = 0;
    if (grid_blocks == 0) {
        if (n_in != 20 || out_size != M * D || ws_size < WS_END) { fprintf(stderr, "kernel_launch: unexpected shapes (n_in %d out %d ws %zu)\n", n_in, out_size, ws_size); grid_blocks = -1; return; }
        int dev = 0, cus = 0, per_cu = 0;
        hipGetDevice(&dev); hipDeviceGetAttribute(&cus, hipDeviceAttributeMultiprocessorCount, dev);
        if (hipFuncSetAttribute((const void*)fwd_megakernel, hipFuncAttributeMaxDynamicSharedMemorySize, LDS_BYTES) != hipSuccess) fprintf(stderr, "kernel_launch: hipFuncSetAttribute failed\n");
        if (hipOccupancyMaxActiveBlocksPerMultiprocessor(&per_cu, (const void*)fwd_megakernel, NTHR, LDS_BYTES) != hipSuccess || per_cu < 1) { fprintf(stderr, "kernel_launch: occupancy query says %d\n", per_cu); per_cu = 1; }
        (void)hipGetLastError();
        grid_blocks = cus * per_cu;
    }
    if (grid_blocks < 0) return;
    if (hipMemsetAsync(d_ws, 0, 65536, stream) != hipSuccess) { fprintf(stderr, "kernel_launch: memset failed\n"); return; }
    Args a{};
    for (int i = 0; i < 20; ++i) a.in[i] = (const float*)d_in[i];
    a.out = (float*)d_out; a.ws = (unsigned char*)d_ws;
    void* kargs[] = {&a};
    hipError_t e = hipLaunchCooperativeKernel((const void*)fwd_megakernel, dim3(grid_blocks), dim3(NTHR), kargs, LDS_BYTES, stream);
    if (e != hipSuccess) fprintf(stderr, "cooperative launch failed: %s (grid %d)\n", hipGetErrorString(e), grid_blocks);
}
```

```cpp
#include <hip/hip_runtime.h>
#include <hip/hip_cooperative_groups.h>
#include <cstdio>
#include <cstdint>
namespace cg = cooperative_groups;
__device__ __forceinline__ int fresh_tid() { int t = threadIdx.x; asm volatile("" : "+v"(t)); return t; }
namespace pg8 {
#define PG8_LAS __attribute__((address_space(3)))
typedef unsigned short bf16_t;
typedef short bf16x8 __attribute__((ext_vector_type(8)));
typedef float f32x4 __attribute__((ext_vector_type(4)));
typedef unsigned u32x4 __attribute__((ext_vector_type(4)));
constexpr int BM = 256, BK = 64, HALF = 128, HTB = HALF * BK * 2  , STAGE_BYTES = 8 * HTB, NXCD = 8, WGM = 8;

__host__ __device__ __forceinline__ int lds_byte(int r, int c) { const int st = (r >> 4) * 2 + (c >> 5), rr = r & 15, cc = c & 31, ob = rr * 64 + cc * 2; return st * 1024 + (ob ^ (((ob >> 9) & 1) << 5)); }
__host__ __device__ __forceinline__ void stage_rc(int b, int& R, int& C) { const int st = b / 1024, sb = b % 1024, swz = sb ^ (((sb >> 9) & 1) << 5); R = (st >> 1) * 16 + swz / 64; C = (st & 1) * 32 + (swz % 64) / 2; }
__host__ __device__ __forceinline__ int perm32(int rho) { const int n = rho >> 4, i = rho & 15; return 8 * (i >> 2) + 4 * n + (i & 3); }

struct Unit { int pm, pn; };
struct Gemm { const bf16_t* A; const bf16_t* Bt; int M, N, K; };

struct StaticOrder {
    int nM, nN, nwg, G, c;
    __host__ __device__ void init(int M, int N, int G_, int c_) { nM = M / BM; nN = N / BM; nwg = nM * nN; G = G_; c = c_; }
    __host__ __device__ bool next(int i, Unit& u) const {
        const long L = (long)i * G + c; if (L >= nwg) return false;
        int wgid = (int)L; { const int q = nwg / NXCD, r = nwg % NXCD, xcd = wgid % NXCD, off = wgid / NXCD; wgid = (xcd < r ? xcd * (q + 1) : r * (q + 1) + (xcd - r) * q) + off; }
        const int nig = WGM * nN, gid = wgid / nig, fm = gid * WGM, gsz = (nM - fm) < WGM ? (nM - fm) : WGM;
        u.pm = fm + ((wgid % nig) % gsz); u.pn = (wgid % nig) / gsz; return true;
    }
    __device__ __forceinline__ void a_ready(const Unit&) const {}
    __device__ __forceinline__ void done(const Unit&) const {}
};

typedef float f32x2c_t __attribute__((ext_vector_type(2))); typedef __bf16 bf16x2c_t __attribute__((ext_vector_type(2)));
__device__ __forceinline__ unsigned cvt_pk_bf16(float lo, float hi) { const f32x2c_t v = {lo, hi}; const bf16x2c_t b = __builtin_convertvector(v, bf16x2c_t); return __builtin_bit_cast(unsigned, b); }
typedef float f32x2 __attribute__((ext_vector_type(2)));
__device__ __forceinline__ f32x2 gelu_pk(f32x2 v) {
    const f32x2 av = __builtin_elementwise_abs(v), d = av * 0.2316418882f + 1.0f;
    f32x2 t; t.x = __builtin_amdgcn_rcpf(d.x); t.y = __builtin_amdgcn_rcpf(d.y);
    f32x2 q = t * 0.5307027145f + (-0.7265760135f); q = q * t + 0.7107068705f; q = q * t + (-0.142248368f); q = q * t + 0.127414796f; q = q * t;
    const f32x2 s = (v * v) * (-0.72134752044f);
    f32x2 e; e.x = __builtin_amdgcn_exp2f(s.x); e.y = __builtin_amdgcn_exp2f(s.y);
    const f32x2 m = av * (q * e);
    return __builtin_elementwise_max(v, (f32x2){0.f, 0.f}) - m;
}
}
namespace pg8 {
template <class Epi, class Sched, bool ALIGN_EPI = false, bool SP2 = false, bool APERM = false  >
__device__ __forceinline__ void gemm_phase(PG8_LAS unsigned char* lds, const Gemm g, const Sched& S, const Epi& E) {
    const int tid = fresh_tid(), wid = __builtin_amdgcn_readfirstlane(tid >> 6), lane = tid & 63, wr = wid >> 2, wc = wid & 3, fr = lane & 15, fq = lane >> 4;
    const int K = g.K, nt = K / BK;
    unsigned voffA[2], voffB[2];
#pragma unroll
    for (int i = 0; i < 2; ++i) { int R, C; stage_rc(tid * 16 + i * 8192, R, C); const int Rb = Epi::PERM ? ((R & ~31) + perm32(R & 31)) : R;
        const int Ra = APERM ? ((R & ~63) + 4 * (R & 15) + ((R >> 4) & 3)) : R;
        voffA[i] = (unsigned)(Ra * K + C) * 2u; voffB[i] = (unsigned)(Rb * K + C) * 2u; }
    const size_t kstep = (size_t)(BK * 2);
    const size_t hstep = (size_t)HALF * K * 2;
    const size_t tstep = 2 * hstep;
    const unsigned ldsw = (unsigned)wid * 1024u;
    const int aoff = lds_byte(wr * 64 + fr, fq * 8), boff = lds_byte(wc * 32 + fr, fq * 8);
#define PG8_SA(b, h) (((b) * 2 + (h)) * HTB)
#define PG8_SB(b, h) ((4 + (b) * 2 + (h)) * HTB)
#define PG8_STAGE(bufoff, gbase, voff) do { _Pragma("unroll") for (int _i = 0; _i < 2; ++_i) \
        __builtin_amdgcn_global_load_lds((const unsigned*)((const char*)(gbase) + (voff)[_i]), (PG8_LAS unsigned*)(lds + (bufoff) + ldsw + _i * 8192), 16, 0, 0); } while (0)
#define PG8_LDA(dst, b, h) do { _Pragma("unroll") for (int m = 0; m < 4; ++m) _Pragma("unroll") for (int k = 0; k < 2; ++k) dst[m][k] = *(const PG8_LAS bf16x8*)(lds + PG8_SA(b, h) + aoff + m * 2048 + k * 1024); } while (0)
#define PG8_LDB(dst, b, h) do { _Pragma("unroll") for (int n = 0; n < 2; ++n) _Pragma("unroll") for (int k = 0; k < 2; ++k) dst[n][k] = *(const PG8_LAS bf16x8*)(lds + PG8_SB(b, h) + boff + n * 2048 + k * 1024); } while (0)
#define PG8_MMA(ai, bj, At, Bt) do { __builtin_amdgcn_s_setprio(1); _Pragma("unroll") for (int m = 0; m < 4; ++m) _Pragma("unroll") for (int n = 0; n < 2; ++n) _Pragma("unroll") for (int k = 0; k < 2; ++k) \
        acc[ai][bj][m][n] = __builtin_amdgcn_mfma_f32_16x16x32_bf16(Bt[n][k], At[m][k], acc[ai][bj][m][n], 0, 0, 0); __builtin_amdgcn_s_setprio(0); } while (0)
#define PG8_WAIT_V(n) asm volatile("s_waitcnt vmcnt(" #n ")" ::: "memory")
#define PG8_WAIT_L(n) asm volatile("s_waitcnt lgkmcnt(" #n ")" ::: "memory")
#define PG8_BAR __builtin_amdgcn_s_barrier()
#define PG8_SCHED __builtin_amdgcn_sched_barrier(0)
    Unit cur, nxt; int ui = 0;
    if (!S.next(0, cur)) return;
    f32x4 acc[2][2][4][2];
#pragma unroll
    for (int a = 0; a < 2; ++a)
#pragma unroll
        for (int b = 0; b < 2; ++b)
#pragma unroll
            for (int m = 0; m < 4; ++m)
#pragma unroll
                for (int n = 0; n < 2; ++n) acc[a][b][m][n] = (f32x4){0.f, 0.f, 0.f, 0.f};
    bf16x8 At[4][2], B0[2][2], B1[2][2];
    const char* cA = (const char*)g.A + (size_t)cur.pm * tstep; const char* cB = (const char*)g.Bt + (size_t)cur.pn * tstep;
    S.a_ready(cur);
    if constexpr (SP2) {
        PG8_STAGE(PG8_SB(0, 0), cB, voffB); PG8_STAGE(PG8_SB(0, 1), cB + hstep, voffB); PG8_STAGE(PG8_SA(0, 0), cA, voffA); PG8_STAGE(PG8_SA(0, 1), cA + hstep, voffA);
        if (wr == 1) PG8_BAR;
        PG8_WAIT_V(2); PG8_BAR;
        PG8_STAGE(PG8_SB(1, 0), cB + kstep, voffB); PG8_STAGE(PG8_SA(1, 0), cA + kstep, voffA); PG8_STAGE(PG8_SB(1, 1), cB + hstep + kstep, voffB);
        PG8_WAIT_V(6); PG8_BAR;
    } else {
        PG8_STAGE(PG8_SB(0, 0), cB, voffB); PG8_STAGE(PG8_SA(0, 0), cA, voffA); PG8_STAGE(PG8_SB(0, 1), cB + hstep, voffB); PG8_STAGE(PG8_SA(0, 1), cA + hstep, voffA);
        if (wr == 1) PG8_BAR;
        PG8_WAIT_V(4); PG8_BAR;
        PG8_STAGE(PG8_SB(1, 0), cB + kstep, voffB); PG8_STAGE(PG8_SA(1, 0), cA + kstep, voffA); PG8_STAGE(PG8_SB(1, 1), cB + hstep + kstep, voffB);
        PG8_WAIT_V(6); PG8_BAR;
    }
    for (;;) {
        const bool has_next = S.next(ui + 1, nxt);
        const char* nA = has_next ? (const char*)g.A + (size_t)nxt.pm * tstep : cA; const char* nB = has_next ? (const char*)g.Bt + (size_t)nxt.pn * tstep : cB;
        for (int t = 0; t < nt; t += 2) {
            const bool last = (t == nt - 2);
            const char* a1 = cA + (size_t)(t + 1) * kstep;
            const char* a2 = last ? nA : cA + (size_t)(t + 2) * kstep; const char* b2 = last ? nB : cB + (size_t)(t + 2) * kstep;
            const char* a3 = a2 + kstep; const char* b3 = b2 + kstep;
            if (last && has_next) S.a_ready(nxt);
            if constexpr (SP2) {
            PG8_LDB(B0, 0, 0); PG8_LDB(B1, 0, 1); PG8_SCHED; PG8_LDA(At, 0, 0); PG8_STAGE(PG8_SA(1, 1), a1 + hstep, voffA);
            PG8_WAIT_V(8); PG8_WAIT_L(0); PG8_BAR; PG8_MMA(0, 0, At, B0); PG8_MMA(0, 1, At, B1); PG8_BAR; PG8_SCHED;
            PG8_LDA(At, 0, 1); PG8_STAGE(PG8_SB(0, 0), b2, voffB); PG8_STAGE(PG8_SB(0, 1), b2 + hstep, voffB); PG8_STAGE(PG8_SA(0, 0), a2, voffA);
            PG8_WAIT_V(8); PG8_WAIT_L(0); PG8_BAR; PG8_MMA(1, 0, At, B0); PG8_MMA(1, 1, At, B1); PG8_BAR; PG8_SCHED;
            PG8_LDB(B0, 1, 0); PG8_LDB(B1, 1, 1); PG8_SCHED; PG8_LDA(At, 1, 0); PG8_STAGE(PG8_SA(0, 1), a2 + hstep, voffA);
            PG8_WAIT_V(8); PG8_WAIT_L(0); PG8_BAR; PG8_MMA(0, 0, At, B0); PG8_MMA(0, 1, At, B1); PG8_BAR; PG8_SCHED;
            PG8_LDA(At, 1, 1); PG8_STAGE(PG8_SB(1, 0), b3, voffB); PG8_STAGE(PG8_SB(1, 1), b3 + hstep, voffB); PG8_STAGE(PG8_SA(1, 0), a3, voffA);
            PG8_WAIT_V(8); PG8_WAIT_L(0); PG8_BAR; PG8_MMA(1, 0, At, B0); PG8_MMA(1, 1, At, B1); PG8_BAR; PG8_SCHED;
            } else {
            PG8_LDB(B0, 0, 0); PG8_SCHED; PG8_LDA(At, 0, 0); PG8_STAGE(PG8_SA(1, 1), a1 + hstep, voffA);
            PG8_WAIT_L(8); PG8_BAR; PG8_WAIT_L(0); PG8_MMA(0, 0, At, B0); PG8_BAR; PG8_SCHED;
            PG8_LDB(B1, 0, 1); PG8_STAGE(PG8_SB(0, 0), b2, voffB);
            PG8_BAR; PG8_WAIT_L(0); PG8_MMA(0, 1, At, B1); PG8_BAR;
            PG8_LDA(At, 0, 1); PG8_STAGE(PG8_SA(0, 0), a2, voffA);
            PG8_BAR; PG8_WAIT_L(0); PG8_MMA(1, 0, At, B0); PG8_BAR; PG8_SCHED;
            PG8_STAGE(PG8_SB(0, 1), b2 + hstep, voffB);
            PG8_WAIT_V(6); PG8_BAR; PG8_MMA(1, 1, At, B1); PG8_BAR;
            PG8_LDB(B0, 1, 0); PG8_SCHED; PG8_LDA(At, 1, 0); PG8_STAGE(PG8_SA(0, 1), a2 + hstep, voffA);
            PG8_WAIT_L(8); PG8_BAR; PG8_WAIT_L(0); PG8_MMA(0, 0, At, B0); PG8_BAR; PG8_SCHED;
            PG8_LDB(B1, 1, 1); PG8_STAGE(PG8_SB(1, 0), b3, voffB);
            PG8_BAR; PG8_WAIT_L(0); PG8_MMA(0, 1, At, B1); PG8_BAR;
            PG8_LDA(At, 1, 1); PG8_STAGE(PG8_SA(1, 0), a3, voffA);
            PG8_BAR; PG8_WAIT_L(0); PG8_MMA(1, 0, At, B0); PG8_BAR; PG8_SCHED;
            PG8_STAGE(PG8_SB(1, 1), b3 + hstep, voffB);
            PG8_WAIT_V(6); PG8_BAR; PG8_MMA(1, 1, At, B1); PG8_BAR;
            }
        }
        if constexpr (ALIGN_EPI) { if (wr == 0) PG8_BAR; }
        if constexpr (!Epi::AFTER_DRAIN) { E(acc, cur, wr, wc, fr, fq); S.done(cur); }
        if (!has_next) break;
#pragma unroll
        for (int a = 0; a < 2; ++a)
#pragma unroll
            for (int b = 0; b < 2; ++b)
#pragma unroll
                for (int m = 0; m < 4; ++m)
#pragma unroll
                    for (int n = 0; n < 2; ++n) acc[a][b][m][n] = (f32x4){0.f, 0.f, 0.f, 0.f};
        cur = nxt; cA = nA; cB = nB; ++ui;
        if constexpr (ALIGN_EPI) { if (wr == 1) PG8_BAR; }
    }
    PG8_WAIT_V(0);
    if constexpr (!ALIGN_EPI) { if (wr == 0) PG8_BAR; }
    PG8_BAR;
    if constexpr (Epi::AFTER_DRAIN) { E.fused(acc, cur, wr, wc, fr, fq, lds, wid, lane); S.done(cur); }
#undef PG8_SA
#undef PG8_SB
#undef PG8_STAGE
#undef PG8_LDA
#undef PG8_LDB
#undef PG8_MMA
#undef PG8_WAIT_V
#undef PG8_WAIT_L
#undef PG8_BAR
#undef PG8_SCHED
}
}
namespace pg8 {
template <int CTRL> __device__ __forceinline__ float dppf(float v) { return __builtin_bit_cast(float, __builtin_amdgcn_update_dpp(0, __builtin_bit_cast(int, v), CTRL, 0xf, 0xf, false)); }

template <int CTRL> __device__ __forceinline__ float dppo(float old, float v) { return __builtin_bit_cast(float, __builtin_amdgcn_update_dpp(__builtin_bit_cast(int, old), __builtin_bit_cast(int, v), CTRL, 0xf, 0xf, false)); }
struct EpiBf16P {
    static constexpr bool PERM = true, AFTER_DRAIN = false;
    bf16_t* O; int ldc; const float* rss; PG8_LAS float* tab;
    __device__ __forceinline__ void operator()(const f32x4 (&acc)[2][2][4][2], const Unit& u, int wr, int wc, int fr, int fq) const {
        const int row0 = u.pm * BM + wr * 64 + fr, col0 = u.pn * BM + wc * 32 + 8 * fq;
        if (wr == 0) { const int trow = wc * 64 + fq * 16 + fr, r_ = u.pm * BM + trow;
            tab[trow] = __builtin_amdgcn_rsqf(((rss[r_] + rss[32768 + r_]) + (rss[65536 + r_] + rss[98304 + r_])) * (1.f / 1024.f) + 1e-6f); }
        asm volatile("s_waitcnt lgkmcnt(0)" ::: "memory"); __builtin_amdgcn_s_barrier(); asm volatile("" ::: "memory");
#pragma unroll
        for (int ai = 0; ai < 2; ++ai)
#pragma unroll
            for (int m = 0; m < 4; ++m) { const int row = row0 + ai * HALF + m * 16; bf16_t* rowp = O + (size_t)row * ldc + col0;
                const float rs = tab[wr * 64 + fr + ai * HALF + m * 16];
#pragma unroll
                for (int bj = 0; bj < 2; ++bj) { const f32x4 v0 = acc[ai][bj][m][0] * rs, v1 = acc[ai][bj][m][1] * rs;
                    u32x4 w; w.x = cvt_pk_bf16(v0[0], v0[1]); w.y = cvt_pk_bf16(v0[2], v0[3]); w.z = cvt_pk_bf16(v1[0], v1[1]); w.w = cvt_pk_bf16(v1[2], v1[3]);
                    *(u32x4*)(rowp + bj * HALF) = w; } }
    }
};
struct EpiRes {
    static constexpr bool PERM = true, AFTER_DRAIN = false;
    const float* base32; bf16_t* xs; int ldc; float* rssp; PG8_LAS float* red;
    __device__ __forceinline__ void operator()(const f32x4 (&acc)[2][2][4][2], const Unit& u, int wr, int wc, int fr, int fq) const {
        const int col0 = u.pn * BM + wc * 32 + 8 * fq;
        const size_t off0 = (size_t)(u.pm * BM + wr * 64 + fr) * ldc + col0;
#pragma unroll
        for (int ai = 0; ai < 2; ++ai) {
            u32x4 bv[4][2];
#pragma unroll
            for (int m = 0; m < 4; ++m)
#pragma unroll
                for (int bj = 0; bj < 2; ++bj) bv[m][bj] = *(const u32x4*)(xs + off0 + (size_t)(ai * HALF + m * 16) * ldc + bj * HALF);
#pragma unroll
            for (int m = 0; m < 4; ++m) { float ss = 0.f;
#pragma unroll
                for (int bj = 0; bj < 2; ++bj) { const size_t off = off0 + (size_t)(ai * HALF + m * 16) * ldc + bj * HALF; const u32x4 b = bv[m][bj];
                    f32x4 o0 = (f32x4){__builtin_bit_cast(float, b.x << 16), __builtin_bit_cast(float, b.x & 0xffff0000u), __builtin_bit_cast(float, b.y << 16), __builtin_bit_cast(float, b.y & 0xffff0000u)};
                    f32x4 o1 = (f32x4){__builtin_bit_cast(float, b.z << 16), __builtin_bit_cast(float, b.z & 0xffff0000u), __builtin_bit_cast(float, b.w << 16), __builtin_bit_cast(float, b.w & 0xffff0000u)};
                    o0 = o0 + acc[ai][bj][m][0]; o1 = o1 + acc[ai][bj][m][1];
                    ss += ((o0[0] * o0[0] + o0[1] * o0[1]) + (o0[2] * o0[2] + o0[3] * o0[3])) + ((o1[0] * o1[0] + o1[1] * o1[1]) + (o1[2] * o1[2] + o1[3] * o1[3]));
                    u32x4 w; w.x = cvt_pk_bf16(o0[0], o0[1]); w.y = cvt_pk_bf16(o0[2], o0[3]); w.z = cvt_pk_bf16(o1[0], o1[1]); w.w = cvt_pk_bf16(o1[2], o1[3]); *(u32x4*)(xs + off) = w; }
                ss += __shfl_xor(ss, 16); ss += __shfl_xor(ss, 32);
                if (fq == 0) red[wc * 256 + ai * HALF + wr * 64 + m * 16 + fr] = ss; }
            asm volatile("" ::: "memory"); }
        asm volatile("s_waitcnt lgkmcnt(0)" ::: "memory"); __builtin_amdgcn_s_barrier(); asm volatile("" ::: "memory");
        if (wr == 0) { const int row = wc * 64 + fq * 16 + fr;
            rssp[(size_t)u.pn * 32768 + u.pm * BM + row] = (red[row] + red[256 + row]) + (red[512 + row] + red[768 + row]); }
    }
};
struct EpiResFinal {
    static constexpr bool PERM = true, AFTER_DRAIN = false;
    const bf16_t* xs; float* out; int ldc; float* rssp; const float* g; unsigned* cnt; PG8_LAS float* red;
    __device__ __forceinline__ void operator()(const f32x4 (&acc_)[2][2][4][2], const Unit& u, int wr, int wc, int fr, int fq) const {
        f32x4 (&acc)[2][2][4][2] = const_cast<f32x4 (&)[2][2][4][2]>(acc_);
        const int col0 = u.pn * BM + wc * 32 + 8 * fq;
        const size_t off0 = (size_t)(u.pm * BM + wr * 64 + fr) * ldc + col0;
#pragma unroll
        for (int ai = 0; ai < 2; ++ai) {
          u32x4 bv[4][2];
#pragma unroll
          for (int m = 0; m < 4; ++m)
#pragma unroll
              for (int bj = 0; bj < 2; ++bj) bv[m][bj] = *(const u32x4*)(xs + off0 + (size_t)(ai * HALF + m * 16) * ldc + bj * HALF);
#pragma unroll
            for (int m = 0; m < 4; ++m) { float ss = 0.f;
#pragma unroll
                for (int bj = 0; bj < 2; ++bj) {
                    const u32x4 b = bv[m][bj];
                    const f32x4 o0 = (f32x4){__builtin_bit_cast(float, b.x << 16), __builtin_bit_cast(float, b.x & 0xffff0000u), __builtin_bit_cast(float, b.y << 16), __builtin_bit_cast(float, b.y & 0xffff0000u)} + acc[ai][bj][m][0];
                    const f32x4 o1 = (f32x4){__builtin_bit_cast(float, b.z << 16), __builtin_bit_cast(float, b.z & 0xffff0000u), __builtin_bit_cast(float, b.w << 16), __builtin_bit_cast(float, b.w & 0xffff0000u)} + acc[ai][bj][m][1];
                    ss += ((o0[0] * o0[0] + o0[1] * o0[1]) + (o0[2] * o0[2] + o0[3] * o0[3])) + ((o1[0] * o1[0] + o1[1] * o1[1]) + (o1[2] * o1[2] + o1[3] * o1[3]));
                    acc[ai][bj][m][0] = o0; acc[ai][bj][m][1] = o1; }
                ss += __shfl_xor(ss, 16); ss += __shfl_xor(ss, 32);
                if (fq == 0) red[wc * 256 + ai * HALF + wr * 64 + m * 16 + fr] = ss;
                asm volatile("" ::: "memory"); } }
        asm volatile("s_waitcnt lgkmcnt(0)" ::: "memory"); __builtin_amdgcn_s_barrier(); asm volatile("" ::: "memory");
        const int trow = wc * 64 + fq * 16 + fr;
        float* slot = rssp + (size_t)u.pm * BM + trow;
        if (wr == 0) __hip_atomic_store(slot + (size_t)u.pn * 32768, (red[trow] + red[256 + trow]) + (red[512 + trow] + red[768 + trow]), __ATOMIC_RELAXED, __HIP_MEMORY_SCOPE_AGENT);
        asm volatile("s_waitcnt vmcnt(0)" ::: "memory"); __builtin_amdgcn_s_barrier(); asm volatile("" ::: "memory");
        if (wr == 0 && wc == 0 && fq == 0 && fr == 0) {
            unsigned* c = cnt + 64 * u.pm; __hip_atomic_fetch_add(c, 1u, __ATOMIC_RELAXED, __HIP_MEMORY_SCOPE_AGENT);
            unsigned spins = 0; while (__hip_atomic_load(c, __ATOMIC_RELAXED, __HIP_MEMORY_SCOPE_AGENT) < 4u && ++spins < (1u << 22)) __builtin_amdgcn_s_sleep(1);
        }
        asm volatile("s_waitcnt vmcnt(0)" ::: "memory"); __builtin_amdgcn_s_barrier(); asm volatile("" ::: "memory");
        if (wr == 0) { const float t = (__hip_atomic_load(slot, __ATOMIC_RELAXED, __HIP_MEMORY_SCOPE_AGENT) + __hip_atomic_load(slot + 32768, __ATOMIC_RELAXED, __HIP_MEMORY_SCOPE_AGENT))
                                     + (__hip_atomic_load(slot + 65536, __ATOMIC_RELAXED, __HIP_MEMORY_SCOPE_AGENT) + __hip_atomic_load(slot + 98304, __ATOMIC_RELAXED, __HIP_MEMORY_SCOPE_AGENT));
            red[1024 + trow] = __builtin_amdgcn_rsqf(t * (1.f / 1024.f) + 1e-6f); }
        asm volatile("s_waitcnt lgkmcnt(0)" ::: "memory"); __builtin_amdgcn_s_barrier(); asm volatile("" ::: "memory");
#pragma unroll
        for (int bj = 0; bj < 2; ++bj) { const f32x4 g0 = *(const f32x4*)(g + col0 + bj * HALF), g1 = *(const f32x4*)(g + col0 + bj * HALF + 4);
#pragma unroll
            for (int ai = 0; ai < 2; ++ai)
#pragma unroll
                for (int m = 0; m < 4; ++m) { const float rs = red[1024 + ai * HALF + wr * 64 + m * 16 + fr]; const size_t off = off0 + (size_t)(ai * HALF + m * 16) * ldc + bj * HALF;
                    *(f32x4*)(out + off) = acc[ai][bj][m][0] * rs * g0; *(f32x4*)(out + off + 4) = acc[ai][bj][m][1] * rs * g1; } }
    }
};
struct EpiFfnUp {
    static constexpr bool PERM = true, AFTER_DRAIN = false;
    static constexpr int FFD = 2816;
    bf16_t* act; const float* cw; const float* cb; float* ulast; float* ufirst; float* vfirst; PG8_LAS f32x4* xch; const float* rss;
    __device__ __forceinline__ void operator()(const f32x4 (&acc)[2][2][4][2], const Unit& u, int wr, int wc, int fr, int fq) const {
        const int ch0 = u.pn * 128 + wc * 32 + 8 * fq;
        f32x4 w0[2], w1[2], w2[2], bb[2];
#pragma unroll
        for (int n = 0; n < 2; ++n) { w0[n] = *(const f32x4*)(cw + ch0 + 4 * n); w1[n] = *(const f32x4*)(cw + FFD + ch0 + 4 * n); w2[n] = *(const f32x4*)(cw + 2 * FFD + ch0 + 4 * n); bb[n] = *(const f32x4*)(cb + ch0 + 4 * n); }
        PG8_LAS float* tab = (PG8_LAS float*)(xch + 256);
#define RSTD4(r_) __builtin_amdgcn_rsqf(((rss[(r_)] + rss[32768 + (r_)]) + (rss[65536 + (r_)] + rss[98304 + (r_)])) * (1.f / 1024.f) + 1e-6f)
        if (wr == 0) { const int trow = wc * 64 + fq * 16 + fr; tab[trow] = RSTD4(u.pm * BM + trow); }
        const int rl = wr * 64 + 4 * fr;
        if (fr == 15) {
#pragma unroll
            for (int ai = 0; ai < 2; ++ai)
#pragma unroll
                for (int q = 0; q < 2; ++q) { PG8_LAS f32x4* s = xch + (((((ai * 2 + wr) * 4 + wc) * 4 + fq) * 2 + q) * 2); s[0] = acc[ai][0][2 + q][0]; s[1] = acc[ai][0][2 + q][1]; }
        }
        asm volatile("s_waitcnt lgkmcnt(0)" ::: "memory"); __builtin_amdgcn_s_barrier(); asm volatile("" ::: "memory");
        if (fr == 15 && wr == 1) {
#pragma unroll
            for (int q = 0; q < 2; ++q) { const float r3 = tab[rl + HALF + 2 + q]; float* g = ulast + (size_t)(u.pm * 2 + q) * FFD + ch0; *(f32x4*)g = acc[1][0][2 + q][0] * r3; *(f32x4*)(g + 4) = acc[1][0][2 + q][1] * r3; } }
        if (fr == 0 && wr == 0) {
#pragma unroll
            for (int q = 0; q < 2; ++q) { const float r0 = tab[q]; float* g = ufirst + (size_t)(u.pm * 2 + q) * FFD + ch0; *(f32x4*)g = acc[0][0][q][0] * r0; *(f32x4*)(g + 4) = acc[0][0][q][1] * r0;
                float* h = vfirst + (size_t)(u.pm * 2 + q) * FFD + ch0; *(f32x4*)h = acc[0][1][q][0] * r0; *(f32x4*)(h + 4) = acc[0][1][q][1] * r0; } }
#pragma unroll
        for (int ai = 0; ai < 2; ++ai) {
            f32x4 h2[2] = {(f32x4){0.f, 0.f, 0.f, 0.f}, (f32x4){0.f, 0.f, 0.f, 0.f}}, h3[2] = {h2[0], h2[0]};
            if (wr == 1 || ai == 1) { const int sai = (wr == 1) ? ai : 0, swr = (wr == 1) ? 0 : 1;
                const PG8_LAS f32x4* s = xch + ((((sai * 2 + swr) * 4 + wc) * 4 + fq) * 2) * 2; const float ra = tab[sai * HALF + swr * 64 + 62], rb = tab[sai * HALF + swr * 64 + 63];
                h2[0] = s[0] * ra; h2[1] = s[1] * ra; h3[0] = s[2] * rb; h3[1] = s[3] * rb; }
            const f32x4 rs4 = *(const PG8_LAS f32x4*)(tab + rl + ai * HALF);
            f32x4 us[4][2];
#pragma unroll
            for (int m = 0; m < 4; ++m) { us[m][0] = acc[ai][0][m][0] * rs4[m]; us[m][1] = acc[ai][0][m][1] * rs4[m]; }
            f32x4 s2[2], s3[2];
#pragma unroll
            for (int n = 0; n < 2; ++n)
#pragma unroll
                for (int e = 0; e < 4; ++e) { s2[n][e] = dppo<0x111>(h2[n][e], us[2][n][e]); s3[n][e] = dppo<0x111>(h3[n][e], us[3][n][e]); }
#pragma unroll
            for (int m = 0; m < 4; ++m) {
                f32x4 uc[2];
#pragma unroll
                for (int n = 0; n < 2; ++n) { const f32x4 um1 = (m == 0) ? s3[n] : us[m - 1][n], um2 = (m == 0) ? s2[n] : (m == 1) ? s3[n] : us[m - 2][n];
                    uc[n] = bb[n] + w0[n] * um2 + w1[n] * um1 + w2[n] * us[m][n]; }
                const f32x4 v0 = acc[ai][1][m][0] * rs4[m], v1 = acc[ai][1][m][1] * rs4[m];
                const f32x2 a = gelu_pk((f32x2){uc[0][0], uc[0][1]}), b = gelu_pk((f32x2){uc[0][2], uc[0][3]}), c = gelu_pk((f32x2){uc[1][0], uc[1][1]}), d = gelu_pk((f32x2){uc[1][2], uc[1][3]});
                u32x4 w; w.x = cvt_pk_bf16(a.x * v0[0], a.y * v0[1]); w.y = cvt_pk_bf16(b.x * v0[2], b.y * v0[3]); w.z = cvt_pk_bf16(c.x * v1[0], c.y * v1[1]); w.w = cvt_pk_bf16(d.x * v1[2], d.y * v1[3]);
                *(u32x4*)(act + (size_t)(u.pm * BM + ai * HALF + rl + m) * FFD + ch0) = w;
            }
        }
    }
};
}
#define LAS __attribute__((address_space(3)))
typedef unsigned short bf16;
typedef unsigned v4u __attribute__((ext_vector_type(4)));
typedef unsigned v2u __attribute__((ext_vector_type(2)));
typedef float f32x4 __attribute__((ext_vector_type(4)));
typedef float f32x2 __attribute__((ext_vector_type(2)));
typedef short bf16x8 __attribute__((ext_vector_type(8)));
constexpr int NWAVES = 8, NTHR = 512;
constexpr int BATCH = 8, SEQ = 4096, D = 1024, M = BATCH * SEQ, FFD = 2816, NUP = 2 * FFD, NAB = 2048, NGLA = 3584, GLA_SRC_N = 3088;
constexpr float EPS = 1e-6f;
constexpr size_t MiB = 1u << 20;
constexpr size_t WS_DEC = 1 * MiB, WS_ULAST = 2 * MiB, WS_UFIRST = 5 * MiB, WS_VFIRST = 8 * MiB;
constexpr size_t WS_WABIN = 12 * MiB, WS_WABOUT = 16 * MiB, WS_WGLAIN = 18 * MiB, WS_WGLAOUT = 25 * MiB, WS_WUP = 27 * MiB  , WS_WDN = 49 * MiB  ;
constexpr size_t WS_XN = 64 * MiB, WS_CAT = 128 * MiB, WS_H = 192 * MiB, WS_XS = 416 * MiB  , WS_END = 480 * MiB;
constexpr int LDS_BYTES = 147456, XCH_OFF = 131072;
#ifndef PHM
#define PHM 0xffff
#endif

__device__ __forceinline__ float bflo(unsigned w) { return __builtin_bit_cast(float, w << 16); }
__device__ __forceinline__ float bfhi(unsigned w) { return __builtin_bit_cast(float, w & 0xffff0000u); }
__device__ __forceinline__ unsigned pk2(float lo, float hi) { return pg8::cvt_pk_bf16(lo, hi); }
__device__ __forceinline__ float wave_sum(float v) {
#pragma unroll
    for (int o = 1; o < 64; o <<= 1) v += __shfl_xor(v, o);
    return v;
}
#define LDS_WAIT() asm volatile("s_waitcnt lgkmcnt(0)" ::: "memory")

__device__ __forceinline__ void transpose_item(const float* W, int ldw, int K, bf16* WT, int k0, int n0, int trow0, LAS float* scr, int lane, const float* g = nullptr) {
    float tv[32];
#pragma unroll
    for (int i = 0; i < 32; ++i) { const int kk = 2 * i + (lane >> 5); tv[i] = W[(size_t)(k0 + kk) * ldw + n0 + (lane & 31)]; }
#pragma unroll
    for (int i = 0; i < 32; ++i) { const int kk = 2 * i + (lane >> 5); scr[kk * 33 + (lane & 31)] = tv[i] * (g ? g[k0 + kk] : 1.f); }
    LDS_WAIT(); asm volatile("" ::: "memory");
    const int c = lane & 7;
#pragma unroll
    for (int j = 0; j < 4; ++j) { const int n = (lane >> 3) + 8 * j; const LAS float* s = scr + (8 * c) * 33 + n;
        v4u o; o.x = pk2(s[0 * 33], s[1 * 33]); o.y = pk2(s[2 * 33], s[3 * 33]); o.z = pk2(s[4 * 33], s[5 * 33]); o.w = pk2(s[6 * 33], s[7 * 33]);
        *(v4u*)(WT + (size_t)(trow0 + n) * K + k0 + 8 * c) = o; }
    LDS_WAIT(); asm volatile("" ::: "memory");
}

struct Args { const float* in[20]; float* out; unsigned char* ws; };

__device__ __forceinline__ void convert_rows(const float* X, bf16* XS, float* rss, int gw, int ngw, int lane) {
#pragma unroll 2
    for (int m = gw; m < M; m += ngw) {
        const f32x4* xr = (const f32x4*)(X + (size_t)m * D) + lane;
        f32x4 v[4]; float s = 0.f;
#pragma unroll
        for (int j = 0; j < 4; ++j) { v[j] = xr[64 * j]; s += (v[j].x * v[j].x + v[j].y * v[j].y) + (v[j].z * v[j].z + v[j].w * v[j].w); }
        s = wave_sum(s);
        unsigned long long* o8 = (unsigned long long*)(XS + (size_t)m * D) + lane;
#pragma unroll
        for (int j = 0; j < 4; ++j) o8[64 * j] = (unsigned long long)pk2(v[j].x, v[j].y) | ((unsigned long long)pk2(v[j].z, v[j].w) << 32);
        if (lane < 4) rss[(size_t)lane * 32768 + m] = lane == 0 ? s : 0.f;
    }
}
__device__ __forceinline__ void final_norm_rows(const bf16* XS, float* OUT, const float* g, const float* rss, int gw, int ngw, int lane) {
    f32x4 gv[4];
#pragma unroll
    for (int j = 0; j < 4; ++j) gv[j] = ((const f32x4*)g)[lane + 64 * j];
#pragma unroll 4
    for (int m = gw; m < M; m += ngw) {
        const v2u* xr = (const v2u*)(XS + (size_t)m * D) + lane; f32x4* orow = (f32x4*)(OUT + (size_t)m * D) + lane;
        const float rstd = rsqrtf(((rss[m] + rss[32768 + m]) + (rss[65536 + m] + rss[98304 + m])) * (1.f / D) + EPS);
#pragma unroll
        for (int j = 0; j < 4; ++j) { const v2u w = xr[64 * j]; orow[64 * j] = (f32x4){bflo(w.x), bfhi(w.x), bflo(w.y), bfhi(w.y)} * rstd * gv[j]; }
    }
}

__device__ __forceinline__ void unpack8(const v4u w, float (&f)[8]) {
    f[0] = bflo(w.x); f[1] = bfhi(w.x); f[2] = bflo(w.y); f[3] = bfhi(w.y); f[4] = bflo(w.z); f[5] = bfhi(w.z); f[6] = bflo(w.w); f[7] = bfhi(w.w);
}
__device__ __forceinline__ void ab_mixer(const bf16* H, bf16* CAT, const float* pool_b, const float* pool_scale, const float* scw, const float* scb, int wg, int nwg, int tid) {
    const int cv = tid & 127, sub = tid >> 7;
    float pa[8], pb[8], pc[8], pd[8];
    if (cv < 64) {
#pragma unroll
        for (int e = 0; e < 8; ++e) { pa[e] = pool_b[cv * 8 + e]; pb[e] = pool_scale[cv * 8 + e]; pc[e] = 0.f; pd[e] = 0.f; }
    } else {
        const int c = (cv - 64) * 8;
#pragma unroll
        for (int e = 0; e < 8; ++e) { pa[e] = scw[c + e]; pb[e] = scw[512 + c + e]; pc[e] = scw[1024 + c + e]; pd[e] = scb[c + e]; }
    }
    for (int chunk = wg * 4 + sub; chunk < M / 32; chunk += nwg * 4) {
        const int r0 = chunk * 32, t0 = r0 & (SEQ - 1);
        bf16* outp = CAT + (size_t)r0 * D + cv * 8;
        if (cv < 64) {
            const int win = 2 << (cv >> 4);
            const bf16* p = H + (size_t)r0 * NAB + cv * 8;
            float s[8], f[8];
#pragma unroll
            for (int e = 0; e < 8; ++e) s[e] = 0.f;
            if (t0 > 0) for (int i = 1; i < win; ++i) { unpack8(*(const v4u*)(p - (size_t)i * NAB), f);
#pragma unroll
                for (int e = 0; e < 8; ++e) s[e] += f[e]; }
#pragma unroll 4
            for (int jr = 0; jr < 32; ++jr) {
                const int t = t0 + jr; float cur[8], y[8];
                unpack8(*(const v4u*)(p + (size_t)jr * NAB), cur);
                if (jr >= 1 && t >= win) { unpack8(*(const v4u*)(p + (ptrdiff_t)(jr - win) * NAB), f);
#pragma unroll
                    for (int e = 0; e < 8; ++e) s[e] -= f[e]; }
#pragma unroll
                for (int e = 0; e < 8; ++e) s[e] += cur[e];
                const float inv = 1.f / (float)((t + 1) < win ? (t + 1) : win);
#pragma unroll
                for (int e = 0; e < 8; ++e) y[e] = (s[e] * inv - cur[e] + pa[e]) * pb[e];
                v4u o; o.x = pk2(y[0], y[1]); o.y = pk2(y[2], y[3]); o.z = pk2(y[4], y[5]); o.w = pk2(y[6], y[7]);
                *(v4u*)(outp + (size_t)jr * D) = o;
            }
        } else {
            const bf16* p = H + (size_t)r0 * NAB + (cv - 64) * 8;
            float p1[8], p2[8], a[8], b[8];
#pragma unroll
            for (int e = 0; e < 8; ++e) { p1[e] = 0.f; p2[e] = 0.f; }
            if (t0 > 0) { unpack8(*(const v4u*)(p - NAB + 1024), a); unpack8(*(const v4u*)(p - NAB + 1536), b);
#pragma unroll
                for (int e = 0; e < 8; ++e) p1[e] = a[e] * b[e];
                unpack8(*(const v4u*)(p - 2 * NAB + 1024), a); unpack8(*(const v4u*)(p - 2 * NAB + 1536), b);
#pragma unroll
                for (int e = 0; e < 8; ++e) p2[e] = a[e] * b[e]; }
#pragma unroll 4
            for (int jr = 0; jr < 32; ++jr) {
                float sb[8], y[8];
                unpack8(*(const v4u*)(p + (size_t)jr * NAB + 512), sb); unpack8(*(const v4u*)(p + (size_t)jr * NAB + 1024), a); unpack8(*(const v4u*)(p + (size_t)jr * NAB + 1536), b);
#pragma unroll
                for (int e = 0; e < 8; ++e) { const float pr = a[e] * b[e]; y[e] = sb[e] * (pd[e] + pc[e] * pr + pb[e] * p1[e] + pa[e] * p2[e]); p2[e] = p1[e]; p1[e] = pr; }
                v4u o; o.x = pk2(y[0], y[1]); o.y = pk2(y[2], y[3]); o.z = pk2(y[4], y[5]); o.w = pk2(y[6], y[7]);
                *(v4u*)(outp + (size_t)jr * D) = o;
            }
        }
    }
}

__device__ __forceinline__ float gate_log(float z) { return (fminf(z, 0.f) - __logf(1.f + __expf(-fabsf(z)))) * (1.f / 16.f); }
__device__ __forceinline__ void gla_prep(bf16* H, bf16* KDT, float* DEC, const float* b_g, int wg, int nwg, int tid) {
    const int half = tid >> 8, cp = tid & 255, c = 2 * cp;
    const float bg0 = b_g[c], bg1 = b_g[c + 1];
    const float QS = 0.08838834764831845f;
    for (int it = wg * 2 + half; it < BATCH * 64; it += nwg * 2) {
        bf16* base = H + (size_t)it * 64 * NGLA + c;
        unsigned cg[8], cq[8], ck[8], ng[8], nq[8], nk[8];
#pragma unroll
        for (int m = 0; m < 8; ++m) { const bf16* rp = base + (size_t)m * NGLA; cg[m] = *(const unsigned*)(rp + 3072); cq[m] = *(const unsigned*)rp; ck[m] = *(const unsigned*)(rp + 512); }
        float c0 = 0.f, c1 = 0.f;
        for (int g = 0; g < 8; ++g) {
            bf16* gb = base + (size_t)(g * 8) * NGLA;
            if (g < 7) {
#pragma unroll
                for (int m = 0; m < 8; ++m) { const bf16* rp = gb + (size_t)(8 + m) * NGLA; ng[m] = *(const unsigned*)(rp + 3072); nq[m] = *(const unsigned*)rp; nk[m] = *(const unsigned*)(rp + 512); }
            }
#pragma unroll
            for (int m = 0; m < 8; ++m) { bf16* rp = gb + (size_t)m * NGLA;
                c0 += gate_log(bflo(cg[m]) + bg0); c1 += gate_log(bfhi(cg[m]) + bg1);
                const float d0 = bflo(ck[m]) * __expf(-c0), d1 = bfhi(ck[m]) * __expf(-c1);
                *(unsigned*)rp = pk2(bflo(cq[m]) * QS * __expf(c0), bfhi(cq[m]) * QS * __expf(c1));
                *(unsigned*)(rp + 512) = pk2(d0, d1);
            }
#pragma unroll
            for (int m = 0; m < 8; ++m) { cg[m] = ng[m]; cq[m] = nq[m]; ck[m] = nk[m]; }
        }
        *(f32x2*)(DEC + (size_t)it * 512 + c) = (f32x2){__expf(c0), __expf(c1)};
    }
}

constexpr int QP = 136, VP = 40;
constexpr int L_Q = 0, L_K = L_Q + 64 * QP * 2, L_V = L_K + 64 * QP * 2, L_ST = L_V + 64 * VP * 2, L_SCAN_END = L_ST + 2 * 32 * QP * 2;
static_assert(L_SCAN_END <= XCH_OFF, "scan LDS");
typedef short v4i16_t __attribute__((ext_vector_type(4)));
__device__ __forceinline__ bf16x8 ldfrag(const LAS unsigned char* p) { return *(const LAS bf16x8*)p; }
__device__ __forceinline__ v4i16_t ldtr(const LAS unsigned char* img, int pitch, int row0, int col0, int l16) {
    return __builtin_amdgcn_ds_read_tr16_b64_v4i16((LAS v4i16_t*)(img + (row0 + (l16 >> 2)) * pitch + (col0 + 4 * (l16 & 3)) * 2)); }
__device__ __forceinline__ bf16x8 cat8(v4i16_t a, v4i16_t b) { return __builtin_shufflevector(a, b, 0, 1, 2, 3, 4, 5, 6, 7); }
__device__ __forceinline__ void gla_scan(LAS unsigned char* lds, const bf16* H, const float* DEC, bf16* O, int wg, int nwg, int tid) {
    const int wave = __builtin_amdgcn_readfirstlane(tid >> 6), lane = tid & 63, l16 = lane & 15, lq = lane >> 4;
    for (int item = wg; item < 256; item += nwg) {
        const int x = item & 7, j = item >> 3, bh = x * 4 + (j >> 3), vs = j & 7, b = bh >> 2, h = bh & 3;
        __syncthreads();
        for (int i = tid; i < 2 * 32 * QP / 2; i += NTHR) ((LAS unsigned*)(lds + L_ST))[i] = 0u;
        f32x4 S[2][2];
#pragma unroll
        for (int bq = 0; bq < 2; ++bq)
#pragma unroll
            for (int jv = 0; jv < 2; ++jv) S[bq][jv] = (f32x4){0.f, 0.f, 0.f, 0.f};
        const int hb = (wave & 3) * 2;
        const int r0 = tid >> 4, c16 = tid & 15, mv = (tid & 255) >> 2, c8v = tid & 3;
        const bf16* pq = H + ((size_t)b * SEQ + r0) * NGLA + h * 128 + c16 * 8;
        const bf16* pv = H + ((size_t)b * SEQ + mv) * NGLA + 1024 + h * 256 + vs * 32 + c8v * 8;
        const float* pdec = DEC + ((size_t)(b * 64)) * 512 + h * 128 + 16 * hb + 4 * lq;
        v4u rq0 = *(const v4u*)pq, rq1 = *(const v4u*)(pq + (size_t)32 * NGLA), rk0 = *(const v4u*)(pq + 512), rk1 = *(const v4u*)(pq + (size_t)32 * NGLA + 512);
        v4u rv = *(const v4u*)pv;
        f32x4 rdec0 = *(const f32x4*)pdec, rdec1 = *(const f32x4*)(pdec + 16);
        for (int n = 0; n < 64; ++n) {
            const size_t row0 = (size_t)b * SEQ + n * 64;
            *(LAS v4u*)(lds + L_Q + (r0 * QP + c16 * 8) * 2) = rq0; *(LAS v4u*)(lds + L_Q + ((r0 + 32) * QP + c16 * 8) * 2) = rq1;
            *(LAS v4u*)(lds + L_K + (r0 * QP + c16 * 8) * 2) = rk0; *(LAS v4u*)(lds + L_K + ((r0 + 32) * QP + c16 * 8) * 2) = rk1;
            if (tid < 256) *(LAS v4u*)(lds + L_V + (mv * VP + c8v * 8) * 2) = rv;
            const f32x4 dec0 = rdec0, dec1 = rdec1;
            __syncthreads();
            if (n + 1 < 64) {
                pq += (size_t)64 * NGLA; pv += (size_t)64 * NGLA; pdec += 512;
                rq0 = *(const v4u*)pq; rq1 = *(const v4u*)(pq + (size_t)32 * NGLA); rk0 = *(const v4u*)(pq + 512); rk1 = *(const v4u*)(pq + (size_t)32 * NGLA + 512);
                rv = *(const v4u*)pv; rdec0 = *(const f32x4*)pdec; rdec1 = *(const f32x4*)(pdec + 16);
            }
            if (wave < 4) {
                const int qi = wave; f32x4 o[2] = {(f32x4){0.f, 0.f, 0.f, 0.f}, (f32x4){0.f, 0.f, 0.f, 0.f}};
                bf16x8 qf[4];
#pragma unroll
                for (int kk = 0; kk < 4; ++kk) qf[kk] = ldfrag(lds + L_Q + ((16 * qi + l16) * QP + kk * 32 + lq * 8) * 2);
#pragma unroll
                for (int t = 0; t < 2; ++t) if (2 * t <= qi) {
                    f32x4 a0 = (f32x4){0.f, 0.f, 0.f, 0.f}, a1 = a0;
#pragma unroll
                    for (int kk = 0; kk < 4; ++kk) a0 = __builtin_amdgcn_mfma_f32_16x16x32_bf16(ldfrag(lds + L_K + ((32 * t + l16) * QP + kk * 32 + lq * 8) * 2), qf[kk], a0, 0, 0, 0);
                    if (2 * t == qi) {
#pragma unroll
                        for (int ii = 0; ii < 4; ++ii) if (4 * lq + ii > l16) a0[ii] = 0.f; }
                    if (2 * t + 1 <= qi) {
#pragma unroll
                        for (int kk = 0; kk < 4; ++kk) a1 = __builtin_amdgcn_mfma_f32_16x16x32_bf16(ldfrag(lds + L_K + ((32 * t + 16 + l16) * QP + kk * 32 + lq * 8) * 2), qf[kk], a1, 0, 0, 0);
                        if (2 * t + 1 == qi) {
#pragma unroll
                            for (int ii = 0; ii < 4; ++ii) if (4 * lq + ii > l16) a1[ii] = 0.f; } }
                    const v4u bw = (v4u){pk2(a0[0], a0[1]), pk2(a0[2], a0[3]), pk2(a1[0], a1[1]), pk2(a1[2], a1[3])};
#pragma unroll
                    for (int jv = 0; jv < 2; ++jv) {
                        const bf16x8 aw = cat8(ldtr(lds + L_V, VP * 2, 32 * t + 4 * lq, 16 * jv, l16), ldtr(lds + L_V, VP * 2, 32 * t + 16 + 4 * lq, 16 * jv, l16));
                        o[jv] = __builtin_amdgcn_mfma_f32_16x16x32_bf16(aw, __builtin_bit_cast(bf16x8, bw), o[jv], 0, 0, 0); } }
#pragma unroll
                for (int jv = 0; jv < 2; ++jv) {
#pragma unroll
                    for (int kk = 0; kk < 4; ++kk) o[jv] = __builtin_amdgcn_mfma_f32_16x16x32_bf16(ldfrag(lds + L_ST + ((n & 1) * 32 * QP + (16 * jv + l16) * QP + kk * 32 + lq * 8) * 2), qf[kk], o[jv], 0, 0, 0);
                    *(v2u*)(O + (row0 + 16 * qi + l16) * D + h * 256 + vs * 32 + 16 * jv + 4 * lq) = (v2u){pk2(o[jv][0], o[jv][1]), pk2(o[jv][2], o[jv][3])}; }
            } else {
#pragma unroll
                for (int kk = 0; kk < 2; ++kk) {
                    bf16x8 vb[2];
#pragma unroll
                    for (int jv = 0; jv < 2; ++jv) vb[jv] = cat8(ldtr(lds + L_V, VP * 2, 32 * kk + 8 * lq, 16 * jv, l16), ldtr(lds + L_V, VP * 2, 32 * kk + 8 * lq + 4, 16 * jv, l16));
#pragma unroll
                    for (int bq = 0; bq < 2; ++bq) { const bf16x8 ka = cat8(ldtr(lds + L_K, QP * 2, 32 * kk + 8 * lq, 16 * (hb + bq), l16), ldtr(lds + L_K, QP * 2, 32 * kk + 8 * lq + 4, 16 * (hb + bq), l16));
#pragma unroll
                        for (int jv = 0; jv < 2; ++jv) S[bq][jv] = __builtin_amdgcn_mfma_f32_16x16x32_bf16(ka, vb[jv], S[bq][jv], 0, 0, 0); } }
#pragma unroll
                for (int bq = 0; bq < 2; ++bq)
#pragma unroll
                    for (int jv = 0; jv < 2; ++jv) { S[bq][jv] = S[bq][jv] * (bq ? dec1 : dec0);
                        *(LAS v2u*)(lds + L_ST + (((n + 1) & 1) * 32 * QP + (16 * jv + l16) * QP + 16 * (hb + bq) + 4 * lq) * 2) = (v2u){pk2(S[bq][jv][0], S[bq][jv][1]), pk2(S[bq][jv][2], S[bq][jv][3])}; }
            }
            __syncthreads();
        }
    }
}
__device__ __forceinline__ void gla_post(const bf16* O, const bf16* H, bf16* CAT, const float* gnorm, int gw, int ngw, int lane) {
    const int hs = lane >> 5, cl = (lane & 31) * 8;
    float gn[8];
#pragma unroll
    for (int e = 0; e < 8; ++e) gn[e] = gnorm[cl + e];
#pragma unroll 2
    for (int m = gw; m < M; m += ngw) {
        v4u ow[2], rw[2];
#pragma unroll
        for (int p = 0; p < 2; ++p) { ow[p] = *(const v4u*)(O + (size_t)m * D + (hs + 2 * p) * 256 + cl); rw[p] = *(const v4u*)(H + (size_t)m * NGLA + 2048 + (hs + 2 * p) * 256 + cl); }
#pragma unroll
        for (int p = 0; p < 2; ++p) { float o[8], r[8], y[8]; unpack8(ow[p], o); unpack8(rw[p], r);
            float ss = 0.f;
#pragma unroll
            for (int e = 0; e < 8; ++e) ss += o[e] * o[e];
#pragma unroll
            for (int sh = 1; sh < 32; sh <<= 1) ss += __shfl_xor(ss, sh);
            const float rs = rsqrtf(ss * (1.f / 256.f) + EPS);
#pragma unroll
            for (int e = 0; e < 8; ++e) y[e] = o[e] * rs * gn[e] * (r[e] / (1.f + __expf(-r[e])));
            *(v4u*)(CAT + (size_t)m * D + (hs + 2 * p) * 256 + cl) = (v4u){pk2(y[0], y[1]), pk2(y[2], y[3]), pk2(y[4], y[5]), pk2(y[6], y[7])}; }
    }
}

#define XB_TMO      128
#define XB_XCNT(j)  (256  + 64 * (j))
#define XB_XSUB(j)  (1280 + 64 * (j))
#define XB_XGEN(j)  (2304 + 64 * (j))
#define XB_TOP      3328
#define XB_TOPGEN   3392
#define XCD_BAR_WORDS 3456
#define XB_SPIN_CAP (1u << 18)

__device__ __forceinline__ unsigned xb_ld(unsigned* p)              { return __hip_atomic_load(p, __ATOMIC_RELAXED, __HIP_MEMORY_SCOPE_AGENT); }
__device__ __forceinline__ unsigned xb_add(unsigned* p, unsigned v) { return __hip_atomic_fetch_add(p, v, __ATOMIC_RELAXED, __HIP_MEMORY_SCOPE_AGENT); }
__device__ __forceinline__ unsigned xb_xcc_id() { return (unsigned)__builtin_amdgcn_s_getreg((3 << 11) | 20) & 0xFu; }
#define XB_SPIN(cond, bar) do { unsigned _sp = 0; while (cond) { __builtin_amdgcn_s_sleep(1); \
    if ((++_sp & 255u) == 0u) { if (xb_ld(&(bar)[XB_TMO])) break; if (_sp > XB_SPIN_CAP) { atomicAdd(&(bar)[XB_TMO], 1u); break; } } } } while (0)

struct XcdBarrier {
    unsigned* bar; unsigned x;
    volatile LAS unsigned* st;
};

__device__ __forceinline__ XcdBarrier xcd_barrier_post(unsigned* bar, volatile LAS unsigned* st) {
    XcdBarrier b; b.bar = bar; b.x = xb_xcc_id(); b.st = st;
    if (threadIdx.x == 0) (void)xb_add(&bar[XB_XCNT(b.x)], 1u);
    return b;
}
__device__ __forceinline__ void xcd_barrier_complete(unsigned* bar, unsigned x, unsigned& nloc, unsigned& nx) {
    const unsigned G = gridDim.x * gridDim.y * gridDim.z;
    unsigned sum, cnt, mine, sp = 0u;
    for (;;) {
        sum = 0u; cnt = 0u; mine = 0u;
#pragma unroll
        for (unsigned j = 0; j < 16; ++j) { const unsigned c = xb_ld(&bar[XB_XCNT(j)]); sum += c; cnt += (c > 0u) ? 1u : 0u; mine = (j == x) ? c : mine; }
        if (sum == G) break;
        __builtin_amdgcn_s_sleep(1);
        if ((++sp & 255u) == 0u) { if (xb_ld(&bar[XB_TMO])) break; if (sp > XB_SPIN_CAP) { atomicAdd(&bar[XB_TMO], 1u); break; } }
    }
    nloc = mine > 0u ? mine : 1u; nx = cnt > 0u ? cnt : 1u;
}

__device__ __forceinline__ void xcd_barrier(const XcdBarrier& b) {
    asm volatile("s_waitcnt vmcnt(0)" ::: "memory");
    __syncthreads();
    if (threadIdx.x == 0) {
        unsigned* bar = b.bar;
        __builtin_amdgcn_s_waitcnt(0);
        unsigned nloc = b.st[0], nx = b.st[1];
        if (nloc == 0u) { xcd_barrier_complete(bar, b.x, nloc, nx); b.st[0] = nloc; b.st[1] = nx; }
        const unsigned old = xb_add(&bar[XB_XSUB(b.x)], 1u);
        const unsigned gen = old / nloc;
        if (old + 1u == (gen + 1u) * nloc) {
            __builtin_amdgcn_fence(__ATOMIC_RELEASE, "agent");
            asm volatile("s_waitcnt vmcnt(0)" ::: "memory");
            const unsigned og = xb_add(&bar[XB_TOP], 1u);
            const unsigned tg = og / nx;
            if (og + 1u == (tg + 1u) * nx) xb_add(&bar[XB_TOPGEN], 1u);
            else XB_SPIN(xb_ld(&bar[XB_TOPGEN]) == tg, bar);
            __builtin_amdgcn_fence(__ATOMIC_ACQUIRE, "agent");
            xb_add(&bar[XB_XGEN(b.x)], 1u);
            asm volatile("s_waitcnt vmcnt(0)" ::: "memory");
        } else {
            XB_SPIN(xb_ld(&bar[XB_XGEN(b.x)]) == gen, bar);
            __builtin_amdgcn_fence(__ATOMIC_ACQUIRE, "agent");
            asm volatile("s_waitcnt vmcnt(0)" ::: "memory");
        }
    }
    __syncthreads();
}

#define GRID_SYNC() do { XcdBarrier b_; b_.bar = (unsigned*)(GAS unsigned*)karg(21); b_.x = xb_xcc_id(); b_.st = (volatile LAS unsigned*)(lds + MISC_OFF); xcd_barrier(b_); } while (0)
constexpr int MISC_OFF = XCH_OFF + 8192;
#define GAS __attribute__((address_space(1)))
typedef const __attribute__((address_space(4))) unsigned long long* kaptr_t;
__device__ __forceinline__ unsigned long long karg(int k) { kaptr_t p = (kaptr_t)__builtin_amdgcn_kernarg_segment_ptr(); asm volatile("" : "+s"(p)); return p[k]; }
#define INF(k) ((const float*)(const GAS float*)karg(k))
#define XOUT() ((float*)(GAS float*)karg(20))
#define WSB(off) ((bf16*)(GAS bf16*)(karg(21) + (off)))
#define WSF(off) ((float*)(GAS float*)(karg(21) + (off)))
#define RSSP(i) WSF(60 * MiB + (size_t)(i) * 524288)
__global__ void __launch_bounds__(NTHR, 2) fwd_megakernel(Args args) {
    extern __shared__ __attribute__((aligned(16))) unsigned char lds_raw[];
    cg::grid_group grid = cg::this_grid();
    LAS unsigned char* lds = (LAS unsigned char*)lds_raw;
    { const int tid = threadIdx.x; if (tid < 2) ((LAS unsigned*)(lds + MISC_OFF))[tid] = 0u; }
    __syncthreads();
    grid.sync();
    (void)xcd_barrier_post((unsigned*)(GAS unsigned*)karg(21), (volatile LAS unsigned*)(lds + MISC_OFF));
    (void)args;
#define WAVE_IDS() const int tid_ = fresh_tid(), lane = tid_ & 63, wave = __builtin_amdgcn_readfirstlane(tid_ >> 6), G = gridDim.x, wg = blockIdx.x, gw = wg * NWAVES + wave, ngw = G * NWAVES

    {
        WAVE_IDS();
        LAS float* scr = (LAS float*)(lds + wave * 16384);
        constexpr int I_ABIN = 16 * 48, I_ABOUT = 16 * 32, I_GLAIN = 16 * 96, I_GLAOUT = 16 * 32, I_UP = 16 * 176, I_DN = 44 * 32;
        constexpr int NITEMS = I_ABIN + I_ABOUT + I_GLAIN + I_GLAOUT + 2 * I_UP + 2 * I_DN;
        for (int it = gw; it < NITEMS; it += ngw) {
            int r = it;
            if (r < I_ABIN) { const int kb = r / 48, nb = r % 48; transpose_item(INF(3), NAB, D, WSB(WS_WABIN), kb * 64, 512 + nb * 32, 512 + nb * 32, scr, lane, INF(1)); continue; } r -= I_ABIN;
            if (r < I_ABOUT) { const int kb = r / 32, nb = r % 32; transpose_item(INF(9), D, D, WSB(WS_WABOUT), kb * 64, nb * 32, nb * 32, scr, lane); continue; } r -= I_ABOUT;
            if (r < I_GLAIN) { const int kb = r / 96, nb = r % 96; transpose_item(INF(10), GLA_SRC_N, D, WSB(WS_WGLAIN), kb * 64, nb * 32, nb * 32, scr, lane, INF(1) + D); continue; } r -= I_GLAIN;
            if (r < I_GLAOUT) { const int kb = r / 32, nb = r % 32; transpose_item(INF(14), D, D, WSB(WS_WGLAOUT), kb * 64, nb * 32, nb * 32, scr, lane); continue; } r -= I_GLAOUT;
            if (r < 2 * I_UP) { const int l = r / I_UP, q = r % I_UP, kb = q / 176, nb = q % 176, n0 = nb * 32, isv = n0 >= FFD, ch = isv ? n0 - FFD : n0;
                transpose_item(INF(15) + (size_t)l * D * NUP, NUP, D, WSB(WS_WUP) + (size_t)l * NUP * D, kb * 64, n0, (ch >> 7) * 256 + isv * 128 + (ch & 127), scr, lane, INF(2) + (size_t)l * D); continue; } r -= 2 * I_UP;
            { const int l = r / I_DN, q = r % I_DN, kb = q / 32, nb = q % 32;
                transpose_item(INF(18) + (size_t)l * FFD * D, D, FFD, WSB(WS_WDN) + (size_t)l * D * FFD, kb * 64, nb * 32, nb * 32, scr, lane); }
        }
        { const float* abin = INF(3); const float* poolw = INF(4); const float* glain = INF(10); const float* wg2 = INF(11); const float* mn1 = INF(1) + D; const float* mn0 = INF(1); bf16* W_ABIN = WSB(WS_WABIN); bf16* W_GLAIN = WSB(WS_WGLAIN);
        for (int idx = wg * NTHR + tid_; idx < 256 * 512; idx += G * NTHR) {
            const int k4 = idx >> 9, n = idx & 511, g = n >> 7, nn = n & 127;
            const float* wi = abin + (size_t)(4 * k4) * NAB + g * 128; const float* pw = poolw + (size_t)g * 128 * 128 + nn;
            float s0 = 0.f, s1 = 0.f, s2 = 0.f, s3 = 0.f;
#pragma unroll 8
            for (int c = 0; c < 128; ++c) { const float w = pw[c * 128]; s0 += wi[c] * w; s1 += wi[NAB + c] * w; s2 += wi[2 * NAB + c] * w; s3 += wi[3 * NAB + c] * w; }
            { const f32x4 m0 = *(const f32x4*)(mn0 + 4 * k4); *(v2u*)(W_ABIN + (size_t)n * D + 4 * k4) = (v2u){pk2(s0 * m0[0], s1 * m0[1]), pk2(s2 * m0[2], s3 * m0[3])}; }
            const float* gi = glain + (size_t)(4 * k4) * GLA_SRC_N + 3072; const float* g2 = wg2 + n;
            float t0 = 0.f, t1 = 0.f, t2 = 0.f, t3 = 0.f;
#pragma unroll
            for (int r = 0; r < 16; ++r) { const float w = g2[r * 512]; t0 += gi[r] * w; t1 += gi[GLA_SRC_N + r] * w; t2 += gi[2 * GLA_SRC_N + r] * w; t3 += gi[3 * GLA_SRC_N + r] * w; }
            const f32x4 mg = *(const f32x4*)(mn1 + 4 * k4);
            *(v2u*)(W_GLAIN + (size_t)(3072 + n) * D + 4 * k4) = (v2u){pk2(t0 * mg[0], t1 * mg[1]), pk2(t2 * mg[2], t3 * mg[3])};
        } }
        convert_rows(INF(0), WSB(WS_XS), RSSP(4), gw, ngw, lane);
    }
    GRID_SYNC();

    for (int l = 0; l < 2; ++l) {
        { const int N = (l == 0) ? NAB : NGLA;
          pg8::Gemm g{WSB(WS_XS), (l == 0) ? WSB(WS_WABIN) : WSB(WS_WGLAIN), M, N, D}; pg8::StaticOrder S; S.init(M, N, gridDim.x, blockIdx.x);
          pg8::EpiBf16P E{WSB(WS_H), N, (l == 0) ? (const float*)RSSP(4) : (const float*)RSSP(1), (LAS float*)(lds + XCH_OFF)};
          if (PHM & 1) pg8::gemm_phase<pg8::EpiBf16P, pg8::StaticOrder, true, true>(lds, g, S, E); }
        GRID_SYNC();
        if (l == 0) {
            if (PHM & 2) ab_mixer(WSB(WS_H), WSB(WS_CAT), INF(5), INF(6), INF(7), INF(8), blockIdx.x, gridDim.x, fresh_tid());
        } else {
            if (PHM & 4) gla_prep(WSB(WS_H), WSB(WS_CAT), WSF(WS_DEC), INF(12), blockIdx.x, gridDim.x, fresh_tid());
            GRID_SYNC();
            if (PHM & 8) gla_scan(lds, WSB(WS_H), WSF(WS_DEC), WSB(WS_XN), blockIdx.x, gridDim.x, fresh_tid());
            GRID_SYNC();
            { WAVE_IDS(); if (PHM & 16) gla_post(WSB(WS_XN), WSB(WS_H), WSB(WS_CAT), INF(13), gw, ngw, lane); }
        }
        GRID_SYNC();
        { pg8::Gemm g{WSB(WS_CAT), (l == 0) ? WSB(WS_WABOUT) : WSB(WS_WGLAOUT), M, D, D}; pg8::StaticOrder S; S.init(M, D, gridDim.x, blockIdx.x);
          pg8::EpiRes E{(const float*)nullptr, WSB(WS_XS), D, RSSP(2 * l), (LAS float*)(lds + XCH_OFF)};
          if (PHM & 32) pg8::gemm_phase<pg8::EpiRes, pg8::StaticOrder, true, true>(lds, g, S, E); }
        GRID_SYNC();
        { pg8::Gemm g{WSB(WS_XS), WSB(WS_WUP) + (size_t)l * NUP * D, M, NUP, D}; pg8::StaticOrder S; S.init(M, NUP, gridDim.x, blockIdx.x);
          pg8::EpiFfnUp E{WSB(WS_H), INF(16) + (size_t)l * 3 * FFD, INF(17) + (size_t)l * FFD, WSF(WS_ULAST), WSF(WS_UFIRST), WSF(WS_VFIRST), (LAS f32x4*)(lds + XCH_OFF), RSSP(2 * l)};
          if (PHM & 64) pg8::gemm_phase<pg8::EpiFfnUp, pg8::StaticOrder, true, true, true>(lds, g, S, E); }
        GRID_SYNC();
        { pg8::Gemm g{WSB(WS_H), WSB(WS_WDN) + (size_t)l * D * FFD, M, D, FFD}; pg8::StaticOrder S; S.init(M, D, gridDim.x, blockIdx.x);
          if (PHM & 256) {
          const float* cw = INF(16) + (size_t)l * 3 * FFD; const float* cb = INF(17) + (size_t)l * FFD;
          const float* ULAST = WSF(WS_ULAST); const float* UFIRST = WSF(WS_UFIRST); const float* VFIRST = WSF(WS_VFIRST); bf16* ACT = WSB(WS_H);
          pg8::Unit u;
          for (int i = 0; S.next(i, u); ++i) {
              if ((u.pm & 15) == 0) continue;
              for (int c4 = fresh_tid(); c4 < FFD / 4; c4 += NTHR) {
                  const int ch = 4 * c4;
                  const f32x4 uf0 = *(const f32x4*)(UFIRST + (size_t)(u.pm * 2) * FFD + ch), uf1 = *(const f32x4*)(UFIRST + (size_t)(u.pm * 2 + 1) * FFD + ch);
                  const f32x4 ul0 = *(const f32x4*)(ULAST + (size_t)((u.pm - 1) * 2) * FFD + ch), ul1 = *(const f32x4*)(ULAST + (size_t)((u.pm - 1) * 2 + 1) * FFD + ch);
                  const f32x4 vf0 = *(const f32x4*)(VFIRST + (size_t)(u.pm * 2) * FFD + ch), vf1 = *(const f32x4*)(VFIRST + (size_t)(u.pm * 2 + 1) * FFD + ch);
                  const f32x4 a0 = *(const f32x4*)(cw + ch), a1 = *(const f32x4*)(cw + FFD + ch), a2 = *(const f32x4*)(cw + 2 * FFD + ch), bb = *(const f32x4*)(cb + ch);
                  const f32x4 u0 = bb + a0 * ul0 + a1 * ul1 + a2 * uf0, u1 = bb + a0 * ul1 + a1 * uf0 + a2 * uf1;
                  const f32x2 g00 = pg8::gelu_pk((f32x2){u0[0], u0[1]}), g01 = pg8::gelu_pk((f32x2){u0[2], u0[3]}), g10 = pg8::gelu_pk((f32x2){u1[0], u1[1]}), g11 = pg8::gelu_pk((f32x2){u1[2], u1[3]});
                  *(v2u*)(ACT + (size_t)(u.pm * 256) * FFD + ch) = (v2u){pk2(g00.x * vf0[0], g00.y * vf0[1]), pk2(g01.x * vf0[2], g01.y * vf0[3])};
                  *(v2u*)(ACT + (size_t)(u.pm * 256 + 1) * FFD + ch) = (v2u){pk2(g10.x * vf1[0], g10.y * vf1[1]), pk2(g11.x * vf1[2], g11.y * vf1[3])};
              }
          }
          asm volatile("s_waitcnt vmcnt(0)" ::: "memory"); __syncthreads();
          }
          if (l == 0 || gridDim.x != 256) { pg8::EpiRes E{(const float*)nullptr, WSB(WS_XS), D, RSSP(2 * l + 1), (LAS float*)(lds + XCH_OFF)};
              pg8::gemm_phase<pg8::EpiRes, pg8::StaticOrder, true, true>(lds, g, S, E); }
          else { pg8::EpiResFinal E{WSB(WS_XS), XOUT(), D, RSSP(3), INF(19), (unsigned*)(GAS unsigned*)(karg(21) + 16384), (LAS float*)(lds + XCH_OFF)};
              pg8::gemm_phase<pg8::EpiResFinal, pg8::StaticOrder, true, true>(lds, g, S, E); } }
        if (l == 0) GRID_SYNC();
    }
    if (gridDim.x != 256) { GRID_SYNC(); WAVE_IDS(); final_norm_rows(WSB(WS_XS), XOUT(), INF(19), RSSP(3), gw, ngw, lane); }
}

extern "C" void kernel_launch(void* const* d_in, const int* in_sizes, int n_in, void* d_out, int out_size, void* d_ws, size_t ws_size, hipStream_t stream) {
    static int grid_blocks = 0;
    if (grid_blocks == 0) {
        if (n_in != 20 || out_size != M * D || ws_size < WS_END) { fprintf(stderr, "kernel_launch: unexpected shapes (n_in %d out %d ws %zu)\n", n_in, out_size, ws_size); grid_blocks = -1; return; }
        int dev = 0, cus = 0, per_cu = 0;
        hipGetDevice(&dev); hipDeviceGetAttribute(&cus, hipDeviceAttributeMultiprocessorCount, dev);
        if (hipFuncSetAttribute((const void*)fwd_megakernel, hipFuncAttributeMaxDynamicSharedMemorySize, LDS_BYTES) != hipSuccess) fprintf(stderr, "kernel_launch: hipFuncSetAttribute failed\n");
        if (hipOccupancyMaxActiveBlocksPerMultiprocessor(&per_cu, (const void*)fwd_megakernel, NTHR, LDS_BYTES) != hipSuccess || per_cu < 1) { fprintf(stderr, "kernel_launch: occupancy query says %d\n", per_cu); per_cu = 1; }
        (void)hipGetLastError();
        grid_blocks = cus * per_cu;
    }
    if (grid_blocks < 0) return;
    if (hipMemsetAsync(d_ws, 0, 65536, stream) != hipSuccess) { fprintf(stderr, "kernel_launch: memset failed\n"); return; }
    Args a{};
    for (int i = 0; i < 20; ++i) a.in[i] = (const float*)d_in[i];
    a.out = (float*)d_out; a.ws = (unsigned char*)d_ws;
    void* kargs[] = {&a};
    hipError_t e = hipLaunchCooperativeKernel((const void*)fwd_megakernel, dim3(grid_blocks), dim3(NTHR), kargs, LDS_BYTES, stream);
    if (e != hipSuccess) fprintf(stderr, "cooperative launch failed: %s (grid %d)\n", hipGetErrorString(e), grid_blocks);
}
```

```cpp
#include <hip/hip_runtime.h>
#include <hip/hip_cooperative_groups.h>
#include <cstdio>
#include <cstdint>
namespace cg = cooperative_groups;
__device__ __forceinline__ int fresh_tid() { int t = threadIdx.x; asm volatile("" : "+v"(t)); return t; }
namespace pg8 {
#define PG8_LAS __attribute__((address_space(3)))
typedef unsigned short bf16_t;
typedef short bf16x8 __attribute__((ext_vector_type(8)));
typedef float f32x4 __attribute__((ext_vector_type(4)));
typedef unsigned u32x4 __attribute__((ext_vector_type(4)));
constexpr int BM = 256, BK = 64, HALF = 128, HTB = HALF * BK * 2  , STAGE_BYTES = 8 * HTB, NXCD = 8, WGM = 8;

__host__ __device__ __forceinline__ int lds_byte(int r, int c) { const int st = (r >> 4) * 2 + (c >> 5), rr = r & 15, cc = c & 31, ob = rr * 64 + cc * 2; return st * 1024 + (ob ^ (((ob >> 9) & 1) << 5)); }
__host__ __device__ __forceinline__ void stage_rc(int b, int& R, int& C) { const int st = b / 1024, sb = b % 1024, swz = sb ^ (((sb >> 9) & 1) << 5); R = (st >> 1) * 16 + swz / 64; C = (st & 1) * 32 + (swz % 64) / 2; }
__host__ __device__ __forceinline__ int perm32(int rho) { const int n = rho >> 4, i = rho & 15; return 8 * (i >> 2) + 4 * n + (i & 3); }

struct Unit { int pm, pn; };
struct Gemm { const bf16_t* A; const bf16_t* Bt; int M, N, K; };

struct StaticOrder {
    int nM, nN, nwg, G, c;
    __host__ __device__ void init(int M, int N, int G_, int c_) { nM = M / BM; nN = N / BM; nwg = nM * nN; G = G_; c = c_; }
    __host__ __device__ bool next(int i, Unit& u) const {
        const long L = (long)i * G + c; if (L >= nwg) return false;
        int wgid = (int)L; { const int q = nwg / NXCD, r = nwg % NXCD, xcd = wgid % NXCD, off = wgid / NXCD; wgid = (xcd < r ? xcd * (q + 1) : r * (q + 1) + (xcd - r) * q) + off; }
        const int nig = WGM * nN, gid = wgid / nig, fm = gid * WGM, gsz = (nM - fm) < WGM ? (nM - fm) : WGM;
        u.pm = fm + ((wgid % nig) % gsz); u.pn = (wgid % nig) / gsz; return true;
    }
    __device__ __forceinline__ void a_ready(const Unit&) const {}
    __device__ __forceinline__ void done(const Unit&) const {}
};

typedef float f32x2c_t __attribute__((ext_vector_type(2))); typedef __bf16 bf16x2c_t __attribute__((ext_vector_type(2)));
__device__ __forceinline__ unsigned cvt_pk_bf16(float lo, float hi) { const f32x2c_t v = {lo, hi}; const bf16x2c_t b = __builtin_convertvector(v, bf16x2c_t); return __builtin_bit_cast(unsigned, b); }
typedef float f32x2 __attribute__((ext_vector_type(2)));
__device__ __forceinline__ f32x2 gelu_pk(f32x2 v) {
    const f32x2 av = __builtin_elementwise_abs(v), d = av * 0.2316418882f + 1.0f;
    f32x2 t; t.x = __builtin_amdgcn_rcpf(d.x); t.y = __builtin_amdgcn_rcpf(d.y);
    f32x2 q = t * 0.5307027145f + (-0.7265760135f); q = q * t + 0.7107068705f; q = q * t + (-0.142248368f); q = q * t + 0.127414796f; q = q * t;
    const f32x2 s = (v * v) * (-0.72134752044f);
    f32x2 e; e.x = __builtin_amdgcn_exp2f(s.x); e.y = __builtin_amdgcn_exp2f(s.y);
    const f32x2 m = av * (q * e);
    return __builtin_elementwise_max(v, (f32x2){0.f, 0.f}) - m;
}
}
namespace pg8 {
template <class Epi, class Sched, bool ALIGN_EPI = false, bool SP2 = false, bool APERM = false  >
__device__ __forceinline__ void gemm_phase(PG8_LAS unsigned char* lds, const Gemm g, const Sched& S, const Epi& E) {
    const int tid = fresh_tid(), wid = __builtin_amdgcn_readfirstlane(tid >> 6), lane = tid & 63, wr = wid >> 2, wc = wid & 3, fr = lane & 15, fq = lane >> 4;
    const int K = g.K, nt = K / BK;
    unsigned voffA[2], voffB[2];
#pragma unroll
    for (int i = 0; i < 2; ++i) { int R, C; stage_rc(tid * 16 + i * 8192, R, C); const int Rb = Epi::PERM ? ((R & ~31) + perm32(R & 31)) : R;
        const int Ra = APERM ? ((R & ~63) + 4 * (R & 15) + ((R >> 4) & 3)) : R;
        voffA[i] = (unsigned)(Ra * K + C) * 2u; voffB[i] = (unsigned)(Rb * K + C) * 2u; }
    const size_t kstep = (size_t)(BK * 2);
    const size_t hstep = (size_t)HALF * K * 2;
    const size_t tstep = 2 * hstep;
    const unsigned ldsw = (unsigned)wid * 1024u;
    const int aoff = lds_byte(wr * 64 + fr, fq * 8), boff = lds_byte(wc * 32 + fr, fq * 8);
#define PG8_SA(b, h) (((b) * 2 + (h)) * HTB)
#define PG8_SB(b, h) ((4 + (b) * 2 + (h)) * HTB)
#define PG8_STAGE(bufoff, gbase, voff) do { _Pragma("unroll") for (int _i = 0; _i < 2; ++_i) \
        __builtin_amdgcn_global_load_lds((const unsigned*)((const char*)(gbase) + (voff)[_i]), (PG8_LAS unsigned*)(lds + (bufoff) + ldsw + _i * 8192), 16, 0, 0); } while (0)
#define PG8_LDA(dst, b, h) do { _Pragma("unroll") for (int m = 0; m < 4; ++m) _Pragma("unroll") for (int k = 0; k < 2; ++k) dst[m][k] = *(const PG8_LAS bf16x8*)(lds + PG8_SA(b, h) + aoff + m * 2048 + k * 1024); } while (0)
#define PG8_LDB(dst, b, h) do { _Pragma("unroll") for (int n = 0; n < 2; ++n) _Pragma("unroll") for (int k = 0; k < 2; ++k) dst[n][k] = *(const PG8_LAS bf16x8*)(lds + PG8_SB(b, h) + boff + n * 2048 + k * 1024); } while (0)
#define PG8_MMA(ai, bj, At, Bt) do { __builtin_amdgcn_s_setprio(1); _Pragma("unroll") for (int m = 0; m < 4; ++m) _Pragma("unroll") for (int n = 0; n < 2; ++n) _Pragma("unroll") for (int k = 0; k < 2; ++k) \
        acc[ai][bj][m][n] = __builtin_amdgcn_mfma_f32_16x16x32_bf16(Bt[n][k], At[m][k], acc[ai][bj][m][n], 0, 0, 0); __builtin_amdgcn_s_setprio(0); } while (0)
#define PG8_WAIT_V(n) asm volatile("s_waitcnt vmcnt(" #n ")" ::: "memory")
#define PG8_WAIT_L(n) asm volatile("s_waitcnt lgkmcnt(" #n ")" ::: "memory")
#define PG8_BAR __builtin_amdgcn_s_barrier()
#define PG8_SCHED __builtin_amdgcn_sched_barrier(0)
    Unit cur, nxt; int ui = 0;
    if (!S.next(0, cur)) return;
    f32x4 acc[2][2][4][2];
#pragma unroll
    for (int a = 0; a < 2; ++a)
#pragma unroll
        for (int b = 0; b < 2; ++b)
#pragma unroll
            for (int m = 0; m < 4; ++m)
#pragma unroll
                for (int n = 0; n < 2; ++n) acc[a][b][m][n] = (f32x4){0.f, 0.f, 0.f, 0.f};
    bf16x8 At[4][2], B0[2][2], B1[2][2];
    const char* cA = (const char*)g.A + (size_t)cur.pm * tstep; const char* cB = (const char*)g.Bt + (size_t)cur.pn * tstep;
    S.a_ready(cur);
    if constexpr (SP2) {
        PG8_STAGE(PG8_SB(0, 0), cB, voffB); PG8_STAGE(PG8_SB(0, 1), cB + hstep, voffB); PG8_STAGE(PG8_SA(0, 0), cA, voffA); PG8_STAGE(PG8_SA(0, 1), cA + hstep, voffA);
        if (wr == 1) PG8_BAR;
        PG8_WAIT_V(2); PG8_BAR;
        PG8_STAGE(PG8_SB(1, 0), cB + kstep, voffB); PG8_STAGE(PG8_SA(1, 0), cA + kstep, voffA); PG8_STAGE(PG8_SB(1, 1), cB + hstep + kstep, voffB);
        PG8_WAIT_V(6); PG8_BAR;
    } else {
        PG8_STAGE(PG8_SB(0, 0), cB, voffB); PG8_STAGE(PG8_SA(0, 0), cA, voffA); PG8_STAGE(PG8_SB(0, 1), cB + hstep, voffB); PG8_STAGE(PG8_SA(0, 1), cA + hstep, voffA);
        if (wr == 1) PG8_BAR;
        PG8_WAIT_V(4); PG8_BAR;
        PG8_STAGE(PG8_SB(1, 0), cB + kstep, voffB); PG8_STAGE(PG8_SA(1, 0), cA + kstep, voffA); PG8_STAGE(PG8_SB(1, 1), cB + hstep + kstep, voffB);
        PG8_WAIT_V(6); PG8_BAR;
    }
    for (;;) {
        const bool has_next = S.next(ui + 1, nxt);
        const char* nA = has_next ? (const char*)g.A + (size_t)nxt.pm * tstep : cA; const char* nB = has_next ? (const char*)g.Bt + (size_t)nxt.pn * tstep : cB;
        for (int t = 0; t < nt; t += 2) {
            const bool last = (t == nt - 2);
            const char* a1 = cA + (size_t)(t + 1) * kstep;
            const char* a2 = last ? nA : cA + (size_t)(t + 2) * kstep; const char* b2 = last ? nB : cB + (size_t)(t + 2) * kstep;
            const char* a3 = a2 + kstep; const char* b3 = b2 + kstep;
            if (last && has_next) S.a_ready(nxt);
            if constexpr (SP2) {
            PG8_LDB(B0, 0, 0); PG8_LDB(B1, 0, 1); PG8_SCHED; PG8_LDA(At, 0, 0); PG8_STAGE(PG8_SA(1, 1), a1 + hstep, voffA);
            PG8_WAIT_V(8); PG8_WAIT_L(0); PG8_BAR; PG8_MMA(0, 0, At, B0); PG8_MMA(0, 1, At, B1); PG8_BAR; PG8_SCHED;
            PG8_LDA(At, 0, 1); PG8_STAGE(PG8_SB(0, 0), b2, voffB); PG8_STAGE(PG8_SB(0, 1), b2 + hstep, voffB); PG8_STAGE(PG8_SA(0, 0), a2, voffA);
            PG8_WAIT_V(8); PG8_WAIT_L(0); PG8_BAR; PG8_MMA(1, 0, At, B0); PG8_MMA(1, 1, At, B1); PG8_BAR; PG8_SCHED;
            PG8_LDB(B0, 1, 0); PG8_LDB(B1, 1, 1); PG8_SCHED; PG8_LDA(At, 1, 0); PG8_STAGE(PG8_SA(0, 1), a2 + hstep, voffA);
            PG8_WAIT_V(8); PG8_WAIT_L(0); PG8_BAR; PG8_MMA(0, 0, At, B0); PG8_MMA(0, 1, At, B1); PG8_BAR; PG8_SCHED;
            PG8_LDA(At, 1, 1); PG8_STAGE(PG8_SB(1, 0), b3, voffB); PG8_STAGE(PG8_SB(1, 1), b3 + hstep, voffB); PG8_STAGE(PG8_SA(1, 0), a3, voffA);
            PG8_WAIT_V(8); PG8_WAIT_L(0); PG8_BAR; PG8_MMA(1, 0, At, B0); PG8_MMA(1, 1, At, B1); PG8_BAR; PG8_SCHED;
            } else {
            PG8_LDB(B0, 0, 0); PG8_SCHED; PG8_LDA(At, 0, 0); PG8_STAGE(PG8_SA(1, 1), a1 + hstep, voffA);
            PG8_WAIT_L(8); PG8_BAR; PG8_WAIT_L(0); PG8_MMA(0, 0, At, B0); PG8_BAR; PG8_SCHED;
            PG8_LDB(B1, 0, 1); PG8_STAGE(PG8_SB(0, 0), b2, voffB);
            PG8_BAR; PG8_WAIT_L(0); PG8_MMA(0, 1, At, B1); PG8_BAR;
            PG8_LDA(At, 0, 1); PG8_STAGE(PG8_SA(0, 0), a2, voffA);
            PG8_BAR; PG8_WAIT_L(0); PG8_MMA(1, 0, At, B0); PG8_BAR; PG8_SCHED;
            PG8_STAGE(PG8_SB(0, 1), b2 + hstep, voffB);
            PG8_WAIT_V(6); PG8_BAR; PG8_MMA(1, 1, At, B1); PG8_BAR;
            PG8_LDB(B0, 1, 0); PG8_SCHED; PG8_LDA(At, 1, 0); PG8_STAGE(PG8_SA(0, 1), a2 + hstep, voffA);
            PG8_WAIT_L(8); PG8_BAR; PG8_WAIT_L(0); PG8_MMA(0, 0, At, B0); PG8_BAR; PG8_SCHED;
            PG8_LDB(B1, 1, 1); PG8_STAGE(PG8_SB(1, 0), b3, voffB);
            PG8_BAR; PG8_WAIT_L(0); PG8_MMA(0, 1, At, B1); PG8_BAR;
            PG8_LDA(At, 1, 1); PG8_STAGE(PG8_SA(1, 0), a3, voffA);
            PG8_BAR; PG8_WAIT_L(0); PG8_MMA(1, 0, At, B0); PG8_BAR; PG8_SCHED;
            PG8_STAGE(PG8_SB(1, 1), b3 + hstep, voffB);
            PG8_WAIT_V(6); PG8_BAR; PG8_MMA(1, 1, At, B1); PG8_BAR;
            }
        }
        if constexpr (ALIGN_EPI) { if (wr == 0) PG8_BAR; }
        if constexpr (!Epi::AFTER_DRAIN) { E(acc, cur, wr, wc, fr, fq); S.done(cur); }
        if (!has_next) break;
#pragma unroll
        for (int a = 0; a < 2; ++a)
#pragma unroll
            for (int b = 0; b < 2; ++b)
#pragma unroll
                for (int m = 0; m < 4; ++m)
#pragma unroll
                    for (int n = 0; n < 2; ++n) acc[a][b][m][n] = (f32x4){0.f, 0.f, 0.f, 0.f};
        cur = nxt; cA = nA; cB = nB; ++ui;
        if constexpr (ALIGN_EPI) { if (wr == 1) PG8_BAR; }
    }
    PG8_WAIT_V(0);
    if constexpr (!ALIGN_EPI) { if (wr == 0) PG8_BAR; }
    PG8_BAR;
    if constexpr (Epi::AFTER_DRAIN) { E.fused(acc, cur, wr, wc, fr, fq, lds, wid, lane); S.done(cur); }
#undef PG8_SA
#undef PG8_SB
#undef PG8_STAGE
#undef PG8_LDA
#undef PG8_LDB
#undef PG8_MMA
#undef PG8_WAIT_V
#undef PG8_WAIT_L
#undef PG8_BAR
#undef PG8_SCHED
}
}
namespace pg8 {
template <int CTRL> __device__ __forceinline__ float dppf(float v) { return __builtin_bit_cast(float, __builtin_amdgcn_update_dpp(0, __builtin_bit_cast(int, v), CTRL, 0xf, 0xf, false)); }

template <int CTRL> __device__ __forceinline__ float dppo(float old, float v) { return __builtin_bit_cast(float, __builtin_amdgcn_update_dpp(__builtin_bit_cast(int, old), __builtin_bit_cast(int, v), CTRL, 0xf, 0xf, false)); }
struct EpiBf16P {
    static constexpr bool PERM = true, AFTER_DRAIN = false;
    bf16_t* O; int ldc; const float* rss; PG8_LAS float* tab;
    __device__ __forceinline__ void operator()(const f32x4 (&acc)[2][2][4][2], const Unit& u, int wr, int wc, int fr, int fq) const {
        const int row0 = u.pm * BM + wr * 64 + fr, col0 = u.pn * BM + wc * 32 + 8 * fq;
        if (wr == 0) { const int trow = wc * 64 + fq * 16 + fr, r_ = u.pm * BM + trow;
            tab[trow] = __builtin_amdgcn_rsqf(((rss[r_] + rss[32768 + r_]) + (rss[65536 + r_] + rss[98304 + r_])) * (1.f / 1024.f) + 1e-6f); }
        asm volatile("s_waitcnt lgkmcnt(0)" ::: "memory"); __builtin_amdgcn_s_barrier(); asm volatile("" ::: "memory");
#pragma unroll
        for (int ai = 0; ai < 2; ++ai)
#pragma unroll
            for (int m = 0; m < 4; ++m) { const int row = row0 + ai * HALF + m * 16; bf16_t* rowp = O + (size_t)row * ldc + col0;
                const float rs = tab[wr * 64 + fr + ai * HALF + m * 16];
#pragma unroll
                for (int bj = 0; bj < 2; ++bj) { const f32x4 v0 = acc[ai][bj][m][0] * rs, v1 = acc[ai][bj][m][1] * rs;
                    u32x4 w; w.x = cvt_pk_bf16(v0[0], v0[1]); w.y = cvt_pk_bf16(v0[2], v0[3]); w.z = cvt_pk_bf16(v1[0], v1[1]); w.w = cvt_pk_bf16(v1[2], v1[3]);
                    *(u32x4*)(rowp + bj * HALF) = w; } }
    }
};
struct EpiRes {
    static constexpr bool PERM = true, AFTER_DRAIN = false;
    const float* base32; bf16_t* xs; int ldc; float* rssp; PG8_LAS float* red;
    __device__ __forceinline__ void operator()(const f32x4 (&acc)[2][2][4][2], const Unit& u, int wr, int wc, int fr, int fq) const {
        const int col0 = u.pn * BM + wc * 32 + 8 * fq;
        const size_t off0 = (size_t)(u.pm * BM + wr * 64 + fr) * ldc + col0;
#pragma unroll
        for (int ai = 0; ai < 2; ++ai) {
            u32x4 bv[4][2];
#pragma unroll
            for (int m = 0; m < 4; ++m)
#pragma unroll
                for (int bj = 0; bj < 2; ++bj) bv[m][bj] = *(const u32x4*)(xs + off0 + (size_t)(ai * HALF + m * 16) * ldc + bj * HALF);
#pragma unroll
            for (int m = 0; m < 4; ++m) { float ss = 0.f;
#pragma unroll
                for (int bj = 0; bj < 2; ++bj) { const size_t off = off0 + (size_t)(ai * HALF + m * 16) * ldc + bj * HALF; const u32x4 b = bv[m][bj];
                    f32x4 o0 = (f32x4){__builtin_bit_cast(float, b.x << 16), __builtin_bit_cast(float, b.x & 0xffff0000u), __builtin_bit_cast(float, b.y << 16), __builtin_bit_cast(float, b.y & 0xffff0000u)};
                    f32x4 o1 = (f32x4){__builtin_bit_cast(float, b.z << 16), __builtin_bit_cast(float, b.z & 0xffff0000u), __builtin_bit_cast(float, b.w << 16), __builtin_bit_cast(float, b.w & 0xffff0000u)};
                    o0 = o0 + acc[ai][bj][m][0]; o1 = o1 + acc[ai][bj][m][1];
                    ss += ((o0[0] * o0[0] + o0[1] * o0[1]) + (o0[2] * o0[2] + o0[3] * o0[3])) + ((o1[0] * o1[0] + o1[1] * o1[1]) + (o1[2] * o1[2] + o1[3] * o1[3]));
                    u32x4 w; w.x = cvt_pk_bf16(o0[0], o0[1]); w.y = cvt_pk_bf16(o0[2], o0[3]); w.z = cvt_pk_bf16(o1[0], o1[1]); w.w = cvt_pk_bf16(o1[2], o1[3]); *(u32x4*)(xs + off) = w; }
                ss += __shfl_xor(ss, 16); ss += __shfl_xor(ss, 32);
                if (fq == 0) red[wc * 256 + ai * HALF + wr * 64 + m * 16 + fr] = ss; }
            asm volatile("" ::: "memory"); }
        asm volatile("s_waitcnt lgkmcnt(0)" ::: "memory"); __builtin_amdgcn_s_barrier(); asm volatile("" ::: "memory");
        if (wr == 0) { const int row = wc * 64 + fq * 16 + fr;
            rssp[(size_t)u.pn * 32768 + u.pm * BM + row] = (red[row] + red[256 + row]) + (red[512 + row] + red[768 + row]); }
    }
};
struct EpiResFinal {
    static constexpr bool PERM = true, AFTER_DRAIN = false;
    const bf16_t* xs; float* out; int ldc; float* rssp; const float* g; unsigned* cnt; PG8_LAS float* red;
    __device__ __forceinline__ void operator()(const f32x4 (&acc_)[2][2][4][2], const Unit& u, int wr, int wc, int fr, int fq) const {
        f32x4 (&acc)[2][2][4][2] = const_cast<f32x4 (&)[2][2][4][2]>(acc_);
        const int col0 = u.pn * BM + wc * 32 + 8 * fq;
        const size_t off0 = (size_t)(u.pm * BM + wr * 64 + fr) * ldc + col0;
#pragma unroll
        for (int ai = 0; ai < 2; ++ai) {
          u32x4 bv[4][2];
#pragma unroll
          for (int m = 0; m < 4; ++m)
#pragma unroll
              for (int bj = 0; bj < 2; ++bj) bv[m][bj] = *(const u32x4*)(xs + off0 + (size_t)(ai * HALF + m * 16) * ldc + bj * HALF);
#pragma unroll
            for (int m = 0; m < 4; ++m) { float ss = 0.f;
#pragma unroll
                for (int bj = 0; bj < 2; ++bj) {
                    const u32x4 b = bv[m][bj];
                    const f32x4 o0 = (f32x4){__builtin_bit_cast(float, b.x << 16), __builtin_bit_cast(float, b.x & 0xffff0000u), __builtin_bit_cast(float, b.y << 16), __builtin_bit_cast(float, b.y & 0xffff0000u)} + acc[ai][bj][m][0];
                    const f32x4 o1 = (f32x4){__builtin_bit_cast(float, b.z << 16), __builtin_bit_cast(float, b.z & 0xffff0000u), __builtin_bit_cast(float, b.w << 16), __builtin_bit_cast(float, b.w & 0xffff0000u)} + acc[ai][bj][m][1];
                    ss += ((o0[0] * o0[0] + o0[1] * o0[1]) + (o0[2] * o0[2] + o0[3] * o0[3])) + ((o1[0] * o1[0] + o1[1] * o1[1]) + (o1[2] * o1[2] + o1[3] * o1[3]));
                    acc[ai][bj][m][0] = o0; acc[ai][bj][m][1] = o1; }
                ss += __shfl_xor(ss, 16); ss += __shfl_xor(ss, 32);
                if (fq == 0) red[wc * 256 + ai * HALF + wr * 64 + m * 16 + fr] = ss;
                asm volatile("" ::: "memory"); } }
        asm volatile("s_waitcnt lgkmcnt(0)" ::: "memory"); __builtin_amdgcn_s_barrier(); asm volatile("" ::: "memory");
        const int trow = wc * 64 + fq * 16 + fr;
        float* slot = rssp + (size_t)u.pm * BM + trow;
        if (wr == 0) __hip_atomic_store(slot + (size_t)u.pn * 32768, (red[trow] + red[256 + trow]) + (red[512 + trow] + red[768 + trow]), __ATOMIC_RELAXED, __HIP_MEMORY_SCOPE_AGENT);
        asm volatile("s_waitcnt vmcnt(0)" ::: "memory"); __builtin_amdgcn_s_barrier(); asm volatile("" ::: "memory");
        if (wr == 0 && wc == 0 && fq == 0 && fr == 0) {
            unsigned* c = cnt + 64 * u.pm; __hip_atomic_fetch_add(c, 1u, __ATOMIC_RELAXED, __HIP_MEMORY_SCOPE_AGENT);
            unsigned spins = 0; while (__hip_atomic_load(c, __ATOMIC_RELAXED, __HIP_MEMORY_SCOPE_AGENT) < 4u && ++spins < (1u << 22)) __builtin_amdgcn_s_sleep(1);
        }
        asm volatile("s_waitcnt vmcnt(0)" ::: "memory"); __builtin_amdgcn_s_barrier(); asm volatile("" ::: "memory");
        if (wr == 0) { const float t = (__hip_atomic_load(slot, __ATOMIC_RELAXED, __HIP_MEMORY_SCOPE_AGENT) + __hip_atomic_load(slot + 32768, __ATOMIC_RELAXED, __HIP_MEMORY_SCOPE_AGENT))
                                     + (__hip_atomic_load(slot + 65536, __ATOMIC_RELAXED, __HIP_MEMORY_SCOPE_AGENT) + __hip_atomic_load(slot + 98304, __ATOMIC_RELAXED, __HIP_MEMORY_SCOPE_AGENT));
            red[1024 + trow] = __builtin_amdgcn_rsqf(t * (1.f / 1024.f) + 1e-6f); }
        asm volatile("s_waitcnt lgkmcnt(0)" ::: "memory"); __builtin_amdgcn_s_barrier(); asm volatile("" ::: "memory");
#pragma unroll
        for (int bj = 0; bj < 2; ++bj) { const f32x4 g0 = *(const f32x4*)(g + col0 + bj * HALF), g1 = *(const f32x4*)(g + col0 + bj * HALF + 4);
#pragma unroll
            for (int ai = 0; ai < 2; ++ai)
#pragma unroll
                for (int m = 0; m < 4; ++m) { const float rs = red[1024 + ai * HALF + wr * 64 + m * 16 + fr]; const size_t off = off0 + (size_t)(ai * HALF + m * 16) * ldc + bj * HALF;
                    *(f32x4*)(out + off) = acc[ai][bj][m][0] * rs * g0; *(f32x4*)(out + off + 4) = acc[ai][bj][m][1] * rs * g1; } }
    }
};
struct EpiFfnUp {
    static constexpr bool PERM = true, AFTER_DRAIN = false;
    static constexpr int FFD = 2816;
    bf16_t* act; const float* cw; const float* cb; float* ulast; float* ufirst; float* vfirst; PG8_LAS f32x4* xch; const float* rss;
    __device__ __forceinline__ void operator()(const f32x4 (&acc)[2][2][4][2], const Unit& u, int wr, int wc, int fr, int fq) const {
        const int ch0 = u.pn * 128 + wc * 32 + 8 * fq;
        f32x4 w0[2], w1[2], w2[2], bb[2];
#pragma unroll
        for (int n = 0; n < 2; ++n) { w0[n] = *(const f32x4*)(cw + ch0 + 4 * n); w1[n] = *(const f32x4*)(cw + FFD + ch0 + 4 * n); w2[n] = *(const f32x4*)(cw + 2 * FFD + ch0 + 4 * n); bb[n] = *(const f32x4*)(cb + ch0 + 4 * n); }
        PG8_LAS float* tab = (PG8_LAS float*)(xch + 256);
#define RSTD4(r_) __builtin_amdgcn_rsqf(((rss[(r_)] + rss[32768 + (r_)]) + (rss[65536 + (r_)] + rss[98304 + (r_)])) * (1.f / 1024.f) + 1e-6f)
        if (wr == 0) { const int trow = wc * 64 + fq * 16 + fr; tab[trow] = RSTD4(u.pm * BM + trow); }
        const int rl = wr * 64 + 4 * fr;
        if (fr == 15) {
#pragma unroll
            for (int ai = 0; ai < 2; ++ai)
#pragma unroll
                for (int q = 0; q < 2; ++q) { PG8_LAS f32x4* s = xch + (((((ai * 2 + wr) * 4 + wc) * 4 + fq) * 2 + q) * 2); s[0] = acc[ai][0][2 + q][0]; s[1] = acc[ai][0][2 + q][1]; }
        }
        asm volatile("s_waitcnt lgkmcnt(0)" ::: "memory"); __builtin_amdgcn_s_barrier(); asm volatile("" ::: "memory");
        if (fr == 15 && wr == 1) {
#pragma unroll
            for (int q = 0; q < 2; ++q) { const float r3 = tab[rl + HALF + 2 + q]; float* g = ulast + (size_t)(u.pm * 2 + q) * FFD + ch0; *(f32x4*)g = acc[1][0][2 + q][0] * r3; *(f32x4*)(g + 4) = acc[1][0][2 + q][1] * r3; } }
        if (fr == 0 && wr == 0) {
#pragma unroll
            for (int q = 0; q < 2; ++q) { const float r0 = tab[q]; float* g = ufirst + (size_t)(u.pm * 2 + q) * FFD + ch0; *(f32x4*)g = acc[0][0][q][0] * r0; *(f32x4*)(g + 4) = acc[0][0][q][1] * r0;
                float* h = vfirst + (size_t)(u.pm * 2 + q) * FFD + ch0; *(f32x4*)h = acc[0][1][q][0] * r0; *(f32x4*)(h + 4) = acc[0][1][q][1] * r0; } }
#pragma unroll
        for (int ai = 0; ai < 2; ++ai) {
            f32x4 h2[2] = {(f32x4){0.f, 0.f, 0.f, 0.f}, (f32x4){0.f, 0.f, 0.f, 0.f}}, h3[2] = {h2[0], h2[0]};
            if (wr == 1 || ai == 1) { const int sai = (wr == 1) ? ai : 0, swr = (wr == 1) ? 0 : 1;
                const PG8_LAS f32x4* s = xch + ((((sai * 2 + swr) * 4 + wc) * 4 + fq) * 2) * 2; const float ra = tab[sai * HALF + swr * 64 + 62], rb = tab[sai * HALF + swr * 64 + 63];
                h2[0] = s[0] * ra; h2[1] = s[1] * ra; h3[0] = s[2] * rb; h3[1] = s[3] * rb; }
            const f32x4 rs4 = *(const PG8_LAS f32x4*)(tab + rl + ai * HALF);
            f32x4 us[4][2];
#pragma unroll
            for (int m = 0; m < 4; ++m) { us[m][0] = acc[ai][0][m][0] * rs4[m]; us[m][1] = acc[ai][0][m][1] * rs4[m]; }
            f32x4 s2[2], s3[2];
#pragma unroll
            for (int n = 0; n < 2; ++n)
#pragma unroll
                for (int e = 0; e < 4; ++e) { s2[n][e] = dppo<0x111>(h2[n][e], us[2][n][e]); s3[n][e] = dppo<0x111>(h3[n][e], us[3][n][e]); }
#pragma unroll
            for (int m = 0; m < 4; ++m) {
                f32x4 uc[2];
#pragma unroll
                for (int n = 0; n < 2; ++n) { const f32x4 um1 = (m == 0) ? s3[n] : us[m - 1][n], um2 = (m == 0) ? s2[n] : (m == 1) ? s3[n] : us[m - 2][n];
                    uc[n] = bb[n] + w0[n] * um2 + w1[n] * um1 + w2[n] * us[m][n]; }
                const f32x4 v0 = acc[ai][1][m][0] * rs4[m], v1 = acc[ai][1][m][1] * rs4[m];
                const f32x2 a = gelu_pk((f32x2){uc[0][0], uc[0][1]}), b = gelu_pk((f32x2){uc[0][2], uc[0][3]}), c = gelu_pk((f32x2){uc[1][0], uc[1][1]}), d = gelu_pk((f32x2){uc[1][2], uc[1][3]});
                u32x4 w; w.x = cvt_pk_bf16(a.x * v0[0], a.y * v0[1]); w.y = cvt_pk_bf16(b.x * v0[2], b.y * v0[3]); w.z = cvt_pk_bf16(c.x * v1[0], c.y * v1[1]); w.w = cvt_pk_bf16(d.x * v1[2], d.y * v1[3]);
                *(u32x4*)(act + (size_t)(u.pm * BM + ai * HALF + rl + m) * FFD + ch0) = w;
            }
        }
    }
};
}
#define LAS __attribute__((address_space(3)))
typedef unsigned short bf16;
typedef unsigned v4u __attribute__((ext_vector_type(4)));
typedef unsigned v2u __attribute__((ext_vector_type(2)));
typedef float f32x4 __attribute__((ext_vector_type(4)));
typedef float f32x2 __attribute__((ext_vector_type(2)));
typedef short bf16x8 __attribute__((ext_vector_type(8)));
constexpr int NWAVES = 8, NTHR = 512;
constexpr int BATCH = 8, SEQ = 4096, D = 1024, M = BATCH * SEQ, FFD = 2816, NUP = 2 * FFD, NAB = 2048, NGLA = 3584, GLA_SRC_N = 3088;
constexpr float EPS = 1e-6f;
constexpr size_t MiB = 1u << 20;
constexpr size_t WS_DEC = 1 * MiB, WS_ULAST = 2 * MiB, WS_UFIRST = 5 * MiB, WS_VFIRST = 8 * MiB;
constexpr size_t WS_WABIN = 12 * MiB, WS_WABOUT = 16 * MiB, WS_WGLAIN = 18 * MiB, WS_WGLAOUT = 25 * MiB, WS_WUP = 27 * MiB  , WS_WDN = 49 * MiB  ;
constexpr size_t WS_XN = 64 * MiB, WS_CAT = 128 * MiB, WS_H = 192 * MiB, WS_XS = 416 * MiB  , WS_END = 480 * MiB;
constexpr int LDS_BYTES = 147456, XCH_OFF = 131072;
#ifndef PHM
#define PHM 0xffff
#endif

__device__ __forceinline__ float bflo(unsigned w) { return __builtin_bit_cast(float, w << 16); }
__device__ __forceinline__ float bfhi(unsigned w) { return __builtin_bit_cast(float, w & 0xffff0000u); }
__device__ __forceinline__ unsigned pk2(float lo, float hi) { return pg8::cvt_pk_bf16(lo, hi); }
__device__ __forceinline__ float wave_sum(float v) {
#pragma unroll
    for (int o = 1; o < 64; o <<= 1) v += __shfl_xor(v, o);
    return v;
}
#define LDS_WAIT() asm volatile("s_waitcnt lgkmcnt(0)" ::: "memory")

__device__ __forceinline__ void transpose_item(const float* W, int ldw, int K, bf16* WT, int k0, int n0, int trow0, LAS float* scr, int lane, const float* g = nullptr) {
    float tv[32];
#pragma unroll
    for (int i = 0; i < 32; ++i) { const int kk = 2 * i + (lane >> 5); tv[i] = W[(size_t)(k0 + kk) * ldw + n0 + (lane & 31)]; }
#pragma unroll
    for (int i = 0; i < 32; ++i) { const int kk = 2 * i + (lane >> 5); scr[kk * 33 + (lane & 31)] = tv[i] * (g ? g[k0 + kk] : 1.f); }
    LDS_WAIT(); asm volatile("" ::: "memory");
    const int c = lane & 7;
#pragma unroll
    for (int j = 0; j < 4; ++j) { const int n = (lane >> 3) + 8 * j; const LAS float* s = scr + (8 * c) * 33 + n;
        v4u o; o.x = pk2(s[0 * 33], s[1 * 33]); o.y = pk2(s[2 * 33], s[3 * 33]); o.z = pk2(s[4 * 33], s[5 * 33]); o.w = pk2(s[6 * 33], s[7 * 33]);
        *(v4u*)(WT + (size_t)(trow0 + n) * K + k0 + 8 * c) = o; }
    LDS_WAIT(); asm volatile("" ::: "memory");
}

struct Args { const float* in[20]; float* out; unsigned char* ws; };

__device__ __forceinline__ void convert_rows(const float* X, bf16* XS, float* rss, int gw, int ngw, int lane) {
#pragma unroll 2
    for (int m = gw; m < M; m += ngw) {
        const f32x4* xr = (const f32x4*)(X + (size_t)m * D) + lane;
        f32x4 v[4]; float s = 0.f;
#pragma unroll
        for (int j = 0; j < 4; ++j) { v[j] = xr[64 * j]; s += (v[j].x * v[j].x + v[j].y * v[j].y) + (v[j].z * v[j].z + v[j].w * v[j].w); }
        s = wave_sum(s);
        unsigned long long* o8 = (unsigned long long*)(XS + (size_t)m * D) + lane;
#pragma unroll
        for (int j = 0; j < 4; ++j) o8[64 * j] = (unsigned long long)pk2(v[j].x, v[j].y) | ((unsigned long long)pk2(v[j].z, v[j].w) << 32);
        if (lane < 4) rss[(size_t)lane * 32768 + m] = lane == 0 ? s : 0.f;
    }
}
__device__ __forceinline__ void final_norm_rows(const bf16* XS, float* OUT, const float* g, const float* rss, int gw, int ngw, int lane) {
    f32x4 gv[4];
#pragma unroll
    for (int j = 0; j < 4; ++j) gv[j] = ((const f32x4*)g)[lane + 64 * j];
#pragma unroll 4
    for (int m = gw; m < M; m += ngw) {
        const v2u* xr = (const v2u*)(XS + (size_t)m * D) + lane; f32x4* orow = (f32x4*)(OUT + (size_t)m * D) + lane;
        const float rstd = rsqrtf(((rss[m] + rss[32768 + m]) + (rss[65536 + m] + rss[98304 + m])) * (1.f / D) + EPS);
#pragma unroll
        for (int j = 0; j < 4; ++j) { const v2u w = xr[64 * j]; orow[64 * j] = (f32x4){bflo(w.x), bfhi(w.x), bflo(w.y), bfhi(w.y)} * rstd * gv[j]; }
    }
}

__device__ __forceinline__ void unpack8(const v4u w, float (&f)[8]) {
    f[0] = bflo(w.x); f[1] = bfhi(w.x); f[2] = bflo(w.y); f[3] = bfhi(w.y); f[4] = bflo(w.z); f[5] = bfhi(w.z); f[6] = bflo(w.w); f[7] = bfhi(w.w);
}
__device__ __forceinline__ void ab_mixer(const bf16* H, bf16* CAT, const float* pool_b, const float* pool_scale, const float* scw, const float* scb, int wg, int nwg, int tid) {
    const int cv = tid & 127, sub = tid >> 7;
    float pa[8], pb[8], pc[8], pd[8];
    if (cv < 64) {
#pragma unroll
        for (int e = 0; e < 8; ++e) { pa[e] = pool_b[cv * 8 + e]; pb[e] = pool_scale[cv * 8 + e]; pc[e] = 0.f; pd[e] = 0.f; }
    } else {
        const int c = (cv - 64) * 8;
#pragma unroll
        for (int e = 0; e < 8; ++e) { pa[e] = scw[c + e]; pb[e] = scw[512 + c + e]; pc[e] = scw[1024 + c + e]; pd[e] = scb[c + e]; }
    }
    for (int chunk = wg * 4 + sub; chunk < M / 32; chunk += nwg * 4) {
        const int r0 = chunk * 32, t0 = r0 & (SEQ - 1);
        bf16* outp = CAT + (size_t)r0 * D + cv * 8;
        if (cv < 64) {
            const int win = 2 << (cv >> 4);
            const bf16* p = H + (size_t)r0 * NAB + cv * 8;
            float s[8], f[8];
#pragma unroll
            for (int e = 0; e < 8; ++e) s[e] = 0.f;
            if (t0 > 0) for (int i = 1; i < win; ++i) { unpack8(*(const v4u*)(p - (size_t)i * NAB), f);
#pragma unroll
                for (int e = 0; e < 8; ++e) s[e] += f[e]; }
#pragma unroll 4
            for (int jr = 0; jr < 32; ++jr) {
                const int t = t0 + jr; float cur[8], y[8];
                unpack8(*(const v4u*)(p + (size_t)jr * NAB), cur);
                if (jr >= 1 && t >= win) { unpack8(*(const v4u*)(p + (ptrdiff_t)(jr - win) * NAB), f);
#pragma unroll
                    for (int e = 0; e < 8; ++e) s[e] -= f[e]; }
#pragma unroll
                for (int e = 0; e < 8; ++e) s[e] += cur[e];
                const float inv = 1.f / (float)((t + 1) < win ? (t + 1) : win);
#pragma unroll
                for (int e = 0; e < 8; ++e) y[e] = (s[e] * inv - cur[e] + pa[e]) * pb[e];
                v4u o; o.x = pk2(y[0], y[1]); o.y = pk2(y[2], y[3]); o.z = pk2(y[4], y[5]); o.w = pk2(y[6], y[7]);
                *(v4u*)(outp + (size_t)jr * D) = o;
            }
        } else {
            const bf16* p = H + (size_t)r0 * NAB + (cv - 64) * 8;
            float p1[8], p2[8], a[8], b[8];
#pragma unroll
            for (int e = 0; e < 8; ++e) { p1[e] = 0.f; p2[e] = 0.f; }
            if (t0 > 0) { unpack8(*(const v4u*)(p - NAB + 1024), a); unpack8(*(const v4u*)(p - NAB + 1536), b);
#pragma unroll
                for (int e = 0; e < 8; ++e) p1[e] = a[e] * b[e];
                unpack8(*(const v4u*)(p - 2 * NAB + 1024), a); unpack8(*(const v4u*)(p - 2 * NAB + 1536), b);
#pragma unroll
                for (int e = 0; e < 8; ++e) p2[e] = a[e] * b[e]; }
#pragma unroll 4
            for (int jr = 0; jr < 32; ++jr) {
                float sb[8], y[8];
                unpack8(*(const v4u*)(p + (size_t)jr * NAB + 512), sb); unpack8(*(const v4u*)(p + (size_t)jr * NAB + 1024), a); unpack8(*(const v4u*)(p + (size_t)jr * NAB + 1536), b);
#pragma unroll
                for (int e = 0; e < 8; ++e) { const float pr = a[e] * b[e]; y[e] = sb[e] * (pd[e] + pc[e] * pr + pb[e] * p1[e] + pa[e] * p2[e]); p2[e] = p1[e]; p1[e] = pr; }
                v4u o; o.x = pk2(y[0], y[1]); o.y = pk2(y[2], y[3]); o.z = pk2(y[4], y[5]); o.w = pk2(y[6], y[7]);
                *(v4u*)(outp + (size_t)jr * D) = o;
            }
        }
    }
}

__device__ __forceinline__ float gate_log(float z) { return (fminf(z, 0.f) - __logf(1.f + __expf(-fabsf(z)))) * (1.f / 16.f); }
__device__ __forceinline__ void gla_prep(bf16* H, bf16* KDT, float* DEC, const float* b_g, int wg, int nwg, int tid) {
    const int half = tid >> 8, cp = tid & 255, c = 2 * cp;
    const float bg0 = b_g[c], bg1 = b_g[c + 1];
    const float QS = 0.08838834764831845f;
    for (int it = wg * 2 + half; it < BATCH * 64; it += nwg * 2) {
        bf16* base = H + (size_t)it * 64 * NGLA + c;
        unsigned cg[8], cq[8], ck[8], ng[8], nq[8], nk[8];
#pragma unroll
        for (int m = 0; m < 8; ++m) { const bf16* rp = base + (size_t)m * NGLA; cg[m] = *(const unsigned*)(rp + 3072); cq[m] = *(const unsigned*)rp; ck[m] = *(const unsigned*)(rp + 512); }
        float c0 = 0.f, c1 = 0.f;
        for (int g = 0; g < 8; ++g) {
            bf16* gb = base + (size_t)(g * 8) * NGLA;
            if (g < 7) {
#pragma unroll
                for (int m = 0; m < 8; ++m) { const bf16* rp = gb + (size_t)(8 + m) * NGLA; ng[m] = *(const unsigned*)(rp + 3072); nq[m] = *(const unsigned*)rp; nk[m] = *(const unsigned*)(rp + 512); }
            }
#pragma unroll
            for (int m = 0; m < 8; ++m) { bf16* rp = gb + (size_t)m * NGLA;
                c0 += gate_log(bflo(cg[m]) + bg0); c1 += gate_log(bfhi(cg[m]) + bg1);
                const float d0 = bflo(ck[m]) * __expf(-c0), d1 = bfhi(ck[m]) * __expf(-c1);
                *(unsigned*)rp = pk2(bflo(cq[m]) * QS * __expf(c0), bfhi(cq[m]) * QS * __expf(c1));
                *(unsigned*)(rp + 512) = pk2(d0, d1);
            }
#pragma unroll
            for (int m = 0; m < 8; ++m) { cg[m] = ng[m]; cq[m] = nq[m]; ck[m] = nk[m]; }
        }
        *(f32x2*)(DEC + (size_t)it * 512 + c) = (f32x2){__expf(c0), __expf(c1)};
    }
}

constexpr int QP = 136, VP = 40;
constexpr int L_Q = 0, L_K = L_Q + 64 * QP * 2, L_V = L_K + 64 * QP * 2, L_ST = L_V + 64 * VP * 2, L_SCAN_END = L_ST + 2 * 32 * QP * 2;
static_assert(L_SCAN_END <= XCH_OFF, "scan LDS");
typedef short v4i16_t __attribute__((ext_vector_type(4)));
__device__ __forceinline__ bf16x8 ldfrag(const LAS unsigned char* p) { return *(const LAS bf16x8*)p; }
__device__ __forceinline__ v4i16_t ldtr(const LAS unsigned char* img, int pitch, int row0, int col0, int l16) {
    return __builtin_amdgcn_ds_read_tr16_b64_v4i16((LAS v4i16_t*)(img + (row0 + (l16 >> 2)) * pitch + (col0 + 4 * (l16 & 3)) * 2)); }
__device__ __forceinline__ bf16x8 cat8(v4i16_t a, v4i16_t b) { return __builtin_shufflevector(a, b, 0, 1, 2, 3, 4, 5, 6, 7); }
__device__ __forceinline__ void gla_scan(LAS unsigned char* lds, const bf16* H, const float* DEC, bf16* O, int wg, int nwg, int tid) {
    const int wave = __builtin_amdgcn_readfirstlane(tid >> 6), lane = tid & 63, l16 = lane & 15, lq = lane >> 4;
    for (int item = wg; item < 256; item += nwg) {
        const int x = item & 7, j = item >> 3, bh = x * 4 + (j >> 3), vs = j & 7, b = bh >> 2, h = bh & 3;
        __syncthreads();
        for (int i = tid; i < 2 * 32 * QP / 2; i += NTHR) ((LAS unsigned*)(lds + L_ST))[i] = 0u;
        f32x4 S[2][2];
#pragma unroll
        for (int bq = 0; bq < 2; ++bq)
#pragma unroll
            for (int jv = 0; jv < 2; ++jv) S[bq][jv] = (f32x4){0.f, 0.f, 0.f, 0.f};
        const int hb = (wave & 3) * 2;
        const int r0 = tid >> 4, c16 = tid & 15, mv = (tid & 255) >> 2, c8v = tid & 3;
        const bf16* pq = H + ((size_t)b * SEQ + r0) * NGLA + h * 128 + c16 * 8;
        const bf16* pv = H + ((size_t)b * SEQ + mv) * NGLA + 1024 + h * 256 + vs * 32 + c8v * 8;
        const float* pdec = DEC + ((size_t)(b * 64)) * 512 + h * 128 + 16 * hb + 4 * lq;
        v4u rq0 = *(const v4u*)pq, rq1 = *(const v4u*)(pq + (size_t)32 * NGLA), rk0 = *(const v4u*)(pq + 512), rk1 = *(const v4u*)(pq + (size_t)32 * NGLA + 512);
        v4u rv = *(const v4u*)pv;
        f32x4 rdec0 = *(const f32x4*)pdec, rdec1 = *(const f32x4*)(pdec + 16);
        for (int n = 0; n < 64; ++n) {
            const size_t row0 = (size_t)b * SEQ + n * 64;
            *(LAS v4u*)(lds + L_Q + (r0 * QP + c16 * 8) * 2) = rq0; *(LAS v4u*)(lds + L_Q + ((r0 + 32) * QP + c16 * 8) * 2) = rq1;
            *(LAS v4u*)(lds + L_K + (r0 * QP + c16 * 8) * 2) = rk0; *(LAS v4u*)(lds + L_K + ((r0 + 32) * QP + c16 * 8) * 2) = rk1;
            if (tid < 256) *(LAS v4u*)(lds + L_V + (mv * VP + c8v * 8) * 2) = rv;
            const f32x4 dec0 = rdec0, dec1 = rdec1;
            __syncthreads();
            if (n + 1 < 64) {
                pq += (size_t)64 * NGLA; pv += (size_t)64 * NGLA; pdec += 512;
                rq0 = *(const v4u*)pq; rq1 = *(const v4u*)(pq + (size_t)32 * NGLA); rk0 = *(const v4u*)(pq + 512); rk1 = *(const v4u*)(pq + (size_t)32 * NGLA + 512);
                rv = *(const v4u*)pv; rdec0 = *(const f32x4*)pdec; rdec1 = *(const f32x4*)(pdec + 16);
            }
            if (wave < 4) {
                const int qi = wave; f32x4 o[2] = {(f32x4){0.f, 0.f, 0.f, 0.f}, (f32x4){0.f, 0.f, 0.f, 0.f}};
                bf16x8 qf[4];
#pragma unroll
                for (int kk = 0; kk < 4; ++kk) qf[kk] = ldfrag(lds + L_Q + ((16 * qi + l16) * QP + kk * 32 + lq * 8) * 2);
#pragma unroll
                for (int t = 0; t < 2; ++t) if (2 * t <= qi) {
                    f32x4 a0 = (f32x4){0.f, 0.f, 0.f, 0.f}, a1 = a0;
#pragma unroll
                    for (int kk = 0; kk < 4; ++kk) a0 = __builtin_amdgcn_mfma_f32_16x16x32_bf16(ldfrag(lds + L_K + ((32 * t + l16) * QP + kk * 32 + lq * 8) * 2), qf[kk], a0, 0, 0, 0);
                    if (2 * t == qi) {
#pragma unroll
                        for (int ii = 0; ii < 4; ++ii) if (4 * lq + ii > l16) a0[ii] = 0.f; }
                    if (2 * t + 1 <= qi) {
#pragma unroll
                        for (int kk = 0; kk < 4; ++kk) a1 = __builtin_amdgcn_mfma_f32_16x16x32_bf16(ldfrag(lds + L_K + ((32 * t + 16 + l16) * QP + kk * 32 + lq * 8) * 2), qf[kk], a1, 0, 0, 0);
                        if (2 * t + 1 == qi) {
#pragma unroll
                            for (int ii = 0; ii < 4; ++ii) if (4 * lq + ii > l16) a1[ii] = 0.f; } }
                    const v4u bw = (v4u){pk2(a0[0], a0[1]), pk2(a0[2], a0[3]), pk2(a1[0], a1[1]), pk2(a1[2], a1[3])};
#pragma unroll
                    for (int jv = 0; jv < 2; ++jv) {
                        const bf16x8 aw = cat8(ldtr(lds + L_V, VP * 2, 32 * t + 4 * lq, 16 * jv, l16), ldtr(lds + L_V, VP * 2, 32 * t + 16 + 4 * lq, 16 * jv, l16));
                        o[jv] = __builtin_amdgcn_mfma_f32_16x16x32_bf16(aw, __builtin_bit_cast(bf16x8, bw), o[jv], 0, 0, 0); } }
#pragma unroll
                for (int jv = 0; jv < 2; ++jv) {
#pragma unroll
                    for (int kk = 0; kk < 4; ++kk) o[jv] = __builtin_amdgcn_mfma_f32_16x16x32_bf16(ldfrag(lds + L_ST + ((n & 1) * 32 * QP + (16 * jv + l16) * QP + kk * 32 + lq * 8) * 2), qf[kk], o[jv], 0, 0, 0);
                    *(v2u*)(O + (row0 + 16 * qi + l16) * D + h * 256 + vs * 32 + 16 * jv + 4 * lq) = (v2u){pk2(o[jv][0], o[jv][1]), pk2(o[jv][2], o[jv][3])}; }
            } else {
#pragma unroll
                for (int kk = 0; kk < 2; ++kk) {
                    bf16x8 vb[2];
#pragma unroll
                    for (int jv = 0; jv < 2; ++jv) vb[jv] = cat8(ldtr(lds + L_V, VP * 2, 32 * kk + 8 * lq, 16 * jv, l16), ldtr(lds + L_V, VP * 2, 32 * kk + 8 * lq + 4, 16 * jv, l16));
#pragma unroll
                    for (int bq = 0; bq < 2; ++bq) { const bf16x8 ka = cat8(ldtr(lds + L_K, QP * 2, 32 * kk + 8 * lq, 16 * (hb + bq), l16), ldtr(lds + L_K, QP * 2, 32 * kk + 8 * lq + 4, 16 * (hb + bq), l16));
#pragma unroll
                        for (int jv = 0; jv < 2; ++jv) S[bq][jv] = __builtin_amdgcn_mfma_f32_16x16x32_bf16(ka, vb[jv], S[bq][jv], 0, 0, 0); } }
#pragma unroll
                for (int bq = 0; bq < 2; ++bq)
#pragma unroll
                    for (int jv = 0; jv < 2; ++jv) { S[bq][jv] = S[bq][jv] * (bq ? dec1 : dec0);
                        *(LAS v2u*)(lds + L_ST + (((n + 1) & 1) * 32 * QP + (16 * jv + l16) * QP + 16 * (hb + bq) + 4 * lq) * 2) = (v2u){pk2(S[bq][jv][0], S[bq][jv][1]), pk2(S[bq][jv][2], S[bq][jv][3])}; }
            }
            __syncthreads();
        }
    }
}
__device__ __forceinline__ void gla_post(const bf16* O, const bf16* H, bf16* CAT, const float* gnorm, int gw, int ngw, int lane) {
    const int hs = lane >> 5, cl = (lane & 31) * 8;
    float gn[8];
#pragma unroll
    for (int e = 0; e < 8; ++e) gn[e] = gnorm[cl + e];
#pragma unroll 2
    for (int m = gw; m < M; m += ngw) {
        v4u ow[2], rw[2];
#pragma unroll
        for (int p = 0; p < 2; ++p) { ow[p] = *(const v4u*)(O + (size_t)m * D + (hs + 2 * p) * 256 + cl); rw[p] = *(const v4u*)(H + (size_t)m * NGLA + 2048 + (hs + 2 * p) * 256 + cl); }
#pragma unroll
        for (int p = 0; p < 2; ++p) { float o[8], r[8], y[8]; unpack8(ow[p], o); unpack8(rw[p], r);
            float ss = 0.f;
#pragma unroll
            for (int e = 0; e < 8; ++e) ss += o[e] * o[e];
#pragma unroll
            for (int sh = 1; sh < 32; sh <<= 1) ss += __shfl_xor(ss, sh);
            const float rs = rsqrtf(ss * (1.f / 256.f) + EPS);
#pragma unroll
            for (int e = 0; e < 8; ++e) y[e] = o[e] * rs * gn[e] * (r[e] / (1.f + __expf(-r[e])));
            *(v4u*)(CAT + (size_t)m * D + (hs + 2 * p) * 256 + cl) = (v4u){pk2(y[0], y[1]), pk2(y[2], y[3]), pk2(y[4], y[5]), pk2(y[6], y[7])}; }
    }
}

#define XB_TMO      128
#define XB_XCNT(j)  (256  + 64 * (j))
#define XB_XSUB(j)  (1280 + 64 * (j))
#define XB_XGEN(j)  (2304 + 64 * (j))
#define XB_TOP      3328
#define XB_TOPGEN   3392
#define XCD_BAR_WORDS 3456
#define XB_SPIN_CAP (1u << 18)

__device__ __forceinline__ unsigned xb_ld(unsigned* p)              { return __hip_atomic_load(p, __ATOMIC_RELAXED, __HIP_MEMORY_SCOPE_AGENT); }
__device__ __forceinline__ unsigned xb_add(unsigned* p, unsigned v) { return __hip_atomic_fetch_add(p, v, __ATOMIC_RELAXED, __HIP_MEMORY_SCOPE_AGENT); }
__device__ __forceinline__ unsigned xb_xcc_id() { return (unsigned)__builtin_amdgcn_s_getreg((3 << 11) | 20) & 0xFu; }
#define XB_SPIN(cond, bar) do { unsigned _sp = 0; while (cond) { __builtin_amdgcn_s_sleep(1); \
    if ((++_sp & 255u) == 0u) { if (xb_ld(&(bar)[XB_TMO])) break; if (_sp > XB_SPIN_CAP) { atomicAdd(&(bar)[XB_TMO], 1u); break; } } } } while (0)

struct XcdBarrier {
    unsigned* bar; unsigned x;
    volatile LAS unsigned* st;
};

__device__ __forceinline__ XcdBarrier xcd_barrier_post(unsigned* bar, volatile LAS unsigned* st) {
    XcdBarrier b; b.bar = bar; b.x = xb_xcc_id(); b.st = st;
    if (threadIdx.x == 0) (void)xb_add(&bar[XB_XCNT(b.x)], 1u);
    return b;
}
__device__ __forceinline__ void xcd_barrier_complete(unsigned* bar, unsigned x, unsigned& nloc, unsigned& nx) {
    const unsigned G = gridDim.x * gridDim.y * gridDim.z;
    unsigned sum, cnt, mine, sp = 0u;
    for (;;) {
        sum = 0u; cnt = 0u; mine = 0u;
#pragma unroll
        for (unsigned j = 0; j < 16; ++j) { const unsigned c = xb_ld(&bar[XB_XCNT(j)]); sum += c; cnt += (c > 0u) ? 1u : 0u; mine = (j == x) ? c : mine; }
        if (sum == G) break;
        __builtin_amdgcn_s_sleep(1);
        if ((++sp & 255u) == 0u) { if (xb_ld(&bar[XB_TMO])) break; if (sp > XB_SPIN_CAP) { atomicAdd(&bar[XB_TMO], 1u); break; } }
    }
    nloc = mine > 0u ? mine : 1u; nx = cnt > 0u ? cnt : 1u;
}

__device__ __forceinline__ void xcd_barrier(const XcdBarrier& b) {
    asm volatile("s_waitcnt vmcnt(0)" ::: "memory");
    __syncthreads();
    if (threadIdx.x == 0) {
        unsigned* bar = b.bar;
        __builtin_amdgcn_s_waitcnt(0);
        unsigned nloc = b.st[0], nx = b.st[1];
        if (nloc == 0u) { xcd_barrier_complete(bar, b.x, nloc, nx); b.st[0] = nloc; b.st[1] = nx; }
        const unsigned old = xb_add(&bar[XB_XSUB(b.x)], 1u);
        const unsigned gen = old / nloc;
        if (old + 1u == (gen + 1u) * nloc) {
            __builtin_amdgcn_fence(__ATOMIC_RELEASE, "agent");
            asm volatile("s_waitcnt vmcnt(0)" ::: "memory");
            const unsigned og = xb_add(&bar[XB_TOP], 1u);
            const unsigned tg = og / nx;
            if (og + 1u == (tg + 1u) * nx) xb_add(&bar[XB_TOPGEN], 1u);
            else XB_SPIN(xb_ld(&bar[XB_TOPGEN]) == tg, bar);
            __builtin_amdgcn_fence(__ATOMIC_ACQUIRE, "agent");
            xb_add(&bar[XB_XGEN(b.x)], 1u);
            asm volatile("s_waitcnt vmcnt(0)" ::: "memory");
        } else {
            XB_SPIN(xb_ld(&bar[XB_XGEN(b.x)]) == gen, bar);
            __builtin_amdgcn_fence(__ATOMIC_ACQUIRE, "agent");
            asm volatile("s_waitcnt vmcnt(0)" ::: "memory");
        }
    }
    __syncthreads();
}

#define GRID_SYNC() do { XcdBarrier b_; b_.bar = (unsigned*)(GAS unsigned*)karg(21); b_.x = xb_xcc_id(); b_.st = (volatile LAS unsigned*)(lds + MISC_OFF); xcd_barrier(b_); } while (0)
constexpr int MISC_OFF = XCH_OFF + 8192;
#define GAS __attribute__((address_space(1)))
typedef const __attribute__((address_space(4))) unsigned long long* kaptr_t;
__device__ __forceinline__ unsigned long long karg(int k) { kaptr_t p = (kaptr_t)__builtin_amdgcn_kernarg_segment_ptr(); asm volatile("" : "+s"(p)); return p[k]; }
#define INF(k) ((const float*)(const GAS float*)karg(k))
#define XOUT() ((float*)(GAS float*)karg(20))
#define WSB(off) ((bf16*)(GAS bf16*)(karg(21) + (off)))
#define WSF(off) ((float*)(GAS float*)(karg(21) + (off)))
#define RSSP(i) WSF(60 * MiB + (size_t)(i) * 524288)
__global__ void __launch_bounds__(NTHR, 2) fwd_megakernel(Args args) {
    extern __shared__ __attribute__((aligned(16))) unsigned char lds_raw[];
    cg::grid_group grid = cg::this_grid();
    LAS unsigned char* lds = (LAS unsigned char*)lds_raw;
    { const int tid = threadIdx.x; if (tid < 2) ((LAS unsigned*)(lds + MISC_OFF))[tid] = 0u; }
    __syncthreads();
    grid.sync();
    (void)xcd_barrier_post((unsigned*)(GAS unsigned*)karg(21), (volatile LAS unsigned*)(lds + MISC_OFF));
    (void)args;
#define WAVE_IDS() const int tid_ = fresh_tid(), lane = tid_ & 63, wave = __builtin_amdgcn_readfirstlane(tid_ >> 6), G = gridDim.x, wg = blockIdx.x, gw = wg * NWAVES + wave, ngw = G * NWAVES

    {
        WAVE_IDS();
        LAS float* scr = (LAS float*)(lds + wave * 16384);
        constexpr int I_ABIN = 16 * 48, I_ABOUT = 16 * 32, I_GLAIN = 16 * 96, I_GLAOUT = 16 * 32, I_UP = 16 * 176, I_DN = 44 * 32;
        constexpr int NITEMS = I_ABIN + I_ABOUT + I_GLAIN + I_GLAOUT + 2 * I_UP + 2 * I_DN;
        for (int it = gw; it < NITEMS; it += ngw) {
            int r = it;
            if (r < I_ABIN) { const int kb = r / 48, nb = r % 48; transpose_item(INF(3), NAB, D, WSB(WS_WABIN), kb * 64, 512 + nb * 32, 512 + nb * 32, scr, lane, INF(1)); continue; } r -= I_ABIN;
            if (r < I_ABOUT) { const int kb = r / 32, nb = r % 32; transpose_item(INF(9), D, D, WSB(WS_WABOUT), kb * 64, nb * 32, nb * 32, scr, lane); continue; } r -= I_ABOUT;
            if (r < I_GLAIN) { const int kb = r / 96, nb = r % 96; transpose_item(INF(10), GLA_SRC_N, D, WSB(WS_WGLAIN), kb * 64, nb * 32, nb * 32, scr, lane, INF(1) + D); continue; } r -= I_GLAIN;
            if (r < I_GLAOUT) { const int kb = r / 32, nb = r % 32; transpose_item(INF(14), D, D, WSB(WS_WGLAOUT), kb * 64, nb * 32, nb * 32, scr, lane); continue; } r -= I_GLAOUT;
            if (r < 2 * I_UP) { const int l = r / I_UP, q = r % I_UP, kb = q / 176, nb = q % 176, n0 = nb * 32, isv = n0 >= FFD, ch = isv ? n0 - FFD : n0;
                transpose_item(INF(15) + (size_t)l * D * NUP, NUP, D, WSB(WS_WUP) + (size_t)l * NUP * D, kb * 64, n0, (ch >> 7) * 256 + isv * 128 + (ch & 127), scr, lane, INF(2) + (size_t)l * D); continue; } r -= 2 * I_UP;
            { const int l = r / I_DN, q = r % I_DN, kb = q / 32, nb = q % 32;
                transpose_item(INF(18) + (size_t)l * FFD * D, D, FFD, WSB(WS_WDN) + (size_t)l * D * FFD, kb * 64, nb * 32, nb * 32, scr, lane); }
        }
        __syncthreads();
        for (int fb = wg; fb < 256; fb += G) {
            const int g = fb & 3, kb = fb >> 2; LAS float* PW = (LAS float*)lds; LAS float* WI = (LAS float*)(lds + 65536);
            const float* poolw = INF(4) + (size_t)g * 16384; const float* abin = INF(3) + (size_t)(16 * kb) * NAB + g * 128;
#pragma unroll
            for (int q = 0; q < 8; ++q) *(LAS f32x4*)(PW + 4 * (tid_ + NTHR * q)) = *(const f32x4*)(poolw + 4 * (tid_ + NTHR * q));
            *(LAS f32x4*)(WI + 4 * tid_) = *(const f32x4*)(abin + (size_t)(tid_ >> 5) * NAB + (tid_ & 31) * 4);
            __syncthreads();
            const int n = tid_ & 127, kq = tid_ >> 7; const LAS float* wi = WI + (4 * kq) * 128;
            float s0 = 0.f, s1 = 0.f, s2 = 0.f, s3 = 0.f;
#pragma unroll 16
            for (int c = 0; c < 128; ++c) { const float w = PW[c * 128 + n]; s0 += wi[c] * w; s1 += wi[128 + c] * w; s2 += wi[256 + c] * w; s3 += wi[384 + c] * w; }
            const int k0 = 16 * kb + 4 * kq; const f32x4 m0 = *(const f32x4*)(INF(1) + k0);
            *(v2u*)(WSB(WS_WABIN) + (size_t)(g * 128 + n) * D + k0) = (v2u){pk2(s0 * m0[0], s1 * m0[1]), pk2(s2 * m0[2], s3 * m0[3])};
            __syncthreads();
        }
        { const float* glain = INF(10); const float* wg2 = INF(11); const float* mn1 = INF(1) + D; bf16* W_GLAIN = WSB(WS_WGLAIN);
        for (int idx = wg * NTHR + tid_; idx < 256 * 512; idx += G * NTHR) {
            const int k4 = idx >> 9, n = idx & 511;
            const float* gi = glain + (size_t)(4 * k4) * GLA_SRC_N + 3072; const float* g2 = wg2 + n;
            float t0 = 0.f, t1 = 0.f, t2 = 0.f, t3 = 0.f;
#pragma unroll
            for (int r = 0; r < 16; ++r) { const float w = g2[r * 512]; t0 += gi[r] * w; t1 += gi[GLA_SRC_N + r] * w; t2 += gi[2 * GLA_SRC_N + r] * w; t3 += gi[3 * GLA_SRC_N + r] * w; }
            const f32x4 mg = *(const f32x4*)(mn1 + 4 * k4);
            *(v2u*)(W_GLAIN + (size_t)(3072 + n) * D + 4 * k4) = (v2u){pk2(t0 * mg[0], t1 * mg[1]), pk2(t2 * mg[2], t3 * mg[3])};
        } }
        convert_rows(INF(0), WSB(WS_XS), RSSP(4), gw, ngw, lane);
    }
    GRID_SYNC();

    for (int l = 0; l < 2; ++l) {
        { const int N = (l == 0) ? NAB : NGLA;
          pg8::Gemm g{WSB(WS_XS), (l == 0) ? WSB(WS_WABIN) : WSB(WS_WGLAIN), M, N, D}; pg8::StaticOrder S; S.init(M, N, gridDim.x, blockIdx.x);
          pg8::EpiBf16P E{WSB(WS_H), N, (l == 0) ? (const float*)RSSP(4) : (const float*)RSSP(1), (LAS float*)(lds + XCH_OFF)};
          if (PHM & 1) pg8::gemm_phase<pg8::EpiBf16P, pg8::StaticOrder, true, true>(lds, g, S, E); }
        GRID_SYNC();
        if (l == 0) {
            if (PHM & 2) ab_mixer(WSB(WS_H), WSB(WS_CAT), INF(5), INF(6), INF(7), INF(8), blockIdx.x, gridDim.x, fresh_tid());
        } else {
            if (PHM & 4) gla_prep(WSB(WS_H), WSB(WS_CAT), WSF(WS_DEC), INF(12), blockIdx.x, gridDim.x, fresh_tid());
            GRID_SYNC();
            if (PHM & 8) gla_scan(lds, WSB(WS_H), WSF(WS_DEC), WSB(WS_XN), blockIdx.x, gridDim.x, fresh_tid());
            GRID_SYNC();
            { WAVE_IDS(); if (PHM & 16) gla_post(WSB(WS_XN), WSB(WS_H), WSB(WS_CAT), INF(13), gw, ngw, lane); }
        }
        GRID_SYNC();
        { pg8::Gemm g{WSB(WS_CAT), (l == 0) ? WSB(WS_WABOUT) : WSB(WS_WGLAOUT), M, D, D}; pg8::StaticOrder S; S.init(M, D, gridDim.x, blockIdx.x);
          pg8::EpiRes E{(const float*)nullptr, WSB(WS_XS), D, RSSP(2 * l), (LAS float*)(lds + XCH_OFF)};
          if (PHM & 32) pg8::gemm_phase<pg8::EpiRes, pg8::StaticOrder, true, true>(lds, g, S, E); }
        GRID_SYNC();
        { pg8::Gemm g{WSB(WS_XS), WSB(WS_WUP) + (size_t)l * NUP * D, M, NUP, D}; pg8::StaticOrder S; S.init(M, NUP, gridDim.x, blockIdx.x);
          pg8::EpiFfnUp E{WSB(WS_H), INF(16) + (size_t)l * 3 * FFD, INF(17) + (size_t)l * FFD, WSF(WS_ULAST), WSF(WS_UFIRST), WSF(WS_VFIRST), (LAS f32x4*)(lds + XCH_OFF), RSSP(2 * l)};
          if (PHM & 64) pg8::gemm_phase<pg8::EpiFfnUp, pg8::StaticOrder, true, true, true>(lds, g, S, E); }
        GRID_SYNC();
        { pg8::Gemm g{WSB(WS_H), WSB(WS_WDN) + (size_t)l * D * FFD, M, D, FFD}; pg8::StaticOrder S; S.init(M, D, gridDim.x, blockIdx.x);
          if (PHM & 256) {
          const float* cw = INF(16) + (size_t)l * 3 * FFD; const float* cb = INF(17) + (size_t)l * FFD;
          const float* ULAST = WSF(WS_ULAST); const float* UFIRST = WSF(WS_UFIRST); const float* VFIRST = WSF(WS_VFIRST); bf16* ACT = WSB(WS_H);
          pg8::Unit u;
          for (int i = 0; S.next(i, u); ++i) {
              if ((u.pm & 15) == 0) continue;
              for (int c4 = fresh_tid(); c4 < FFD / 4; c4 += NTHR) {
                  const int ch = 4 * c4;
                  const f32x4 uf0 = *(const f32x4*)(UFIRST + (size_t)(u.pm * 2) * FFD + ch), uf1 = *(const f32x4*)(UFIRST + (size_t)(u.pm * 2 + 1) * FFD + ch);
                  const f32x4 ul0 = *(const f32x4*)(ULAST + (size_t)((u.pm - 1) * 2) * FFD + ch), ul1 = *(const f32x4*)(ULAST + (size_t)((u.pm - 1) * 2 + 1) * FFD + ch);
                  const f32x4 vf0 = *(const f32x4*)(VFIRST + (size_t)(u.pm * 2) * FFD + ch), vf1 = *(const f32x4*)(VFIRST + (size_t)(u.pm * 2 + 1) * FFD + ch);
                  const f32x4 a0 = *(const f32x4*)(cw + ch), a1 = *(const f32x4*)(cw + FFD + ch), a2 = *(const f32x4*)(cw + 2 * FFD + ch), bb = *(const f32x4*)(cb + ch);
                  const f32x4 u0 = bb + a0 * ul0 + a1 * ul1 + a2 * uf0, u1 = bb + a0 * ul1 + a1 * uf0 + a2 * uf1;
                  const f32x2 g00 = pg8::gelu_pk((f32x2){u0[0], u0[1]}), g01 = pg8::gelu_pk((f32x2){u0[2], u0[3]}), g10 = pg8::gelu_pk((f32x2){u1[0], u1[1]}), g11 = pg8::gelu_pk((f32x2){u1[2], u1[3]});
                  *(v2u*)(ACT + (size_t)(u.pm * 256) * FFD + ch) = (v2u){pk2(g00.x * vf0[0], g00.y * vf0[1]), pk2(g01.x * vf0[2], g01.y * vf0[3])};
                  *(v2u*)(ACT + (size_t)(u.pm * 256 + 1) * FFD + ch) = (v2u){pk2(g10.x * vf1[0], g10.y * vf1[1]), pk2(g11.x * vf1[2], g11.y * vf1[3])};
              }
          }
          asm volatile("s_waitcnt vmcnt(0)" ::: "memory"); __syncthreads();
          }
          if (l == 0 || gridDim.x != 256) { pg8::EpiRes E{(const float*)nullptr, WSB(WS_XS), D, RSSP(2 * l + 1), (LAS float*)(lds + XCH_OFF)};
              pg8::gemm_phase<pg8::EpiRes, pg8::StaticOrder, true, true>(lds, g, S, E); }
          else { pg8::EpiResFinal E{WSB(WS_XS), XOUT(), D, RSSP(3), INF(19), (unsigned*)(GAS unsigned*)(karg(21) + 16384), (LAS float*)(lds + XCH_OFF)};
              pg8::gemm_phase<pg8::EpiResFinal, pg8::StaticOrder, true, true>(lds, g, S, E); } }
        if (l == 0) GRID_SYNC();
    }
    if (gridDim.x != 256) { GRID_SYNC(); WAVE_IDS(); final_norm_rows(WSB(WS_XS), XOUT(), INF(19), RSSP(3), gw, ngw, lane); }
}

extern "C" void kernel_launch(void* const* d_in, const int* in_sizes, int n_in, void* d_out, int out_size, void* d_ws, size_t ws_size, hipStream_t stream) {
    static int grid_blocks = 0;
    if (grid_blocks == 0) {
        if (n_in != 20 || out_size != M * D || ws_size < WS_END) { fprintf(stderr, "kernel_launch: unexpected shapes (n_in %d out %d ws %zu)\n", n_in, out_size, ws_size); grid_blocks = -1; return; }
        int dev = 0, cus = 0, per_cu = 0;
        hipGetDevice(&dev); hipDeviceGetAttribute(&cus, hipDeviceAttributeMultiprocessorCount, dev);
        if (hipFuncSetAttribute((const void*)fwd_megakernel, hipFuncAttributeMaxDynamicSharedMemorySize, LDS_BYTES) != hipSuccess) fprintf(stderr, "kernel_launch: hipFuncSetAttribute failed\n");
        if (hipOccupancyMaxActiveBlocksPerMultiprocessor(&per_cu, (const void*)fwd_megakernel, NTHR, LDS_BYTES) != hipSuccess || per_cu < 1) { fprintf(stderr, "kernel_launch: occupancy query says %d\n", per_cu); per_cu = 1; }
        (void)hipGetLastError();
        grid_blocks = cus * per_cu;
    }
    if (grid_blocks < 0) return;
    if (hipMemsetAsync(d_ws, 0, 65536, stream) != hipSuccess) { fprintf(stderr, "kernel_launch: memset failed\n"); return; }
    Args a{};
    for (int i = 0; i < 20; ++i) a.in[i] = (const float*)d_in[i];
    a.out = (float*)d_out; a.ws = (unsigned char*)d_ws;
    void* kargs[] = {&a};
    hipError_t e = hipLaunchCooperativeKernel((const void*)fwd_megakernel, dim3(grid_blocks), dim3(NTHR), kargs, LDS_BYTES, stream);
    if (e != hipSuccess) fprintf(stderr, "cooperative launch failed: %s (grid %d)\n", hipGetErrorString(e), grid_blocks);
}
```

```cpp
#include <hip/hip_runtime.h>
#include <hip/hip_cooperative_groups.h>
#include <cstdio>
#include <cstdint>
namespace cg = cooperative_groups;
__device__ __forceinline__ int fresh_tid() { int t = threadIdx.x; asm volatile("" : "+v"(t)); return t; }
namespace pg8 {
#define PG8_LAS __attribute__((address_space(3)))
typedef unsigned short bf16_t;
typedef short bf16x8 __attribute__((ext_vector_type(8)));
typedef float f32x4 __attribute__((ext_vector_type(4)));
typedef unsigned u32x4 __attribute__((ext_vector_type(4)));
constexpr int BM = 256, BK = 64, HALF = 128, HTB = HALF * BK * 2  , STAGE_BYTES = 8 * HTB, NXCD = 8, WGM = 8;

__host__ __device__ __forceinline__ int lds_byte(int r, int c) { const int st = (r >> 4) * 2 + (c >> 5), rr = r & 15, cc = c & 31, ob = rr * 64 + cc * 2; return st * 1024 + (ob ^ (((ob >> 9) & 1) << 5)); }
__host__ __device__ __forceinline__ void stage_rc(int b, int& R, int& C) { const int st = b / 1024, sb = b % 1024, swz = sb ^ (((sb >> 9) & 1) << 5); R = (st >> 1) * 16 + swz / 64; C = (st & 1) * 32 + (swz % 64) / 2; }
__host__ __device__ __forceinline__ int perm32(int rho) { const int n = rho >> 4, i = rho & 15; return 8 * (i >> 2) + 4 * n + (i & 3); }

struct Unit { int pm, pn; };
struct Gemm { const bf16_t* A; const bf16_t* Bt; int M, N, K; };

struct StaticOrder {
    int nM, nN, nwg, G, c;
    __host__ __device__ void init(int M, int N, int G_, int c_) { nM = M / BM; nN = N / BM; nwg = nM * nN; G = G_; c = c_; }
    __host__ __device__ bool next(int i, Unit& u) const {
        const long L = (long)i * G + c; if (L >= nwg) return false;
        int wgid = (int)L; { const int q = nwg / NXCD, r = nwg % NXCD, xcd = wgid % NXCD, off = wgid / NXCD; wgid = (xcd < r ? xcd * (q + 1) : r * (q + 1) + (xcd - r) * q) + off; }
        const int nig = WGM * nN, gid = wgid / nig, fm = gid * WGM, gsz = (nM - fm) < WGM ? (nM - fm) : WGM;
        u.pm = fm + ((wgid % nig) % gsz); u.pn = (wgid % nig) / gsz; return true;
    }
    __device__ __forceinline__ void a_ready(const Unit&) const {}
    __device__ __forceinline__ void done(const Unit&) const {}
};

typedef float f32x2c_t __attribute__((ext_vector_type(2))); typedef __bf16 bf16x2c_t __attribute__((ext_vector_type(2)));
__device__ __forceinline__ unsigned cvt_pk_bf16(float lo, float hi) { const f32x2c_t v = {lo, hi}; const bf16x2c_t b = __builtin_convertvector(v, bf16x2c_t); return __builtin_bit_cast(unsigned, b); }
typedef float f32x2 __attribute__((ext_vector_type(2)));
__device__ __forceinline__ f32x2 gelu_pk(f32x2 v) {
    const f32x2 av = __builtin_elementwise_abs(v), d = av * 0.2316418882f + 1.0f;
    f32x2 t; t.x = __builtin_amdgcn_rcpf(d.x); t.y = __builtin_amdgcn_rcpf(d.y);
    f32x2 q = t * 0.5307027145f + (-0.7265760135f); q = q * t + 0.7107068705f; q = q * t + (-0.142248368f); q = q * t + 0.127414796f; q = q * t;
    const f32x2 s = (v * v) * (-0.72134752044f);
    f32x2 e; e.x = __builtin_amdgcn_exp2f(s.x); e.y = __builtin_amdgcn_exp2f(s.y);
    const f32x2 m = av * (q * e);
    return __builtin_elementwise_max(v, (f32x2){0.f, 0.f}) - m;
}
}
namespace pg8 {
template <class Epi, class Sched, bool ALIGN_EPI = false, bool SP2 = false, bool APERM = false  >
__device__ __forceinline__ void gemm_phase(PG8_LAS unsigned char* lds, const Gemm g, const Sched& S, const Epi& E) {
    const int tid = fresh_tid(), wid = __builtin_amdgcn_readfirstlane(tid >> 6), lane = tid & 63, wr = wid >> 2, wc = wid & 3, fr = lane & 15, fq = lane >> 4;
    const int K = g.K, nt = K / BK;
    unsigned voffA[2], voffB[2];
#pragma unroll
    for (int i = 0; i < 2; ++i) { int R, C; stage_rc(tid * 16 + i * 8192, R, C); const int Rb = Epi::PERM ? ((R & ~31) + perm32(R & 31)) : R;
        const int Ra = APERM ? ((R & ~63) + 4 * (R & 15) + ((R >> 4) & 3)) : R;
        voffA[i] = (unsigned)(Ra * K + C) * 2u; voffB[i] = (unsigned)(Rb * K + C) * 2u; }
    const size_t kstep = (size_t)(BK * 2);
    const size_t hstep = (size_t)HALF * K * 2;
    const size_t tstep = 2 * hstep;
    const unsigned ldsw = (unsigned)wid * 1024u;
    const int aoff = lds_byte(wr * 64 + fr, fq * 8), boff = lds_byte(wc * 32 + fr, fq * 8);
#define PG8_SA(b, h) (((b) * 2 + (h)) * HTB)
#define PG8_SB(b, h) ((4 + (b) * 2 + (h)) * HTB)
#define PG8_STAGE(bufoff, gbase, voff) do { _Pragma("unroll") for (int _i = 0; _i < 2; ++_i) \
        __builtin_amdgcn_global_load_lds((const unsigned*)((const char*)(gbase) + (voff)[_i]), (PG8_LAS unsigned*)(lds + (bufoff) + ldsw + _i * 8192), 16, 0, 0); } while (0)
#define PG8_LDA(dst, b, h) do { _Pragma("unroll") for (int m = 0; m < 4; ++m) _Pragma("unroll") for (int k = 0; k < 2; ++k) dst[m][k] = *(const PG8_LAS bf16x8*)(lds + PG8_SA(b, h) + aoff + m * 2048 + k * 1024); } while (0)
#define PG8_LDB(dst, b, h) do { _Pragma("unroll") for (int n = 0; n < 2; ++n) _Pragma("unroll") for (int k = 0; k < 2; ++k) dst[n][k] = *(const PG8_LAS bf16x8*)(lds + PG8_SB(b, h) + boff + n * 2048 + k * 1024); } while (0)
#define PG8_MMA(ai, bj, At, Bt) do { __builtin_amdgcn_s_setprio(1); _Pragma("unroll") for (int m = 0; m < 4; ++m) _Pragma("unroll") for (int n = 0; n < 2; ++n) _Pragma("unroll") for (int k = 0; k < 2; ++k) \
        acc[ai][bj][m][n] = __builtin_amdgcn_mfma_f32_16x16x32_bf16(Bt[n][k], At[m][k], acc[ai][bj][m][n], 0, 0, 0); __builtin_amdgcn_s_setprio(0); } while (0)
#define PG8_WAIT_V(n) asm volatile("s_waitcnt vmcnt(" #n ")" ::: "memory")
#define PG8_WAIT_L(n) asm volatile("s_waitcnt lgkmcnt(" #n ")" ::: "memory")
#define PG8_BAR __builtin_amdgcn_s_barrier()
#define PG8_SCHED __builtin_amdgcn_sched_barrier(0)
    Unit cur, nxt; int ui = 0;
    if (!S.next(0, cur)) return;
    f32x4 acc[2][2][4][2];
#pragma unroll
    for (int a = 0; a < 2; ++a)
#pragma unroll
        for (int b = 0; b < 2; ++b)
#pragma unroll
            for (int m = 0; m < 4; ++m)
#pragma unroll
                for (int n = 0; n < 2; ++n) acc[a][b][m][n] = (f32x4){0.f, 0.f, 0.f, 0.f};
    bf16x8 At[4][2], B0[2][2], B1[2][2];
    const char* cA = (const char*)g.A + (size_t)cur.pm * tstep; const char* cB = (const char*)g.Bt + (size_t)cur.pn * tstep;
    S.a_ready(cur);
    if constexpr (SP2) {
        PG8_STAGE(PG8_SB(0, 0), cB, voffB); PG8_STAGE(PG8_SB(0, 1), cB + hstep, voffB); PG8_STAGE(PG8_SA(0, 0), cA, voffA); PG8_STAGE(PG8_SA(0, 1), cA + hstep, voffA);
        if (wr == 1) PG8_BAR;
        PG8_WAIT_V(2); PG8_BAR;
        PG8_STAGE(PG8_SB(1, 0), cB + kstep, voffB); PG8_STAGE(PG8_SA(1, 0), cA + kstep, voffA); PG8_STAGE(PG8_SB(1, 1), cB + hstep + kstep, voffB);
        PG8_WAIT_V(6); PG8_BAR;
    } else {
        PG8_STAGE(PG8_SB(0, 0), cB, voffB); PG8_STAGE(PG8_SA(0, 0), cA, voffA); PG8_STAGE(PG8_SB(0, 1), cB + hstep, voffB); PG8_STAGE(PG8_SA(0, 1), cA + hstep, voffA);
        if (wr == 1) PG8_BAR;
        PG8_WAIT_V(4); PG8_BAR;
        PG8_STAGE(PG8_SB(1, 0), cB + kstep, voffB); PG8_STAGE(PG8_SA(1, 0), cA + kstep, voffA); PG8_STAGE(PG8_SB(1, 1), cB + hstep + kstep, voffB);
        PG8_WAIT_V(6); PG8_BAR;
    }
    for (;;) {
        const bool has_next = S.next(ui + 1, nxt);
        const char* nA = has_next ? (const char*)g.A + (size_t)nxt.pm * tstep : cA; const char* nB = has_next ? (const char*)g.Bt + (size_t)nxt.pn * tstep : cB;
        for (int t = 0; t < nt; t += 2) {
            const bool last = (t == nt - 2);
            const char* a1 = cA + (size_t)(t + 1) * kstep;
            const char* a2 = last ? nA : cA + (size_t)(t + 2) * kstep; const char* b2 = last ? nB : cB + (size_t)(t + 2) * kstep;
            const char* a3 = a2 + kstep; const char* b3 = b2 + kstep;
            if (last && has_next) S.a_ready(nxt);
            if constexpr (SP2) {
            PG8_LDB(B0, 0, 0); PG8_LDB(B1, 0, 1); PG8_SCHED; PG8_LDA(At, 0, 0); PG8_STAGE(PG8_SA(1, 1), a1 + hstep, voffA);
            PG8_WAIT_V(8); PG8_WAIT_L(0); PG8_BAR; PG8_MMA(0, 0, At, B0); PG8_MMA(0, 1, At, B1); PG8_BAR; PG8_SCHED;
            PG8_LDA(At, 0, 1); PG8_STAGE(PG8_SB(0, 0), b2, voffB); PG8_STAGE(PG8_SB(0, 1), b2 + hstep, voffB); PG8_STAGE(PG8_SA(0, 0), a2, voffA);
            PG8_WAIT_V(8); PG8_WAIT_L(0); PG8_BAR; PG8_MMA(1, 0, At, B0); PG8_MMA(1, 1, At, B1); PG8_BAR; PG8_SCHED;
            PG8_LDB(B0, 1, 0); PG8_LDB(B1, 1, 1); PG8_SCHED; PG8_LDA(At, 1, 0); PG8_STAGE(PG8_SA(0, 1), a2 + hstep, voffA);
            PG8_WAIT_V(8); PG8_WAIT_L(0); PG8_BAR; PG8_MMA(0, 0, At, B0); PG8_MMA(0, 1, At, B1); PG8_BAR; PG8_SCHED;
            PG8_LDA(At, 1, 1); PG8_STAGE(PG8_SB(1, 0), b3, voffB); PG8_STAGE(PG8_SB(1, 1), b3 + hstep, voffB); PG8_STAGE(PG8_SA(1, 0), a3, voffA);
            PG8_WAIT_V(8); PG8_WAIT_L(0); PG8_BAR; PG8_MMA(1, 0, At, B0); PG8_MMA(1, 1, At, B1); PG8_BAR; PG8_SCHED;
            } else {
            PG8_LDB(B0, 0, 0); PG8_SCHED; PG8_LDA(At, 0, 0); PG8_STAGE(PG8_SA(1, 1), a1 + hstep, voffA);
            PG8_WAIT_L(8); PG8_BAR; PG8_WAIT_L(0); PG8_MMA(0, 0, At, B0); PG8_BAR; PG8_SCHED;
            PG8_LDB(B1, 0, 1); PG8_STAGE(PG8_SB(0, 0), b2, voffB);
            PG8_BAR; PG8_WAIT_L(0); PG8_MMA(0, 1, At, B1); PG8_BAR;
            PG8_LDA(At, 0, 1); PG8_STAGE(PG8_SA(0, 0), a2, voffA);
            PG8_BAR; PG8_WAIT_L(0); PG8_MMA(1, 0, At, B0); PG8_BAR; PG8_SCHED;
            PG8_STAGE(PG8_SB(0, 1), b2 + hstep, voffB);
            PG8_WAIT_V(6); PG8_BAR; PG8_MMA(1, 1, At, B1); PG8_BAR;
            PG8_LDB(B0, 1, 0); PG8_SCHED; PG8_LDA(At, 1, 0); PG8_STAGE(PG8_SA(0, 1), a2 + hstep, voffA);
            PG8_WAIT_L(8); PG8_BAR; PG8_WAIT_L(0); PG8_MMA(0, 0, At, B0); PG8_BAR; PG8_SCHED;
            PG8_LDB(B1, 1, 1); PG8_STAGE(PG8_SB(1, 0), b3, voffB);
            PG8_BAR; PG8_WAIT_L(0); PG8_MMA(0, 1, At, B1); PG8_BAR;
            PG8_LDA(At, 1, 1); PG8_STAGE(PG8_SA(1, 0), a3, voffA);
            PG8_BAR; PG8_WAIT_L(0); PG8_MMA(1, 0, At, B0); PG8_BAR; PG8_SCHED;
            PG8_STAGE(PG8_SB(1, 1), b3 + hstep, voffB);
            PG8_WAIT_V(6); PG8_BAR; PG8_MMA(1, 1, At, B1); PG8_BAR;
            }
        }
        if constexpr (ALIGN_EPI) { if (wr == 0) PG8_BAR; }
        if constexpr (!Epi::AFTER_DRAIN) { E(acc, cur, wr, wc, fr, fq); S.done(cur); }
        if (!has_next) break;
#pragma unroll
        for (int a = 0; a < 2; ++a)
#pragma unroll
            for (int b = 0; b < 2; ++b)
#pragma unroll
                for (int m = 0; m < 4; ++m)
#pragma unroll
                    for (int n = 0; n < 2; ++n) acc[a][b][m][n] = (f32x4){0.f, 0.f, 0.f, 0.f};
        cur = nxt; cA = nA; cB = nB; ++ui;
        if constexpr (ALIGN_EPI) { if (wr == 1) PG8_BAR; }
    }
    PG8_WAIT_V(0);
    if constexpr (!ALIGN_EPI) { if (wr == 0) PG8_BAR; }
    PG8_BAR;
    if constexpr (Epi::AFTER_DRAIN) { E.fused(acc, cur, wr, wc, fr, fq, lds, wid, lane); S.done(cur); }
#undef PG8_SA
#undef PG8_SB
#undef PG8_STAGE
#undef PG8_LDA
#undef PG8_LDB
#undef PG8_MMA
#undef PG8_WAIT_V
#undef PG8_WAIT_L
#undef PG8_BAR
#undef PG8_SCHED
}
}
namespace pg8 {
template <int CTRL> __device__ __forceinline__ float dppf(float v) { return __builtin_bit_cast(float, __builtin_amdgcn_update_dpp(0, __builtin_bit_cast(int, v), CTRL, 0xf, 0xf, false)); }

template <int CTRL> __device__ __forceinline__ float dppo(float old, float v) { return __builtin_bit_cast(float, __builtin_amdgcn_update_dpp(__builtin_bit_cast(int, old), __builtin_bit_cast(int, v), CTRL, 0xf, 0xf, false)); }
struct EpiBf16P {
    static constexpr bool PERM = true, AFTER_DRAIN = false;
    bf16_t* O; int ldc; const float* rss; PG8_LAS float* tab;
    __device__ __forceinline__ void operator()(const f32x4 (&acc)[2][2][4][2], const Unit& u, int wr, int wc, int fr, int fq) const {
        const int row0 = u.pm * BM + wr * 64 + fr, col0 = u.pn * BM + wc * 32 + 8 * fq;
        if (wr == 0) { const int trow = wc * 64 + fq * 16 + fr, r_ = u.pm * BM + trow;
            tab[trow] = __builtin_amdgcn_rsqf(((rss[r_] + rss[32768 + r_]) + (rss[65536 + r_] + rss[98304 + r_])) * (1.f / 1024.f) + 1e-6f); }
        asm volatile("s_waitcnt lgkmcnt(0)" ::: "memory"); __builtin_amdgcn_s_barrier(); asm volatile("" ::: "memory");
#pragma unroll
        for (int ai = 0; ai < 2; ++ai)
#pragma unroll
            for (int m = 0; m < 4; ++m) { const int row = row0 + ai * HALF + m * 16; bf16_t* rowp = O + (size_t)row * ldc + col0;
                const float rs = tab[wr * 64 + fr + ai * HALF + m * 16];
#pragma unroll
                for (int bj = 0; bj < 2; ++bj) { const f32x4 v0 = acc[ai][bj][m][0] * rs, v1 = acc[ai][bj][m][1] * rs;
                    u32x4 w; w.x = cvt_pk_bf16(v0[0], v0[1]); w.y = cvt_pk_bf16(v0[2], v0[3]); w.z = cvt_pk_bf16(v1[0], v1[1]); w.w = cvt_pk_bf16(v1[2], v1[3]);
                    *(u32x4*)(rowp + bj * HALF) = w; } }
    }
};
struct EpiRes {
    static constexpr bool PERM = true, AFTER_DRAIN = false;
    const float* base32; bf16_t* xs; int ldc; float* rssp; PG8_LAS float* red;
    __device__ __forceinline__ void operator()(const f32x4 (&acc)[2][2][4][2], const Unit& u, int wr, int wc, int fr, int fq) const {
        const int col0 = u.pn * BM + wc * 32 + 8 * fq;
        const size_t off0 = (size_t)(u.pm * BM + wr * 64 + fr) * ldc + col0;
#pragma unroll
        for (int ai = 0; ai < 2; ++ai) {
            u32x4 bv[4][2];
#pragma unroll
            for (int m = 0; m < 4; ++m)
#pragma unroll
                for (int bj = 0; bj < 2; ++bj) bv[m][bj] = *(const u32x4*)(xs + off0 + (size_t)(ai * HALF + m * 16) * ldc + bj * HALF);
#pragma unroll
            for (int m = 0; m < 4; ++m) { float ss = 0.f;
#pragma unroll
                for (int bj = 0; bj < 2; ++bj) { const size_t off = off0 + (size_t)(ai * HALF + m * 16) * ldc + bj * HALF; const u32x4 b = bv[m][bj];
                    f32x4 o0 = (f32x4){__builtin_bit_cast(float, b.x << 16), __builtin_bit_cast(float, b.x & 0xffff0000u), __builtin_bit_cast(float, b.y << 16), __builtin_bit_cast(float, b.y & 0xffff0000u)};
                    f32x4 o1 = (f32x4){__builtin_bit_cast(float, b.z << 16), __builtin_bit_cast(float, b.z & 0xffff0000u), __builtin_bit_cast(float, b.w << 16), __builtin_bit_cast(float, b.w & 0xffff0000u)};
                    o0 = o0 + acc[ai][bj][m][0]; o1 = o1 + acc[ai][bj][m][1];
                    ss += ((o0[0] * o0[0] + o0[1] * o0[1]) + (o0[2] * o0[2] + o0[3] * o0[3])) + ((o1[0] * o1[0] + o1[1] * o1[1]) + (o1[2] * o1[2] + o1[3] * o1[3]));
                    u32x4 w; w.x = cvt_pk_bf16(o0[0], o0[1]); w.y = cvt_pk_bf16(o0[2], o0[3]); w.z = cvt_pk_bf16(o1[0], o1[1]); w.w = cvt_pk_bf16(o1[2], o1[3]); *(u32x4*)(xs + off) = w; }
                ss += __shfl_xor(ss, 16); ss += __shfl_xor(ss, 32);
                if (fq == 0) red[wc * 256 + ai * HALF + wr * 64 + m * 16 + fr] = ss; }
            asm volatile("" ::: "memory"); }
        asm volatile("s_waitcnt lgkmcnt(0)" ::: "memory"); __builtin_amdgcn_s_barrier(); asm volatile("" ::: "memory");
        if (wr == 0) { const int row = wc * 64 + fq * 16 + fr;
            rssp[(size_t)u.pn * 32768 + u.pm * BM + row] = (red[row] + red[256 + row]) + (red[512 + row] + red[768 + row]); }
    }
};
struct EpiResFinal {
    static constexpr bool PERM = true, AFTER_DRAIN = false;
    const bf16_t* xs; float* out; int ldc; float* rssp; const float* g; unsigned* cnt; PG8_LAS float* red;
    __device__ __forceinline__ void operator()(const f32x4 (&acc_)[2][2][4][2], const Unit& u, int wr, int wc, int fr, int fq) const {
        f32x4 (&acc)[2][2][4][2] = const_cast<f32x4 (&)[2][2][4][2]>(acc_);
        const int col0 = u.pn * BM + wc * 32 + 8 * fq;
        const size_t off0 = (size_t)(u.pm * BM + wr * 64 + fr) * ldc + col0;
#pragma unroll
        for (int ai = 0; ai < 2; ++ai) {
          u32x4 bv[4][2];
#pragma unroll
          for (int m = 0; m < 4; ++m)
#pragma unroll
              for (int bj = 0; bj < 2; ++bj) bv[m][bj] = *(const u32x4*)(xs + off0 + (size_t)(ai * HALF + m * 16) * ldc + bj * HALF);
#pragma unroll
            for (int m = 0; m < 4; ++m) { float ss = 0.f;
#pragma unroll
                for (int bj = 0; bj < 2; ++bj) {
                    const u32x4 b = bv[m][bj];
                    const f32x4 o0 = (f32x4){__builtin_bit_cast(float, b.x << 16), __builtin_bit_cast(float, b.x & 0xffff0000u), __builtin_bit_cast(float, b.y << 16), __builtin_bit_cast(float, b.y & 0xffff0000u)} + acc[ai][bj][m][0];
                    const f32x4 o1 = (f32x4){__builtin_bit_cast(float, b.z << 16), __builtin_bit_cast(float, b.z & 0xffff0000u), __builtin_bit_cast(float, b.w << 16), __builtin_bit_cast(float, b.w & 0xffff0000u)} + acc[ai][bj][m][1];
                    ss += ((o0[0] * o0[0] + o0[1] * o0[1]) + (o0[2] * o0[2] + o0[3] * o0[3])) + ((o1[0] * o1[0] + o1[1] * o1[1]) + (o1[2] * o1[2] + o1[3] * o1[3]));
                    acc[ai][bj][m][0] = o0; acc[ai][bj][m][1] = o1; }
                ss += __shfl_xor(ss, 16); ss += __shfl_xor(ss, 32);
                if (fq == 0) red[wc * 256 + ai * HALF + wr * 64 + m * 16 + fr] = ss;
                asm volatile("" ::: "memory"); } }
        asm volatile("s_waitcnt lgkmcnt(0)" ::: "memory"); __builtin_amdgcn_s_barrier(); asm volatile("" ::: "memory");
        const int trow = wc * 64 + fq * 16 + fr;
        float* slot = rssp + (size_t)u.pm * BM + trow;
        if (wr == 0) __hip_atomic_store(slot + (size_t)u.pn * 32768, (red[trow] + red[256 + trow]) + (red[512 + trow] + red[768 + trow]), __ATOMIC_RELAXED, __HIP_MEMORY_SCOPE_AGENT);
        asm volatile("s_waitcnt vmcnt(0)" ::: "memory"); __builtin_amdgcn_s_barrier(); asm volatile("" ::: "memory");
        if (wr == 0 && wc == 0 && fq == 0 && fr == 0) {
            unsigned* c = cnt + 64 * u.pm; __hip_atomic_fetch_add(c, 1u, __ATOMIC_RELAXED, __HIP_MEMORY_SCOPE_AGENT);
            unsigned spins = 0; while (__hip_atomic_load(c, __ATOMIC_RELAXED, __HIP_MEMORY_SCOPE_AGENT) < 4u && ++spins < (1u << 22)) __builtin_amdgcn_s_sleep(1);
        }
        asm volatile("s_waitcnt vmcnt(0)" ::: "memory"); __builtin_amdgcn_s_barrier(); asm volatile("" ::: "memory");
        if (wr == 0) { const float t = (__hip_atomic_load(slot, __ATOMIC_RELAXED, __HIP_MEMORY_SCOPE_AGENT) + __hip_atomic_load(slot + 32768, __ATOMIC_RELAXED, __HIP_MEMORY_SCOPE_AGENT))
                                     + (__hip_atomic_load(slot + 65536, __ATOMIC_RELAXED, __HIP_MEMORY_SCOPE_AGENT) + __hip_atomic_load(slot + 98304, __ATOMIC_RELAXED, __HIP_MEMORY_SCOPE_AGENT));
            red[1024 + trow] = __builtin_amdgcn_rsqf(t * (1.f / 1024.f) + 1e-6f); }
        asm volatile("s_waitcnt lgkmcnt(0)" ::: "memory"); __builtin_amdgcn_s_barrier(); asm volatile("" ::: "memory");
#pragma unroll
        for (int bj = 0; bj < 2; ++bj) { const f32x4 g0 = *(const f32x4*)(g + col0 + bj * HALF), g1 = *(const f32x4*)(g + col0 + bj * HALF + 4);
#pragma unroll
            for (int ai = 0; ai < 2; ++ai)
#pragma unroll
                for (int m = 0; m < 4; ++m) { const float rs = red[1024 + ai * HALF + wr * 64 + m * 16 + fr]; const size_t off = off0 + (size_t)(ai * HALF + m * 16) * ldc + bj * HALF;
                    *(f32x4*)(out + off) = acc[ai][bj][m][0] * rs * g0; *(f32x4*)(out + off + 4) = acc[ai][bj][m][1] * rs * g1; } }
    }
};
struct EpiFfnUp {
    static constexpr bool PERM = true, AFTER_DRAIN = false;
    static constexpr int FFD = 2816;
    bf16_t* act; const float* cw; const float* cb; float* ulast; float* ufirst; float* vfirst; PG8_LAS f32x4* xch; const float* rss;
    __device__ __forceinline__ void operator()(const f32x4 (&acc)[2][2][4][2], const Unit& u, int wr, int wc, int fr, int fq) const {
        const int ch0 = u.pn * 128 + wc * 32 + 8 * fq;
        f32x4 w0[2], w1[2], w2[2], bb[2];
#pragma unroll
        for (int n = 0; n < 2; ++n) { w0[n] = *(const f32x4*)(cw + ch0 + 4 * n); w1[n] = *(const f32x4*)(cw + FFD + ch0 + 4 * n); w2[n] = *(const f32x4*)(cw + 2 * FFD + ch0 + 4 * n); bb[n] = *(const f32x4*)(cb + ch0 + 4 * n); }
        PG8_LAS float* tab = (PG8_LAS float*)(xch + 256);
#define RSTD4(r_) __builtin_amdgcn_rsqf(((rss[(r_)] + rss[32768 + (r_)]) + (rss[65536 + (r_)] + rss[98304 + (r_)])) * (1.f / 1024.f) + 1e-6f)
        if (wr == 0) { const int trow = wc * 64 + fq * 16 + fr; tab[trow] = RSTD4(u.pm * BM + trow); }
        const int rl = wr * 64 + 4 * fr;
        if (fr == 15) {
#pragma unroll
            for (int ai = 0; ai < 2; ++ai)
#pragma unroll
                for (int q = 0; q < 2; ++q) { PG8_LAS f32x4* s = xch + (((((ai * 2 + wr) * 4 + wc) * 4 + fq) * 2 + q) * 2); s[0] = acc[ai][0][2 + q][0]; s[1] = acc[ai][0][2 + q][1]; }
        }
        asm volatile("s_waitcnt lgkmcnt(0)" ::: "memory"); __builtin_amdgcn_s_barrier(); asm volatile("" ::: "memory");
        if (fr == 15 && wr == 1) {
#pragma unroll
            for (int q = 0; q < 2; ++q) { const float r3 = tab[rl + HALF + 2 + q]; float* g = ulast + (size_t)(u.pm * 2 + q) * FFD + ch0; *(f32x4*)g = acc[1][0][2 + q][0] * r3; *(f32x4*)(g + 4) = acc[1][0][2 + q][1] * r3; } }
        if (fr == 0 && wr == 0) {
#pragma unroll
            for (int q = 0; q < 2; ++q) { const float r0 = tab[q]; float* g = ufirst + (size_t)(u.pm * 2 + q) * FFD + ch0; *(f32x4*)g = acc[0][0][q][0] * r0; *(f32x4*)(g + 4) = acc[0][0][q][1] * r0;
                float* h = vfirst + (size_t)(u.pm * 2 + q) * FFD + ch0; *(f32x4*)h = acc[0][1][q][0] * r0; *(f32x4*)(h + 4) = acc[0][1][q][1] * r0; } }
#pragma unroll
        for (int ai = 0; ai < 2; ++ai) {
            f32x4 h2[2] = {(f32x4){0.f, 0.f, 0.f, 0.f}, (f32x4){0.f, 0.f, 0.f, 0.f}}, h3[2] = {h2[0], h2[0]};
            if (wr == 1 || ai == 1) { const int sai = (wr == 1) ? ai : 0, swr = (wr == 1) ? 0 : 1;
                const PG8_LAS f32x4* s = xch + ((((sai * 2 + swr) * 4 + wc) * 4 + fq) * 2) * 2; const float ra = tab[sai * HALF + swr * 64 + 62], rb = tab[sai * HALF + swr * 64 + 63];
                h2[0] = s[0] * ra; h2[1] = s[1] * ra; h3[0] = s[2] * rb; h3[1] = s[3] * rb; }
            const f32x4 rs4 = *(const PG8_LAS f32x4*)(tab + rl + ai * HALF);
            f32x4 us[4][2];
#pragma unroll
            for (int m = 0; m < 4; ++m) { us[m][0] = acc[ai][0][m][0] * rs4[m]; us[m][1] = acc[ai][0][m][1] * rs4[m]; }
            f32x4 s2[2], s3[2];
#pragma unroll
            for (int n = 0; n < 2; ++n)
#pragma unroll
                for (int e = 0; e < 4; ++e) { s2[n][e] = dppo<0x111>(h2[n][e], us[2][n][e]); s3[n][e] = dppo<0x111>(h3[n][e], us[3][n][e]); }
#pragma unroll
            for (int m = 0; m < 4; ++m) {
                f32x4 uc[2];
#pragma unroll
                for (int n = 0; n < 2; ++n) { const f32x4 um1 = (m == 0) ? s3[n] : us[m - 1][n], um2 = (m == 0) ? s2[n] : (m == 1) ? s3[n] : us[m - 2][n];
                    uc[n] = bb[n] + w0[n] * um2 + w1[n] * um1 + w2[n] * us[m][n]; }
                const f32x4 v0 = acc[ai][1][m][0] * rs4[m], v1 = acc[ai][1][m][1] * rs4[m];
                const f32x2 a = gelu_pk((f32x2){uc[0][0], uc[0][1]}), b = gelu_pk((f32x2){uc[0][2], uc[0][3]}), c = gelu_pk((f32x2){uc[1][0], uc[1][1]}), d = gelu_pk((f32x2){uc[1][2], uc[1][3]});
                u32x4 w; w.x = cvt_pk_bf16(a.x * v0[0], a.y * v0[1]); w.y = cvt_pk_bf16(b.x * v0[2], b.y * v0[3]); w.z = cvt_pk_bf16(c.x * v1[0], c.y * v1[1]); w.w = cvt_pk_bf16(d.x * v1[2], d.y * v1[3]);
                *(u32x4*)(act + (size_t)(u.pm * BM + ai * HALF + rl + m) * FFD + ch0) = w;
            }
        }
    }
};
}
#define LAS __attribute__((address_space(3)))
typedef unsigned short bf16;
typedef unsigned v4u __attribute__((ext_vector_type(4)));
typedef unsigned v2u __attribute__((ext_vector_type(2)));
typedef float f32x4 __attribute__((ext_vector_type(4)));
typedef float f32x2 __attribute__((ext_vector_type(2)));
typedef short bf16x8 __attribute__((ext_vector_type(8)));
constexpr int NWAVES = 8, NTHR = 512;
constexpr int BATCH = 8, SEQ = 4096, D = 1024, M = BATCH * SEQ, FFD = 2816, NUP = 2 * FFD, NAB = 2048, NGLA = 3584, GLA_SRC_N = 3088;
constexpr float EPS = 1e-6f;
constexpr size_t MiB = 1u << 20;
constexpr size_t WS_DEC = 1 * MiB, WS_ULAST = 2 * MiB, WS_UFIRST = 5 * MiB, WS_VFIRST = 8 * MiB;
constexpr size_t WS_WABIN = 12 * MiB, WS_WABOUT = 16 * MiB, WS_WGLAIN = 18 * MiB, WS_WGLAOUT = 25 * MiB, WS_WUP = 27 * MiB  , WS_WDN = 49 * MiB  ;
constexpr size_t WS_XN = 64 * MiB, WS_CAT = 128 * MiB, WS_H = 192 * MiB, WS_XS = 416 * MiB  , WS_END = 480 * MiB;
constexpr int LDS_BYTES = 147456, XCH_OFF = 131072;
#ifndef PHM
#define PHM 0xffff
#endif

__device__ __forceinline__ float bflo(unsigned w) { return __builtin_bit_cast(float, w << 16); }
__device__ __forceinline__ float bfhi(unsigned w) { return __builtin_bit_cast(float, w & 0xffff0000u); }
__device__ __forceinline__ unsigned pk2(float lo, float hi) { return pg8::cvt_pk_bf16(lo, hi); }
__device__ __forceinline__ float wave_sum(float v) {
#pragma unroll
    for (int o = 1; o < 64; o <<= 1) v += __shfl_xor(v, o);
    return v;
}
#define LDS_WAIT() asm volatile("s_waitcnt lgkmcnt(0)" ::: "memory")

__device__ __forceinline__ void transpose_item(const float* W, int ldw, int K, bf16* WT, int k0, int n0, int trow0, LAS float* scr, int lane, const float* g = nullptr) {
    float tv[32];
#pragma unroll
    for (int i = 0; i < 32; ++i) { const int kk = 2 * i + (lane >> 5); tv[i] = W[(size_t)(k0 + kk) * ldw + n0 + (lane & 31)]; }
#pragma unroll
    for (int i = 0; i < 32; ++i) { const int kk = 2 * i + (lane >> 5); scr[kk * 33 + (lane & 31)] = tv[i] * (g ? g[k0 + kk] : 1.f); }
    LDS_WAIT(); asm volatile("" ::: "memory");
    const int c = lane & 7;
#pragma unroll
    for (int j = 0; j < 4; ++j) { const int n = (lane >> 3) + 8 * j; const LAS float* s = scr + (8 * c) * 33 + n;
        v4u o; o.x = pk2(s[0 * 33], s[1 * 33]); o.y = pk2(s[2 * 33], s[3 * 33]); o.z = pk2(s[4 * 33], s[5 * 33]); o.w = pk2(s[6 * 33], s[7 * 33]);
        *(v4u*)(WT + (size_t)(trow0 + n) * K + k0 + 8 * c) = o; }
    LDS_WAIT(); asm volatile("" ::: "memory");
}

struct Args { const float* in[20]; float* out; unsigned char* ws; };

__device__ __forceinline__ void convert_rows(const float* X, bf16* XS, float* rss, int gw, int ngw, int lane) {
#pragma unroll 2
    for (int m = gw; m < M; m += ngw) {
        const f32x4* xr = (const f32x4*)(X + (size_t)m * D) + lane;
        f32x4 v[4]; float s = 0.f;
#pragma unroll
        for (int j = 0; j < 4; ++j) { v[j] = xr[64 * j]; s += (v[j].x * v[j].x + v[j].y * v[j].y) + (v[j].z * v[j].z + v[j].w * v[j].w); }
        s = wave_sum(s);
        unsigned long long* o8 = (unsigned long long*)(XS + (size_t)m * D) + lane;
#pragma unroll
        for (int j = 0; j < 4; ++j) o8[64 * j] = (unsigned long long)pk2(v[j].x, v[j].y) | ((unsigned long long)pk2(v[j].z, v[j].w) << 32);
        if (lane < 4) rss[(size_t)lane * 32768 + m] = lane == 0 ? s : 0.f;
    }
}
__device__ __forceinline__ void final_norm_rows(const bf16* XS, float* OUT, const float* g, const float* rss, int gw, int ngw, int lane) {
    f32x4 gv[4];
#pragma unroll
    for (int j = 0; j < 4; ++j) gv[j] = ((const f32x4*)g)[lane + 64 * j];
#pragma unroll 4
    for (int m = gw; m < M; m += ngw) {
        const v2u* xr = (const v2u*)(XS + (size_t)m * D) + lane; f32x4* orow = (f32x4*)(OUT + (size_t)m * D) + lane;
        const float rstd = rsqrtf(((rss[m] + rss[32768 + m]) + (rss[65536 + m] + rss[98304 + m])) * (1.f / D) + EPS);
#pragma unroll
        for (int j = 0; j < 4; ++j) { const v2u w = xr[64 * j]; orow[64 * j] = (f32x4){bflo(w.x), bfhi(w.x), bflo(w.y), bfhi(w.y)} * rstd * gv[j]; }
    }
}

__device__ __forceinline__ void unpack8(const v4u w, float (&f)[8]) {
    f[0] = bflo(w.x); f[1] = bfhi(w.x); f[2] = bflo(w.y); f[3] = bfhi(w.y); f[4] = bflo(w.z); f[5] = bfhi(w.z); f[6] = bflo(w.w); f[7] = bfhi(w.w);
}
__device__ __forceinline__ void ab_mixer(const bf16* H, bf16* CAT, const float* pool_b, const float* pool_scale, const float* scw, const float* scb, int wg, int nwg, int tid) {
    const int cv = tid & 127, sub = tid >> 7;
    float pa[8], pb[8], pc[8], pd[8];
    if (cv < 64) {
#pragma unroll
        for (int e = 0; e < 8; ++e) { pa[e] = pool_b[cv * 8 + e]; pb[e] = pool_scale[cv * 8 + e]; pc[e] = 0.f; pd[e] = 0.f; }
    } else {
        const int c = (cv - 64) * 8;
#pragma unroll
        for (int e = 0; e < 8; ++e) { pa[e] = scw[c + e]; pb[e] = scw[512 + c + e]; pc[e] = scw[1024 + c + e]; pd[e] = scb[c + e]; }
    }
    for (int chunk = wg * 4 + sub; chunk < M / 32; chunk += nwg * 4) {
        const int r0 = chunk * 32, t0 = r0 & (SEQ - 1);
        bf16* outp = CAT + (size_t)r0 * D + cv * 8;
        if (cv < 64) {
            const int win = 2 << (cv >> 4);
            const bf16* p = H + (size_t)r0 * NAB + cv * 8;
            float s[8], f[8];
#pragma unroll
            for (int e = 0; e < 8; ++e) s[e] = 0.f;
            if (t0 > 0) for (int i = 1; i < win; ++i) { unpack8(*(const v4u*)(p - (size_t)i * NAB), f);
#pragma unroll
                for (int e = 0; e < 8; ++e) s[e] += f[e]; }
#pragma unroll 4
            for (int jr = 0; jr < 32; ++jr) {
                const int t = t0 + jr; float cur[8], y[8];
                unpack8(*(const v4u*)(p + (size_t)jr * NAB), cur);
                if (jr >= 1 && t >= win) { unpack8(*(const v4u*)(p + (ptrdiff_t)(jr - win) * NAB), f);
#pragma unroll
                    for (int e = 0; e < 8; ++e) s[e] -= f[e]; }
#pragma unroll
                for (int e = 0; e < 8; ++e) s[e] += cur[e];
                const float inv = 1.f / (float)((t + 1) < win ? (t + 1) : win);
#pragma unroll
                for (int e = 0; e < 8; ++e) y[e] = (s[e] * inv - cur[e] + pa[e]) * pb[e];
                v4u o; o.x = pk2(y[0], y[1]); o.y = pk2(y[2], y[3]); o.z = pk2(y[4], y[5]); o.w = pk2(y[6], y[7]);
                *(v4u*)(outp + (size_t)jr * D) = o;
            }
        } else {
            const bf16* p = H + (size_t)r0 * NAB + (cv - 64) * 8;
            float p1[8], p2[8], a[8], b[8];
#pragma unroll
            for (int e = 0; e < 8; ++e) { p1[e] = 0.f; p2[e] = 0.f; }
            if (t0 > 0) { unpack8(*(const v4u*)(p - NAB + 1024), a); unpack8(*(const v4u*)(p - NAB + 1536), b);
#pragma unroll
                for (int e = 0; e < 8; ++e) p1[e] = a[e] * b[e];
                unpack8(*(const v4u*)(p - 2 * NAB + 1024), a); unpack8(*(const v4u*)(p - 2 * NAB + 1536), b);
#pragma unroll
                for (int e = 0; e < 8; ++e) p2[e] = a[e] * b[e]; }
#pragma unroll 4
            for (int jr = 0; jr < 32; ++jr) {
                float sb[8], y[8];
                unpack8(__builtin_nontemporal_load((const v4u*)(p + (size_t)jr * NAB + 512)), sb); unpack8(__builtin_nontemporal_load((const v4u*)(p + (size_t)jr * NAB + 1024)), a); unpack8(__builtin_nontemporal_load((const v4u*)(p + (size_t)jr * NAB + 1536)), b);
#pragma unroll
                for (int e = 0; e < 8; ++e) { const float pr = a[e] * b[e]; y[e] = sb[e] * (pd[e] + pc[e] * pr + pb[e] * p1[e] + pa[e] * p2[e]); p2[e] = p1[e]; p1[e] = pr; }
                v4u o; o.x = pk2(y[0], y[1]); o.y = pk2(y[2], y[3]); o.z = pk2(y[4], y[5]); o.w = pk2(y[6], y[7]);
                *(v4u*)(outp + (size_t)jr * D) = o;
            }
        }
    }
}

__device__ __forceinline__ float gate_log(float z) { return (fminf(z, 0.f) - __logf(1.f + __expf(-fabsf(z)))) * (1.f / 16.f); }
__device__ __forceinline__ void gla_prep(bf16* H, bf16* KDT, float* DEC, const float* b_g, int wg, int nwg, int tid) {
    const int half = tid >> 8, cp = tid & 255, c = 2 * cp;
    const float bg0 = b_g[c], bg1 = b_g[c + 1];
    const float QS = 0.08838834764831845f;
    for (int it = wg * 2 + half; it < BATCH * 64; it += nwg * 2) {
        bf16* base = H + (size_t)it * 64 * NGLA + c;
        unsigned cg[8], cq[8], ck[8], ng[8], nq[8], nk[8];
#pragma unroll
        for (int m = 0; m < 8; ++m) { const bf16* rp = base + (size_t)m * NGLA; cg[m] = *(const unsigned*)(rp + 3072); cq[m] = *(const unsigned*)rp; ck[m] = *(const unsigned*)(rp + 512); }
        float c0 = 0.f, c1 = 0.f;
        for (int g = 0; g < 8; ++g) {
            bf16* gb = base + (size_t)(g * 8) * NGLA;
            if (g < 7) {
#pragma unroll
                for (int m = 0; m < 8; ++m) { const bf16* rp = gb + (size_t)(8 + m) * NGLA; ng[m] = *(const unsigned*)(rp + 3072); nq[m] = *(const unsigned*)rp; nk[m] = *(const unsigned*)(rp + 512); }
            }
#pragma unroll
            for (int m = 0; m < 8; ++m) { bf16* rp = gb + (size_t)m * NGLA;
                c0 += gate_log(bflo(cg[m]) + bg0); c1 += gate_log(bfhi(cg[m]) + bg1);
                const float d0 = bflo(ck[m]) * __expf(-c0), d1 = bfhi(ck[m]) * __expf(-c1);
                *(unsigned*)rp = pk2(bflo(cq[m]) * QS * __expf(c0), bfhi(cq[m]) * QS * __expf(c1));
                *(unsigned*)(rp + 512) = pk2(d0, d1);
            }
#pragma unroll
            for (int m = 0; m < 8; ++m) { cg[m] = ng[m]; cq[m] = nq[m]; ck[m] = nk[m]; }
        }
        *(f32x2*)(DEC + (size_t)it * 512 + c) = (f32x2){__expf(c0), __expf(c1)};
    }
}

constexpr int QP = 136, VP = 40;
constexpr int L_Q = 0, L_K = L_Q + 64 * QP * 2, L_V = L_K + 64 * QP * 2, L_ST = L_V + 64 * VP * 2, L_SCAN_END = L_ST + 2 * 32 * QP * 2;
static_assert(L_SCAN_END <= XCH_OFF, "scan LDS");
typedef short v4i16_t __attribute__((ext_vector_type(4)));
__device__ __forceinline__ bf16x8 ldfrag(const LAS unsigned char* p) { return *(const LAS bf16x8*)p; }
__device__ __forceinline__ v4i16_t ldtr(const LAS unsigned char* img, int pitch, int row0, int col0, int l16) {
    return __builtin_amdgcn_ds_read_tr16_b64_v4i16((LAS v4i16_t*)(img + (row0 + (l16 >> 2)) * pitch + (col0 + 4 * (l16 & 3)) * 2)); }
__device__ __forceinline__ bf16x8 cat8(v4i16_t a, v4i16_t b) { return __builtin_shufflevector(a, b, 0, 1, 2, 3, 4, 5, 6, 7); }
__device__ __forceinline__ void gla_scan(LAS unsigned char* lds, const bf16* H, const float* DEC, bf16* O, int wg, int nwg, int tid) {
    const int wave = __builtin_amdgcn_readfirstlane(tid >> 6), lane = tid & 63, l16 = lane & 15, lq = lane >> 4;
    for (int item = wg; item < 256; item += nwg) {
        const int x = item & 7, j = item >> 3, bh = x * 4 + (j >> 3), vs = j & 7, b = bh >> 2, h = bh & 3;
        __syncthreads();
        for (int i = tid; i < 2 * 32 * QP / 2; i += NTHR) ((LAS unsigned*)(lds + L_ST))[i] = 0u;
        f32x4 S[2][2];
#pragma unroll
        for (int bq = 0; bq < 2; ++bq)
#pragma unroll
            for (int jv = 0; jv < 2; ++jv) S[bq][jv] = (f32x4){0.f, 0.f, 0.f, 0.f};
        const int hb = (wave & 3) * 2;
        const int r0 = tid >> 4, c16 = tid & 15, mv = (tid & 255) >> 2, c8v = tid & 3;
        const bf16* pq = H + ((size_t)b * SEQ + r0) * NGLA + h * 128 + c16 * 8;
        const bf16* pv = H + ((size_t)b * SEQ + mv) * NGLA + 1024 + h * 256 + vs * 32 + c8v * 8;
        const float* pdec = DEC + ((size_t)(b * 64)) * 512 + h * 128 + 16 * hb + 4 * lq;
        v4u rq0 = *(const v4u*)pq, rq1 = *(const v4u*)(pq + (size_t)32 * NGLA), rk0 = *(const v4u*)(pq + 512), rk1 = *(const v4u*)(pq + (size_t)32 * NGLA + 512);
        v4u rv = *(const v4u*)pv;
        f32x4 rdec0 = *(const f32x4*)pdec, rdec1 = *(const f32x4*)(pdec + 16);
        for (int n = 0; n < 64; ++n) {
            const size_t row0 = (size_t)b * SEQ + n * 64;
            *(LAS v4u*)(lds + L_Q + (r0 * QP + c16 * 8) * 2) = rq0; *(LAS v4u*)(lds + L_Q + ((r0 + 32) * QP + c16 * 8) * 2) = rq1;
            *(LAS v4u*)(lds + L_K + (r0 * QP + c16 * 8) * 2) = rk0; *(LAS v4u*)(lds + L_K + ((r0 + 32) * QP + c16 * 8) * 2) = rk1;
            if (tid < 256) *(LAS v4u*)(lds + L_V + (mv * VP + c8v * 8) * 2) = rv;
            const f32x4 dec0 = rdec0, dec1 = rdec1;
            __syncthreads();
            if (n + 1 < 64) {
                pq += (size_t)64 * NGLA; pv += (size_t)64 * NGLA; pdec += 512;
                rq0 = *(const v4u*)pq; rq1 = *(const v4u*)(pq + (size_t)32 * NGLA); rk0 = *(const v4u*)(pq + 512); rk1 = *(const v4u*)(pq + (size_t)32 * NGLA + 512);
                rv = *(const v4u*)pv; rdec0 = *(const f32x4*)pdec; rdec1 = *(const f32x4*)(pdec + 16);
            }
            if (wave < 4) {
                const int qi = wave; f32x4 o[2] = {(f32x4){0.f, 0.f, 0.f, 0.f}, (f32x4){0.f, 0.f, 0.f, 0.f}};
                bf16x8 qf[4];
#pragma unroll
                for (int kk = 0; kk < 4; ++kk) qf[kk] = ldfrag(lds + L_Q + ((16 * qi + l16) * QP + kk * 32 + lq * 8) * 2);
#pragma unroll
                for (int t = 0; t < 2; ++t) if (2 * t <= qi) {
                    f32x4 a0 = (f32x4){0.f, 0.f, 0.f, 0.f}, a1 = a0;
#pragma unroll
                    for (int kk = 0; kk < 4; ++kk) a0 = __builtin_amdgcn_mfma_f32_16x16x32_bf16(ldfrag(lds + L_K + ((32 * t + l16) * QP + kk * 32 + lq * 8) * 2), qf[kk], a0, 0, 0, 0);
                    if (2 * t == qi) {
#pragma unroll
                        for (int ii = 0; ii < 4; ++ii) if (4 * lq + ii > l16) a0[ii] = 0.f; }
                    if (2 * t + 1 <= qi) {
#pragma unroll
                        for (int kk = 0; kk < 4; ++kk) a1 = __builtin_amdgcn_mfma_f32_16x16x32_bf16(ldfrag(lds + L_K + ((32 * t + 16 + l16) * QP + kk * 32 + lq * 8) * 2), qf[kk], a1, 0, 0, 0);
                        if (2 * t + 1 == qi) {
#pragma unroll
                            for (int ii = 0; ii < 4; ++ii) if (4 * lq + ii > l16) a1[ii] = 0.f; } }
                    const v4u bw = (v4u){pk2(a0[0], a0[1]), pk2(a0[2], a0[3]), pk2(a1[0], a1[1]), pk2(a1[2], a1[3])};
#pragma unroll
                    for (int jv = 0; jv < 2; ++jv) {
                        const bf16x8 aw = cat8(ldtr(lds + L_V, VP * 2, 32 * t + 4 * lq, 16 * jv, l16), ldtr(lds + L_V, VP * 2, 32 * t + 16 + 4 * lq, 16 * jv, l16));
                        o[jv] = __builtin_amdgcn_mfma_f32_16x16x32_bf16(aw, __builtin_bit_cast(bf16x8, bw), o[jv], 0, 0, 0); } }
#pragma unroll
                for (int jv = 0; jv < 2; ++jv) {
#pragma unroll
                    for (int kk = 0; kk < 4; ++kk) o[jv] = __builtin_amdgcn_mfma_f32_16x16x32_bf16(ldfrag(lds + L_ST + ((n & 1) * 32 * QP + (16 * jv + l16) * QP + kk * 32 + lq * 8) * 2), qf[kk], o[jv], 0, 0, 0);
                    *(v2u*)(O + (row0 + 16 * qi + l16) * D + h * 256 + vs * 32 + 16 * jv + 4 * lq) = (v2u){pk2(o[jv][0], o[jv][1]), pk2(o[jv][2], o[jv][3])}; }
            } else {
#pragma unroll
                for (int kk = 0; kk < 2; ++kk) {
                    bf16x8 vb[2];
#pragma unroll
                    for (int jv = 0; jv < 2; ++jv) vb[jv] = cat8(ldtr(lds + L_V, VP * 2, 32 * kk + 8 * lq, 16 * jv, l16), ldtr(lds + L_V, VP * 2, 32 * kk + 8 * lq + 4, 16 * jv, l16));
#pragma unroll
                    for (int bq = 0; bq < 2; ++bq) { const bf16x8 ka = cat8(ldtr(lds + L_K, QP * 2, 32 * kk + 8 * lq, 16 * (hb + bq), l16), ldtr(lds + L_K, QP * 2, 32 * kk + 8 * lq + 4, 16 * (hb + bq), l16));
#pragma unroll
                        for (int jv = 0; jv < 2; ++jv) S[bq][jv] = __builtin_amdgcn_mfma_f32_16x16x32_bf16(ka, vb[jv], S[bq][jv], 0, 0, 0); } }
#pragma unroll
                for (int bq = 0; bq < 2; ++bq)
#pragma unroll
                    for (int jv = 0; jv < 2; ++jv) { S[bq][jv] = S[bq][jv] * (bq ? dec1 : dec0);
                        *(LAS v2u*)(lds + L_ST + (((n + 1) & 1) * 32 * QP + (16 * jv + l16) * QP + 16 * (hb + bq) + 4 * lq) * 2) = (v2u){pk2(S[bq][jv][0], S[bq][jv][1]), pk2(S[bq][jv][2], S[bq][jv][3])}; }
            }
            __syncthreads();
        }
    }
}
__device__ __forceinline__ void gla_post(const bf16* O, const bf16* H, bf16* CAT, const float* gnorm, int gw, int ngw, int lane) {
    const int hs = lane >> 5, cl = (lane & 31) * 8;
    float gn[8];
#pragma unroll
    for (int e = 0; e < 8; ++e) gn[e] = gnorm[cl + e];
#pragma unroll 2
    for (int m = gw; m < M; m += ngw) {
        v4u ow[2], rw[2];
#pragma unroll
        for (int p = 0; p < 2; ++p) { ow[p] = __builtin_nontemporal_load((const v4u*)(O + (size_t)m * D + (hs + 2 * p) * 256 + cl)); rw[p] = __builtin_nontemporal_load((const v4u*)(H + (size_t)m * NGLA + 2048 + (hs + 2 * p) * 256 + cl)); }
#pragma unroll
        for (int p = 0; p < 2; ++p) { float o[8], r[8], y[8]; unpack8(ow[p], o); unpack8(rw[p], r);
            float ss = 0.f;
#pragma unroll
            for (int e = 0; e < 8; ++e) ss += o[e] * o[e];
#pragma unroll
            for (int sh = 1; sh < 32; sh <<= 1) ss += __shfl_xor(ss, sh);
            const float rs = rsqrtf(ss * (1.f / 256.f) + EPS);
#pragma unroll
            for (int e = 0; e < 8; ++e) y[e] = o[e] * rs * gn[e] * (r[e] / (1.f + __expf(-r[e])));
            *(v4u*)(CAT + (size_t)m * D + (hs + 2 * p) * 256 + cl) = (v4u){pk2(y[0], y[1]), pk2(y[2], y[3]), pk2(y[4], y[5]), pk2(y[6], y[7])}; }
    }
}

#define XB_TMO      128
#define XB_XCNT(j)  (256  + 64 * (j))
#define XB_XSUB(j)  (1280 + 64 * (j))
#define XB_XGEN(j)  (2304 + 64 * (j))
#define XB_TOP      3328
#define XB_TOPGEN   3392
#define XCD_BAR_WORDS 3456
#define XB_SPIN_CAP (1u << 18)

__device__ __forceinline__ unsigned xb_ld(unsigned* p)              { return __hip_atomic_load(p, __ATOMIC_RELAXED, __HIP_MEMORY_SCOPE_AGENT); }
__device__ __forceinline__ unsigned xb_add(unsigned* p, unsigned v) { return __hip_atomic_fetch_add(p, v, __ATOMIC_RELAXED, __HIP_MEMORY_SCOPE_AGENT); }
__device__ __forceinline__ unsigned xb_xcc_id() { return (unsigned)__builtin_amdgcn_s_getreg((3 << 11) | 20) & 0xFu; }
#define XB_SPIN(cond, bar) do { unsigned _sp = 0; while (cond) { __builtin_amdgcn_s_sleep(1); \
    if ((++_sp & 255u) == 0u) { if (xb_ld(&(bar)[XB_TMO])) break; if (_sp > XB_SPIN_CAP) { atomicAdd(&(bar)[XB_TMO], 1u); break; } } } } while (0)

struct XcdBarrier {
    unsigned* bar; unsigned x;
    volatile LAS unsigned* st;
};

__device__ __forceinline__ XcdBarrier xcd_barrier_post(unsigned* bar, volatile LAS unsigned* st) {
    XcdBarrier b; b.bar = bar; b.x = xb_xcc_id(); b.st = st;
    if (threadIdx.x == 0) (void)xb_add(&bar[XB_XCNT(b.x)], 1u);
    return b;
}
__device__ __forceinline__ void xcd_barrier_complete(unsigned* bar, unsigned x, unsigned& nloc, unsigned& nx) {
    const unsigned G = gridDim.x * gridDim.y * gridDim.z;
    unsigned sum, cnt, mine, sp = 0u;
    for (;;) {
        sum = 0u; cnt = 0u; mine = 0u;
#pragma unroll
        for (unsigned j = 0; j < 16; ++j) { const unsigned c = xb_ld(&bar[XB_XCNT(j)]); sum += c; cnt += (c > 0u) ? 1u : 0u; mine = (j == x) ? c : mine; }
        if (sum == G) break;
        __builtin_amdgcn_s_sleep(1);
        if ((++sp & 255u) == 0u) { if (xb_ld(&bar[XB_TMO])) break; if (sp > XB_SPIN_CAP) { atomicAdd(&bar[XB_TMO], 1u); break; } }
    }
    nloc = mine > 0u ? mine : 1u; nx = cnt > 0u ? cnt : 1u;
}

__device__ __forceinline__ void xcd_barrier(const XcdBarrier& b) {
    asm volatile("s_waitcnt vmcnt(0)" ::: "memory");
    __syncthreads();
    if (threadIdx.x == 0) {
        unsigned* bar = b.bar;
        __builtin_amdgcn_s_waitcnt(0);
        unsigned nloc = b.st[0], nx = b.st[1];
        if (nloc == 0u) { xcd_barrier_complete(bar, b.x, nloc, nx); b.st[0] = nloc; b.st[1] = nx; }
        const unsigned old = xb_add(&bar[XB_XSUB(b.x)], 1u);
        const unsigned gen = old / nloc;
        if (old + 1u == (gen + 1u) * nloc) {
            __builtin_amdgcn_fence(__ATOMIC_RELEASE, "agent");
            asm volatile("s_waitcnt vmcnt(0)" ::: "memory");
            const unsigned og = xb_add(&bar[XB_TOP], 1u);
            const unsigned tg = og / nx;
            if (og + 1u == (tg + 1u) * nx) xb_add(&bar[XB_TOPGEN], 1u);
            else XB_SPIN(xb_ld(&bar[XB_TOPGEN]) == tg, bar);
            __builtin_amdgcn_fence(__ATOMIC_ACQUIRE, "agent");
            xb_add(&bar[XB_XGEN(b.x)], 1u);
            asm volatile("s_waitcnt vmcnt(0)" ::: "memory");
        } else {
            XB_SPIN(xb_ld(&bar[XB_XGEN(b.x)]) == gen, bar);
            __builtin_amdgcn_fence(__ATOMIC_ACQUIRE, "agent");
            asm volatile("s_waitcnt vmcnt(0)" ::: "memory");
        }
    }
    __syncthreads();
}

#define GRID_SYNC() do { XcdBarrier b_; b_.bar = (unsigned*)(GAS unsigned*)karg(21); b_.x = xb_xcc_id(); b_.st = (volatile LAS unsigned*)(lds + MISC_OFF); xcd_barrier(b_); } while (0)
constexpr int MISC_OFF = XCH_OFF + 8192;
#define GAS __attribute__((address_space(1)))
typedef const __attribute__((address_space(4))) unsigned long long* kaptr_t;
__device__ __forceinline__ unsigned long long karg(int k) { kaptr_t p = (kaptr_t)__builtin_amdgcn_kernarg_segment_ptr(); asm volatile("" : "+s"(p)); return p[k]; }
#define INF(k) ((const float*)(const GAS float*)karg(k))
#define XOUT() ((float*)(GAS float*)karg(20))
#define WSB(off) ((bf16*)(GAS bf16*)(karg(21) + (off)))
#define WSF(off) ((float*)(GAS float*)(karg(21) + (off)))
#define RSSP(i) WSF(60 * MiB + (size_t)(i) * 524288)
__global__ void __launch_bounds__(NTHR, 2) fwd_megakernel(Args args) {
    extern __shared__ __attribute__((aligned(16))) unsigned char lds_raw[];
    cg::grid_group grid = cg::this_grid();
    LAS unsigned char* lds = (LAS unsigned char*)lds_raw;
    { const int tid = threadIdx.x; if (tid < 2) ((LAS unsigned*)(lds + MISC_OFF))[tid] = 0u; }
    __syncthreads();
    grid.sync();
    (void)xcd_barrier_post((unsigned*)(GAS unsigned*)karg(21), (volatile LAS unsigned*)(lds + MISC_OFF));
    (void)args;
#define WAVE_IDS() const int tid_ = fresh_tid(), lane = tid_ & 63, wave = __builtin_amdgcn_readfirstlane(tid_ >> 6), G = gridDim.x, wg = blockIdx.x, gw = wg * NWAVES + wave, ngw = G * NWAVES

    {
        WAVE_IDS();
        LAS float* scr = (LAS float*)(lds + wave * 16384);
        constexpr int I_ABIN = 16 * 48, I_ABOUT = 16 * 32, I_GLAIN = 16 * 96, I_GLAOUT = 16 * 32, I_UP = 16 * 176, I_DN = 44 * 32;
        constexpr int NITEMS = I_ABIN + I_ABOUT + I_GLAIN + I_GLAOUT + 2 * I_UP + 2 * I_DN;
        for (int it = gw; it < NITEMS; it += ngw) {
            int r = it;
            if (r < I_ABIN) { const int kb = r / 48, nb = r % 48; transpose_item(INF(3), NAB, D, WSB(WS_WABIN), kb * 64, 512 + nb * 32, 512 + nb * 32, scr, lane, INF(1)); continue; } r -= I_ABIN;
            if (r < I_ABOUT) { const int kb = r / 32, nb = r % 32; transpose_item(INF(9), D, D, WSB(WS_WABOUT), kb * 64, nb * 32, nb * 32, scr, lane); continue; } r -= I_ABOUT;
            if (r < I_GLAIN) { const int kb = r / 96, nb = r % 96; transpose_item(INF(10), GLA_SRC_N, D, WSB(WS_WGLAIN), kb * 64, nb * 32, nb * 32, scr, lane, INF(1) + D); continue; } r -= I_GLAIN;
            if (r < I_GLAOUT) { const int kb = r / 32, nb = r % 32; transpose_item(INF(14), D, D, WSB(WS_WGLAOUT), kb * 64, nb * 32, nb * 32, scr, lane); continue; } r -= I_GLAOUT;
            if (r < 2 * I_UP) { const int l = r / I_UP, q = r % I_UP, kb = q / 176, nb = q % 176, n0 = nb * 32, isv = n0 >= FFD, ch = isv ? n0 - FFD : n0;
                transpose_item(INF(15) + (size_t)l * D * NUP, NUP, D, WSB(WS_WUP) + (size_t)l * NUP * D, kb * 64, n0, (ch >> 7) * 256 + isv * 128 + (ch & 127), scr, lane, INF(2) + (size_t)l * D); continue; } r -= 2 * I_UP;
            { const int l = r / I_DN, q = r % I_DN, kb = q / 32, nb = q % 32;
                transpose_item(INF(18) + (size_t)l * FFD * D, D, FFD, WSB(WS_WDN) + (size_t)l * D * FFD, kb * 64, nb * 32, nb * 32, scr, lane); }
        }
        __syncthreads();
        for (int fb = wg; fb < 256; fb += G) {
            const int g = fb & 3, kb = fb >> 2; LAS float* PW = (LAS float*)lds; LAS float* WI = (LAS float*)(lds + 65536);
            const float* poolw = INF(4) + (size_t)g * 16384; const float* abin = INF(3) + (size_t)(16 * kb) * NAB + g * 128;
#pragma unroll
            for (int q = 0; q < 8; ++q) *(LAS f32x4*)(PW + 4 * (tid_ + NTHR * q)) = *(const f32x4*)(poolw + 4 * (tid_ + NTHR * q));
            *(LAS f32x4*)(WI + 4 * tid_) = *(const f32x4*)(abin + (size_t)(tid_ >> 5) * NAB + (tid_ & 31) * 4);
            __syncthreads();
            const int n = tid_ & 127, kq = tid_ >> 7; const LAS float* wi = WI + (4 * kq) * 128;
            float s0 = 0.f, s1 = 0.f, s2 = 0.f, s3 = 0.f;
#pragma unroll 16
            for (int c = 0; c < 128; ++c) { const float w = PW[c * 128 + n]; s0 += wi[c] * w; s1 += wi[128 + c] * w; s2 += wi[256 + c] * w; s3 += wi[384 + c] * w; }
            const int k0 = 16 * kb + 4 * kq; const f32x4 m0 = *(const f32x4*)(INF(1) + k0);
            *(v2u*)(WSB(WS_WABIN) + (size_t)(g * 128 + n) * D + k0) = (v2u){pk2(s0 * m0[0], s1 * m0[1]), pk2(s2 * m0[2], s3 * m0[3])};
            __syncthreads();
        }
        { const float* glain = INF(10); const float* wg2 = INF(11); const float* mn1 = INF(1) + D; bf16* W_GLAIN = WSB(WS_WGLAIN);
        for (int idx = wg * NTHR + tid_; idx < 256 * 512; idx += G * NTHR) {
            const int k4 = idx >> 9, n = idx & 511;
            const float* gi = glain + (size_t)(4 * k4) * GLA_SRC_N + 3072; const float* g2 = wg2 + n;
            float t0 = 0.f, t1 = 0.f, t2 = 0.f, t3 = 0.f;
#pragma unroll
            for (int r = 0; r < 16; ++r) { const float w = g2[r * 512]; t0 += gi[r] * w; t1 += gi[GLA_SRC_N + r] * w; t2 += gi[2 * GLA_SRC_N + r] * w; t3 += gi[3 * GLA_SRC_N + r] * w; }
            const f32x4 mg = *(const f32x4*)(mn1 + 4 * k4);
            *(v2u*)(W_GLAIN + (size_t)(3072 + n) * D + 4 * k4) = (v2u){pk2(t0 * mg[0], t1 * mg[1]), pk2(t2 * mg[2], t3 * mg[3])};
        } }
        convert_rows(INF(0), WSB(WS_XS), RSSP(4), gw, ngw, lane);
    }
    GRID_SYNC();

    for (int l = 0; l < 2; ++l) {
        { const int N = (l == 0) ? NAB : NGLA;
          pg8::Gemm g{WSB(WS_XS), (l == 0) ? WSB(WS_WABIN) : WSB(WS_WGLAIN), M, N, D}; pg8::StaticOrder S; S.init(M, N, gridDim.x, blockIdx.x);
          pg8::EpiBf16P E{WSB(WS_H), N, (l == 0) ? (const float*)RSSP(4) : (const float*)RSSP(1), (LAS float*)(lds + XCH_OFF)};
          if (PHM & 1) pg8::gemm_phase<pg8::EpiBf16P, pg8::StaticOrder, true, true>(lds, g, S, E); }
        GRID_SYNC();
        if (l == 0) {
            if (PHM & 2) ab_mixer(WSB(WS_H), WSB(WS_CAT), INF(5), INF(6), INF(7), INF(8), blockIdx.x, gridDim.x, fresh_tid());
        } else {
            if (PHM & 4) gla_prep(WSB(WS_H), WSB(WS_CAT), WSF(WS_DEC), INF(12), blockIdx.x, gridDim.x, fresh_tid());
            GRID_SYNC();
            if (PHM & 8) gla_scan(lds, WSB(WS_H), WSF(WS_DEC), WSB(WS_XN), blockIdx.x, gridDim.x, fresh_tid());
            GRID_SYNC();
            { WAVE_IDS(); if (PHM & 16) gla_post(WSB(WS_XN), WSB(WS_H), WSB(WS_CAT), INF(13), gw, ngw, lane); }
        }
        GRID_SYNC();
        { pg8::Gemm g{WSB(WS_CAT), (l == 0) ? WSB(WS_WABOUT) : WSB(WS_WGLAOUT), M, D, D}; pg8::StaticOrder S; S.init(M, D, gridDim.x, blockIdx.x);
          pg8::EpiRes E{(const float*)nullptr, WSB(WS_XS), D, RSSP(2 * l), (LAS float*)(lds + XCH_OFF)};
          if (PHM & 32) pg8::gemm_phase<pg8::EpiRes, pg8::StaticOrder, true, true>(lds, g, S, E); }
        GRID_SYNC();
        { pg8::Gemm g{WSB(WS_XS), WSB(WS_WUP) + (size_t)l * NUP * D, M, NUP, D}; pg8::StaticOrder S; S.init(M, NUP, gridDim.x, blockIdx.x);
          pg8::EpiFfnUp E{WSB(WS_H), INF(16) + (size_t)l * 3 * FFD, INF(17) + (size_t)l * FFD, WSF(WS_ULAST), WSF(WS_UFIRST), WSF(WS_VFIRST), (LAS f32x4*)(lds + XCH_OFF), RSSP(2 * l)};
          if (PHM & 64) pg8::gemm_phase<pg8::EpiFfnUp, pg8::StaticOrder, true, true, true>(lds, g, S, E); }
        GRID_SYNC();
        { pg8::Gemm g{WSB(WS_H), WSB(WS_WDN) + (size_t)l * D * FFD, M, D, FFD}; pg8::StaticOrder S; S.init(M, D, gridDim.x, blockIdx.x);
          if (PHM & 256) {
          const float* cw = INF(16) + (size_t)l * 3 * FFD; const float* cb = INF(17) + (size_t)l * FFD;
          const float* ULAST = WSF(WS_ULAST); const float* UFIRST = WSF(WS_UFIRST); const float* VFIRST = WSF(WS_VFIRST); bf16* ACT = WSB(WS_H);
          pg8::Unit u;
          for (int i = 0; S.next(i, u); ++i) {
              if ((u.pm & 15) == 0) continue;
              for (int c4 = fresh_tid(); c4 < FFD / 4; c4 += NTHR) {
                  const int ch = 4 * c4;
                  const f32x4 uf0 = *(const f32x4*)(UFIRST + (size_t)(u.pm * 2) * FFD + ch), uf1 = *(const f32x4*)(UFIRST + (size_t)(u.pm * 2 + 1) * FFD + ch);
                  const f32x4 ul0 = *(const f32x4*)(ULAST + (size_t)((u.pm - 1) * 2) * FFD + ch), ul1 = *(const f32x4*)(ULAST + (size_t)((u.pm - 1) * 2 + 1) * FFD + ch);
                  const f32x4 vf0 = *(const f32x4*)(VFIRST + (size_t)(u.pm * 2) * FFD + ch), vf1 = *(const f32x4*)(VFIRST + (size_t)(u.pm * 2 + 1) * FFD + ch);
                  const f32x4 a0 = *(const f32x4*)(cw + ch), a1 = *(const f32x4*)(cw + FFD + ch), a2 = *(const f32x4*)(cw + 2 * FFD + ch), bb = *(const f32x4*)(cb + ch);
                  const f32x4 u0 = bb + a0 * ul0 + a1 * ul1 + a2 * uf0, u1 = bb + a0 * ul1 + a1 * uf0 + a2 * uf1;
                  const f32x2 g00 = pg8::gelu_pk((f32x2){u0[0], u0[1]}), g01 = pg8::gelu_pk((f32x2){u0[2], u0[3]}), g10 = pg8::gelu_pk((f32x2){u1[0], u1[1]}), g11 = pg8::gelu_pk((f32x2){u1[2], u1[3]});
                  *(v2u*)(ACT + (size_t)(u.pm * 256) * FFD + ch) = (v2u){pk2(g00.x * vf0[0], g00.y * vf0[1]), pk2(g01.x * vf0[2], g01.y * vf0[3])};
                  *(v2u*)(ACT + (size_t)(u.pm * 256 + 1) * FFD + ch) = (v2u){pk2(g10.x * vf1[0], g10.y * vf1[1]), pk2(g11.x * vf1[2], g11.y * vf1[3])};
              }
          }
          asm volatile("s_waitcnt vmcnt(0)" ::: "memory"); __syncthreads();
          }
          if (l == 0 || gridDim.x != 256) { pg8::EpiRes E{(const float*)nullptr, WSB(WS_XS), D, RSSP(2 * l + 1), (LAS float*)(lds + XCH_OFF)};
              pg8::gemm_phase<pg8::EpiRes, pg8::StaticOrder, true, true>(lds, g, S, E); }
          else { pg8::EpiResFinal E{WSB(WS_XS), XOUT(), D, RSSP(3), INF(19), (unsigned*)(GAS unsigned*)(karg(21) + 16384), (LAS float*)(lds + XCH_OFF)};
              pg8::gemm_phase<pg8::EpiResFinal, pg8::StaticOrder, true, true>(lds, g, S, E); } }
        if (l == 0) GRID_SYNC();
    }
    if (gridDim.x != 256) { GRID_SYNC(); WAVE_IDS(); final_norm_rows(WSB(WS_XS), XOUT(), INF(19), RSSP(3), gw, ngw, lane); }
}

extern "C" void kernel_launch(void* const* d_in, const int* in_sizes, int n_in, void* d_out, int out_size, void* d_ws, size_t ws_size, hipStream_t stream) {
    static int grid_blocks = 0;
    if (grid_blocks == 0) {
        if (n_in != 20 || out_size != M * D || ws_size < WS_END) { fprintf(stderr, "kernel_launch: unexpected shapes (n_in %d out %d ws %zu)\n", n_in, out_size, ws_size); grid_blocks = -1; return; }
        int dev = 0, cus = 0, per_cu = 0;
        hipGetDevice(&dev); hipDeviceGetAttribute(&cus, hipDeviceAttributeMultiprocessorCount, dev);
        if (hipFuncSetAttribute((const void*)fwd_megakernel, hipFuncAttributeMaxDynamicSharedMemorySize, LDS_BYTES) != hipSuccess) fprintf(stderr, "kernel_launch: hipFuncSetAttribute failed\n");
        if (hipOccupancyMaxActiveBlocksPerMultiprocessor(&per_cu, (const void*)fwd_megakernel, NTHR, LDS_BYTES) != hipSuccess || per_cu < 1) { fprintf(stderr, "kernel_launch: occupancy query says %d\n", per_cu); per_cu = 1; }
        (void)hipGetLastError();
        grid_blocks = cus * per_cu;
    }
    if (grid_blocks < 0) return;
    if (hipMemsetAsync(d_ws, 0, 65536, stream) != hipSuccess) { fprintf(stderr, "kernel_launch: memset failed\n"); return; }
    Args a{};
    for (int i = 0; i < 20; ++i) a.in[i] = (const float*)d_in[i];
    a.out = (float*)d_out; a.ws = (unsigned char*)d_ws;
    void* kargs[] = {&a};
    hipError_t e = hipLaunchCooperativeKernel((const void*)fwd_megakernel, dim3(grid_blocks), dim3(NTHR), kargs, LDS_BYTES, stream);
    if (e != hipSuccess) fprintf(stderr, "cooperative launch failed: %s (grid %d)\n", hipGetErrorString(e), grid_blocks);
}
```

```cpp
#include <hip/hip_runtime.h>
#include <hip/hip_cooperative_groups.h>
#include <cstdio>
#include <cstdint>
namespace cg = cooperative_groups;
__device__ __forceinline__ int fresh_tid() { int t = threadIdx.x; asm volatile("" : "+v"(t)); return t; }
namespace pg8 {
#define PG8_LAS __attribute__((address_space(3)))
typedef unsigned short bf16_t;
typedef short bf16x8 __attribute__((ext_vector_type(8)));
typedef float f32x4 __attribute__((ext_vector_type(4)));
typedef unsigned u32x4 __attribute__((ext_vector_type(4)));
constexpr int BM = 256, BK = 64, HALF = 128, HTB = HALF * BK * 2  , STAGE_BYTES = 8 * HTB, NXCD = 8, WGM = 8;

__host__ __device__ __forceinline__ int lds_byte(int r, int c) { const int st = (r >> 4) * 2 + (c >> 5), rr = r & 15, cc = c & 31, ob = rr * 64 + cc * 2; return st * 1024 + (ob ^ (((ob >> 9) & 1) << 5)); }
__host__ __device__ __forceinline__ void stage_rc(int b, int& R, int& C) { const int st = b / 1024, sb = b % 1024, swz = sb ^ (((sb >> 9) & 1) << 5); R = (st >> 1) * 16 + swz / 64; C = (st & 1) * 32 + (swz % 64) / 2; }
__host__ __device__ __forceinline__ int perm32(int rho) { const int n = rho >> 4, i = rho & 15; return 8 * (i >> 2) + 4 * n + (i & 3); }

struct Unit { int pm, pn; };
struct Gemm { const bf16_t* A; const bf16_t* Bt; int M, N, K; };

struct StaticOrder {
    int nM, nN, nwg, G, c;
    __host__ __device__ void init(int M, int N, int G_, int c_) { nM = M / BM; nN = N / BM; nwg = nM * nN; G = G_; c = c_; }
    __host__ __device__ bool next(int i, Unit& u) const {
        const long L = (long)i * G + c; if (L >= nwg) return false;
        int wgid = (int)L; { const int q = nwg / NXCD, r = nwg % NXCD, xcd = wgid % NXCD, off = wgid / NXCD; wgid = (xcd < r ? xcd * (q + 1) : r * (q + 1) + (xcd - r) * q) + off; }
        const int nig = WGM * nN, gid = wgid / nig, fm = gid * WGM, gsz = (nM - fm) < WGM ? (nM - fm) : WGM;
        u.pm = fm + ((wgid % nig) % gsz); u.pn = (wgid % nig) / gsz; return true;
    }
    __device__ __forceinline__ void a_ready(const Unit&) const {}
    __device__ __forceinline__ void done(const Unit&) const {}
};

typedef float f32x2c_t __attribute__((ext_vector_type(2))); typedef __bf16 bf16x2c_t __attribute__((ext_vector_type(2)));
__device__ __forceinline__ unsigned cvt_pk_bf16(float lo, float hi) { const f32x2c_t v = {lo, hi}; const bf16x2c_t b = __builtin_convertvector(v, bf16x2c_t); return __builtin_bit_cast(unsigned, b); }
typedef float f32x2 __attribute__((ext_vector_type(2)));
__device__ __forceinline__ f32x2 gelu_pk(f32x2 v) {
    const f32x2 av = __builtin_elementwise_abs(v), d = av * 0.2316418882f + 1.0f;
    f32x2 t; t.x = __builtin_amdgcn_rcpf(d.x); t.y = __builtin_amdgcn_rcpf(d.y);
    f32x2 q = t * 0.5307027145f + (-0.7265760135f); q = q * t + 0.7107068705f; q = q * t + (-0.142248368f); q = q * t + 0.127414796f; q = q * t;
    const f32x2 s = (v * v) * (-0.72134752044f);
    f32x2 e; e.x = __builtin_amdgcn_exp2f(s.x); e.y = __builtin_amdgcn_exp2f(s.y);
    const f32x2 m = av * (q * e);
    return __builtin_elementwise_max(v, (f32x2){0.f, 0.f}) - m;
}
}
namespace pg8 {
template <class Epi, class Sched, bool ALIGN_EPI = false, bool SP2 = false, bool APERM = false  >
__device__ __forceinline__ void gemm_phase(PG8_LAS unsigned char* lds, const Gemm g, const Sched& S, const Epi& E) {
    const int tid = fresh_tid(), wid = __builtin_amdgcn_readfirstlane(tid >> 6), lane = tid & 63, wr = wid >> 2, wc = wid & 3, fr = lane & 15, fq = lane >> 4;
    const int K = g.K, nt = K / BK;
    unsigned voffA[2], voffB[2];
#pragma unroll
    for (int i = 0; i < 2; ++i) { int R, C; stage_rc(tid * 16 + i * 8192, R, C); const int Rb = Epi::PERM ? ((R & ~31) + perm32(R & 31)) : R;
        const int Ra = APERM ? ((R & ~63) + 4 * (R & 15) + ((R >> 4) & 3)) : R;
        voffA[i] = (unsigned)(Ra * K + C) * 2u; voffB[i] = (unsigned)(Rb * K + C) * 2u; }
    const size_t kstep = (size_t)(BK * 2);
    const size_t hstep = (size_t)HALF * K * 2;
    const size_t tstep = 2 * hstep;
    const unsigned ldsw = (unsigned)wid * 1024u;
    const int aoff = lds_byte(wr * 64 + fr, fq * 8), boff = lds_byte(wc * 32 + fr, fq * 8);
#define PG8_SA(b, h) (((b) * 2 + (h)) * HTB)
#define PG8_SB(b, h) ((4 + (b) * 2 + (h)) * HTB)
#define PG8_STAGE(bufoff, gbase, voff) do { _Pragma("unroll") for (int _i = 0; _i < 2; ++_i) \
        __builtin_amdgcn_global_load_lds((const unsigned*)((const char*)(gbase) + (voff)[_i]), (PG8_LAS unsigned*)(lds + (bufoff) + ldsw + _i * 8192), 16, 0, 0); } while (0)
#define PG8_LDA(dst, b, h) do { _Pragma("unroll") for (int m = 0; m < 4; ++m) _Pragma("unroll") for (int k = 0; k < 2; ++k) dst[m][k] = *(const PG8_LAS bf16x8*)(lds + PG8_SA(b, h) + aoff + m * 2048 + k * 1024); } while (0)
#define PG8_LDB(dst, b, h) do { _Pragma("unroll") for (int n = 0; n < 2; ++n) _Pragma("unroll") for (int k = 0; k < 2; ++k) dst[n][k] = *(const PG8_LAS bf16x8*)(lds + PG8_SB(b, h) + boff + n * 2048 + k * 1024); } while (0)
#define PG8_MMA(ai, bj, At, Bt) do { __builtin_amdgcn_s_setprio(1); _Pragma("unroll") for (int m = 0; m < 4; ++m) _Pragma("unroll") for (int n = 0; n < 2; ++n) _Pragma("unroll") for (int k = 0; k < 2; ++k) \
        acc[ai][bj][m][n] = __builtin_amdgcn_mfma_f32_16x16x32_bf16(Bt[n][k], At[m][k], acc[ai][bj][m][n], 0, 0, 0); __builtin_amdgcn_s_setprio(0); } while (0)
#define PG8_WAIT_V(n) asm volatile("s_waitcnt vmcnt(" #n ")" ::: "memory")
#define PG8_WAIT_L(n) asm volatile("s_waitcnt lgkmcnt(" #n ")" ::: "memory")
#define PG8_BAR __builtin_amdgcn_s_barrier()
#define PG8_SCHED __builtin_amdgcn_sched_barrier(0)
    Unit cur, nxt; int ui = 0;
    if (!S.next(0, cur)) return;
    f32x4 acc[2][2][4][2];
#pragma unroll
    for (int a = 0; a < 2; ++a)
#pragma unroll
        for (int b = 0; b < 2; ++b)
#pragma unroll
            for (int m = 0; m < 4; ++m)
#pragma unroll
                for (int n = 0; n < 2; ++n) acc[a][b][m][n] = (f32x4){0.f, 0.f, 0.f, 0.f};
    bf16x8 At[4][2], B0[2][2], B1[2][2];
    const char* cA = (const char*)g.A + (size_t)cur.pm * tstep; const char* cB = (const char*)g.Bt + (size_t)cur.pn * tstep;
    S.a_ready(cur);
    if constexpr (SP2) {
        PG8_STAGE(PG8_SB(0, 0), cB, voffB); PG8_STAGE(PG8_SB(0, 1), cB + hstep, voffB); PG8_STAGE(PG8_SA(0, 0), cA, voffA); PG8_STAGE(PG8_SA(0, 1), cA + hstep, voffA);
        if (wr == 1) PG8_BAR;
        PG8_WAIT_V(2); PG8_BAR;
        PG8_STAGE(PG8_SB(1, 0), cB + kstep, voffB); PG8_STAGE(PG8_SA(1, 0), cA + kstep, voffA); PG8_STAGE(PG8_SB(1, 1), cB + hstep + kstep, voffB);
        PG8_WAIT_V(6); PG8_BAR;
    } else {
        PG8_STAGE(PG8_SB(0, 0), cB, voffB); PG8_STAGE(PG8_SA(0, 0), cA, voffA); PG8_STAGE(PG8_SB(0, 1), cB + hstep, voffB); PG8_STAGE(PG8_SA(0, 1), cA + hstep, voffA);
        if (wr == 1) PG8_BAR;
        PG8_WAIT_V(4); PG8_BAR;
        PG8_STAGE(PG8_SB(1, 0), cB + kstep, voffB); PG8_STAGE(PG8_SA(1, 0), cA + kstep, voffA); PG8_STAGE(PG8_SB(1, 1), cB + hstep + kstep, voffB);
        PG8_WAIT_V(6); PG8_BAR;
    }
    for (;;) {
        const bool has_next = S.next(ui + 1, nxt);
        const char* nA = has_next ? (const char*)g.A + (size_t)nxt.pm * tstep : cA; const char* nB = has_next ? (const char*)g.Bt + (size_t)nxt.pn * tstep : cB;
        for (int t = 0; t < nt; t += 2) {
            const bool last = (t == nt - 2);
            const char* a1 = cA + (size_t)(t + 1) * kstep;
            const char* a2 = last ? nA : cA + (size_t)(t + 2) * kstep; const char* b2 = last ? nB : cB + (size_t)(t + 2) * kstep;
            const char* a3 = a2 + kstep; const char* b3 = b2 + kstep;
            if (last && has_next) S.a_ready(nxt);
            if constexpr (SP2) {
            PG8_LDB(B0, 0, 0); PG8_LDB(B1, 0, 1); PG8_SCHED; PG8_LDA(At, 0, 0); PG8_STAGE(PG8_SA(1, 1), a1 + hstep, voffA);
            PG8_WAIT_V(8); PG8_WAIT_L(0); PG8_BAR; PG8_MMA(0, 0, At, B0); PG8_MMA(0, 1, At, B1); PG8_BAR; PG8_SCHED;
            PG8_LDA(At, 0, 1); PG8_STAGE(PG8_SB(0, 0), b2, voffB); PG8_STAGE(PG8_SB(0, 1), b2 + hstep, voffB); PG8_STAGE(PG8_SA(0, 0), a2, voffA);
            PG8_WAIT_V(8); PG8_WAIT_L(0); PG8_BAR; PG8_MMA(1, 0, At, B0); PG8_MMA(1, 1, At, B1); PG8_BAR; PG8_SCHED;
            PG8_LDB(B0, 1, 0); PG8_LDB(B1, 1, 1); PG8_SCHED; PG8_LDA(At, 1, 0); PG8_STAGE(PG8_SA(0, 1), a2 + hstep, voffA);
            PG8_WAIT_V(8); PG8_WAIT_L(0); PG8_BAR; PG8_MMA(0, 0, At, B0); PG8_MMA(0, 1, At, B1); PG8_BAR; PG8_SCHED;
            PG8_LDA(At, 1, 1); PG8_STAGE(PG8_SB(1, 0), b3, voffB); PG8_STAGE(PG8_SB(1, 1), b3 + hstep, voffB); PG8_STAGE(PG8_SA(1, 0), a3, voffA);
            PG8_WAIT_V(8); PG8_WAIT_L(0); PG8_BAR; PG8_MMA(1, 0, At, B0); PG8_MMA(1, 1, At, B1); PG8_BAR; PG8_SCHED;
            } else {
            PG8_LDB(B0, 0, 0); PG8_SCHED; PG8_LDA(At, 0, 0); PG8_STAGE(PG8_SA(1, 1), a1 + hstep, voffA);
            PG8_WAIT_L(8); PG8_BAR; PG8_WAIT_L(0); PG8_MMA(0, 0, At, B0); PG8_BAR; PG8_SCHED;
            PG8_LDB(B1, 0, 1); PG8_STAGE(PG8_SB(0, 0), b2, voffB);
            PG8_BAR; PG8_WAIT_L(0); PG8_MMA(0, 1, At, B1); PG8_BAR;
            PG8_LDA(At, 0, 1); PG8_STAGE(PG8_SA(0, 0), a2, voffA);
            PG8_BAR; PG8_WAIT_L(0); PG8_MMA(1, 0, At, B0); PG8_BAR; PG8_SCHED;
            PG8_STAGE(PG8_SB(0, 1), b2 + hstep, voffB);
            PG8_WAIT_V(6); PG8_BAR; PG8_MMA(1, 1, At, B1); PG8_BAR;
            PG8_LDB(B0, 1, 0); PG8_SCHED; PG8_LDA(At, 1, 0); PG8_STAGE(PG8_SA(0, 1), a2 + hstep, voffA);
            PG8_WAIT_L(8); PG8_BAR; PG8_WAIT_L(0); PG8_MMA(0, 0, At, B0); PG8_BAR; PG8_SCHED;
            PG8_LDB(B1, 1, 1); PG8_STAGE(PG8_SB(1, 0), b3, voffB);
            PG8_BAR; PG8_WAIT_L(0); PG8_MMA(0, 1, At, B1); PG8_BAR;
            PG8_LDA(At, 1, 1); PG8_STAGE(PG8_SA(1, 0), a3, voffA);
            PG8_BAR; PG8_WAIT_L(0); PG8_MMA(1, 0, At, B0); PG8_BAR; PG8_SCHED;
            PG8_STAGE(PG8_SB(1, 1), b3 + hstep, voffB);
            PG8_WAIT_V(6); PG8_BAR; PG8_MMA(1, 1, At, B1); PG8_BAR;
            }
        }
        if constexpr (ALIGN_EPI) { if (wr == 0) PG8_BAR; }
        if constexpr (!Epi::AFTER_DRAIN) { E(acc, cur, wr, wc, fr, fq); S.done(cur); }
        if (!has_next) break;
#pragma unroll
        for (int a = 0; a < 2; ++a)
#pragma unroll
            for (int b = 0; b < 2; ++b)
#pragma unroll
                for (int m = 0; m < 4; ++m)
#pragma unroll
                    for (int n = 0; n < 2; ++n) acc[a][b][m][n] = (f32x4){0.f, 0.f, 0.f, 0.f};
        cur = nxt; cA = nA; cB = nB; ++ui;
        if constexpr (ALIGN_EPI) { if (wr == 1) PG8_BAR; }
    }
    PG8_WAIT_V(0);
    if constexpr (!ALIGN_EPI) { if (wr == 0) PG8_BAR; }
    PG8_BAR;
    if constexpr (Epi::AFTER_DRAIN) { E.fused(acc, cur, wr, wc, fr, fq, lds, wid, lane); S.done(cur); }
#undef PG8_SA
#undef PG8_SB
#undef PG8_STAGE
#undef PG8_LDA
#undef PG8_LDB
#undef PG8_MMA
#undef PG8_WAIT_V
#undef PG8_WAIT_L
#undef PG8_BAR
#undef PG8_SCHED
}
}
namespace pg8 {
template <int CTRL> __device__ __forceinline__ float dppf(float v) { return __builtin_bit_cast(float, __builtin_amdgcn_update_dpp(0, __builtin_bit_cast(int, v), CTRL, 0xf, 0xf, false)); }

template <int CTRL> __device__ __forceinline__ float dppo(float old, float v) { return __builtin_bit_cast(float, __builtin_amdgcn_update_dpp(__builtin_bit_cast(int, old), __builtin_bit_cast(int, v), CTRL, 0xf, 0xf, false)); }
struct EpiBf16P {
    static constexpr bool PERM = true, AFTER_DRAIN = false;
    bf16_t* O; int ldc; const float* rss; PG8_LAS float* tab;
    __device__ __forceinline__ void operator()(const f32x4 (&acc)[2][2][4][2], const Unit& u, int wr, int wc, int fr, int fq) const {
        const int row0 = u.pm * BM + wr * 64 + fr, col0 = u.pn * BM + wc * 32 + 8 * fq;
        if (wr == 0) { const int trow = wc * 64 + fq * 16 + fr, r_ = u.pm * BM + trow;
            tab[trow] = __builtin_amdgcn_rsqf(((rss[r_] + rss[32768 + r_]) + (rss[65536 + r_] + rss[98304 + r_])) * (1.f / 1024.f) + 1e-6f); }
        asm volatile("s_waitcnt lgkmcnt(0)" ::: "memory"); __builtin_amdgcn_s_barrier(); asm volatile("" ::: "memory");
#pragma unroll
        for (int ai = 0; ai < 2; ++ai)
#pragma unroll
            for (int m = 0; m < 4; ++m) { const int row = row0 + ai * HALF + m * 16; bf16_t* rowp = O + (size_t)row * ldc + col0;
                const float rs = tab[wr * 64 + fr + ai * HALF + m * 16];
#pragma unroll
                for (int bj = 0; bj < 2; ++bj) { const f32x4 v0 = acc[ai][bj][m][0] * rs, v1 = acc[ai][bj][m][1] * rs;
                    u32x4 w; w.x = cvt_pk_bf16(v0[0], v0[1]); w.y = cvt_pk_bf16(v0[2], v0[3]); w.z = cvt_pk_bf16(v1[0], v1[1]); w.w = cvt_pk_bf16(v1[2], v1[3]);
                    *(u32x4*)(rowp + bj * HALF) = w; } }
    }
};
struct EpiRes {
    static constexpr bool PERM = true, AFTER_DRAIN = false;
    const float* base32; bf16_t* xs; int ldc; float* rssp; PG8_LAS float* red;
    __device__ __forceinline__ void operator()(const f32x4 (&acc)[2][2][4][2], const Unit& u, int wr, int wc, int fr, int fq) const {
        const int col0 = u.pn * BM + wc * 32 + 8 * fq;
        const size_t off0 = (size_t)(u.pm * BM + wr * 64 + fr) * ldc + col0;
#pragma unroll
        for (int ai = 0; ai < 2; ++ai) {
            u32x4 bv[4][2];
#pragma unroll
            for (int m = 0; m < 4; ++m)
#pragma unroll
                for (int bj = 0; bj < 2; ++bj) bv[m][bj] = *(const u32x4*)(xs + off0 + (size_t)(ai * HALF + m * 16) * ldc + bj * HALF);
#pragma unroll
            for (int m = 0; m < 4; ++m) { float ss = 0.f;
#pragma unroll
                for (int bj = 0; bj < 2; ++bj) { const size_t off = off0 + (size_t)(ai * HALF + m * 16) * ldc + bj * HALF; const u32x4 b = bv[m][bj];
                    f32x4 o0 = (f32x4){__builtin_bit_cast(float, b.x << 16), __builtin_bit_cast(float, b.x & 0xffff0000u), __builtin_bit_cast(float, b.y << 16), __builtin_bit_cast(float, b.y & 0xffff0000u)};
                    f32x4 o1 = (f32x4){__builtin_bit_cast(float, b.z << 16), __builtin_bit_cast(float, b.z & 0xffff0000u), __builtin_bit_cast(float, b.w << 16), __builtin_bit_cast(float, b.w & 0xffff0000u)};
                    o0 = o0 + acc[ai][bj][m][0]; o1 = o1 + acc[ai][bj][m][1];
                    ss += ((o0[0] * o0[0] + o0[1] * o0[1]) + (o0[2] * o0[2] + o0[3] * o0[3])) + ((o1[0] * o1[0] + o1[1] * o1[1]) + (o1[2] * o1[2] + o1[3] * o1[3]));
                    u32x4 w; w.x = cvt_pk_bf16(o0[0], o0[1]); w.y = cvt_pk_bf16(o0[2], o0[3]); w.z = cvt_pk_bf16(o1[0], o1[1]); w.w = cvt_pk_bf16(o1[2], o1[3]); *(u32x4*)(xs + off) = w; }
                ss += __shfl_xor(ss, 16); ss += __shfl_xor(ss, 32);
                if (fq == 0) red[wc * 256 + ai * HALF + wr * 64 + m * 16 + fr] = ss; }
            asm volatile("" ::: "memory"); }
        asm volatile("s_waitcnt lgkmcnt(0)" ::: "memory"); __builtin_amdgcn_s_barrier(); asm volatile("" ::: "memory");
        if (wr == 0) { const int row = wc * 64 + fq * 16 + fr;
            rssp[(size_t)u.pn * 32768 + u.pm * BM + row] = (red[row] + red[256 + row]) + (red[512 + row] + red[768 + row]); }
    }
};
struct EpiResFinal {
    static constexpr bool PERM = true, AFTER_DRAIN = false;
    const bf16_t* xs; float* out; int ldc; float* rssp; const float* g; unsigned* cnt; PG8_LAS float* red;
    __device__ __forceinline__ void operator()(const f32x4 (&acc_)[2][2][4][2], const Unit& u, int wr, int wc, int fr, int fq) const {
        f32x4 (&acc)[2][2][4][2] = const_cast<f32x4 (&)[2][2][4][2]>(acc_);
        const int col0 = u.pn * BM + wc * 32 + 8 * fq;
        const size_t off0 = (size_t)(u.pm * BM + wr * 64 + fr) * ldc + col0;
#pragma unroll
        for (int ai = 0; ai < 2; ++ai) {
          u32x4 bv[4][2];
#pragma unroll
          for (int m = 0; m < 4; ++m)
#pragma unroll
              for (int bj = 0; bj < 2; ++bj) bv[m][bj] = *(const u32x4*)(xs + off0 + (size_t)(ai * HALF + m * 16) * ldc + bj * HALF);
#pragma unroll
            for (int m = 0; m < 4; ++m) { float ss = 0.f;
#pragma unroll
                for (int bj = 0; bj < 2; ++bj) {
                    const u32x4 b = bv[m][bj];
                    const f32x4 o0 = (f32x4){__builtin_bit_cast(float, b.x << 16), __builtin_bit_cast(float, b.x & 0xffff0000u), __builtin_bit_cast(float, b.y << 16), __builtin_bit_cast(float, b.y & 0xffff0000u)} + acc[ai][bj][m][0];
                    const f32x4 o1 = (f32x4){__builtin_bit_cast(float, b.z << 16), __builtin_bit_cast(float, b.z & 0xffff0000u), __builtin_bit_cast(float, b.w << 16), __builtin_bit_cast(float, b.w & 0xffff0000u)} + acc[ai][bj][m][1];
                    ss += ((o0[0] * o0[0] + o0[1] * o0[1]) + (o0[2] * o0[2] + o0[3] * o0[3])) + ((o1[0] * o1[0] + o1[1] * o1[1]) + (o1[2] * o1[2] + o1[3] * o1[3]));
                    acc[ai][bj][m][0] = o0; acc[ai][bj][m][1] = o1; }
                ss += __shfl_xor(ss, 16); ss += __shfl_xor(ss, 32);
                if (fq == 0) red[wc * 256 + ai * HALF + wr * 64 + m * 16 + fr] = ss;
                asm volatile("" ::: "memory"); } }
        asm volatile("s_waitcnt lgkmcnt(0)" ::: "memory"); __builtin_amdgcn_s_barrier(); asm volatile("" ::: "memory");
        const int trow = wc * 64 + fq * 16 + fr;
        float* slot = rssp + (size_t)u.pm * BM + trow;
        if (wr == 0) __hip_atomic_store(slot + (size_t)u.pn * 32768, (red[trow] + red[256 + trow]) + (red[512 + trow] + red[768 + trow]), __ATOMIC_RELAXED, __HIP_MEMORY_SCOPE_AGENT);
        asm volatile("s_waitcnt vmcnt(0)" ::: "memory"); __builtin_amdgcn_s_barrier(); asm volatile("" ::: "memory");
        if (wr == 0 && wc == 0 && fq == 0 && fr == 0) {
            unsigned* c = cnt + 64 * u.pm; __hip_atomic_fetch_add(c, 1u, __ATOMIC_RELAXED, __HIP_MEMORY_SCOPE_AGENT);
            unsigned spins = 0; while (__hip_atomic_load(c, __ATOMIC_RELAXED, __HIP_MEMORY_SCOPE_AGENT) < 4u && ++spins < (1u << 22)) __builtin_amdgcn_s_sleep(1);
        }
        asm volatile("s_waitcnt vmcnt(0)" ::: "memory"); __builtin_amdgcn_s_barrier(); asm volatile("" ::: "memory");
        if (wr == 0) { const float t = (__hip_atomic_load(slot, __ATOMIC_RELAXED, __HIP_MEMORY_SCOPE_AGENT) + __hip_atomic_load(slot + 32768, __ATOMIC_RELAXED, __HIP_MEMORY_SCOPE_AGENT))
                                     + (__hip_atomic_load(slot + 65536, __ATOMIC_RELAXED, __HIP_MEMORY_SCOPE_AGENT) + __hip_atomic_load(slot + 98304, __ATOMIC_RELAXED, __HIP_MEMORY_SCOPE_AGENT));
            red[1024 + trow] = __builtin_amdgcn_rsqf(t * (1.f / 1024.f) + 1e-6f); }
        asm volatile("s_waitcnt lgkmcnt(0)" ::: "memory"); __builtin_amdgcn_s_barrier(); asm volatile("" ::: "memory");
#pragma unroll
        for (int bj = 0; bj < 2; ++bj) { const f32x4 g0 = *(const f32x4*)(g + col0 + bj * HALF), g1 = *(const f32x4*)(g + col0 + bj * HALF + 4);
#pragma unroll
            for (int ai = 0; ai < 2; ++ai)
#pragma unroll
                for (int m = 0; m < 4; ++m) { const float rs = red[1024 + ai * HALF + wr * 64 + m * 16 + fr]; const size_t off = off0 + (size_t)(ai * HALF + m * 16) * ldc + bj * HALF;
                    *(f32x4*)(out + off) = acc[ai][bj][m][0] * rs * g0; *(f32x4*)(out + off + 4) = acc[ai][bj][m][1] * rs * g1; } }
    }
};
struct EpiFfnUp {
    static constexpr bool PERM = true, AFTER_DRAIN = false;
    static constexpr int FFD = 2816;
    bf16_t* act; const float* cw; const float* cb; float* ulast; float* ufirst; float* vfirst; PG8_LAS f32x4* xch; const float* rss;
    __device__ __forceinline__ void operator()(const f32x4 (&acc)[2][2][4][2], const Unit& u, int wr, int wc, int fr, int fq) const {
        const int ch0 = u.pn * 128 + wc * 32 + 8 * fq;
        f32x4 w0[2], w1[2], w2[2], bb[2];
#pragma unroll
        for (int n = 0; n < 2; ++n) { w0[n] = *(const f32x4*)(cw + ch0 + 4 * n); w1[n] = *(const f32x4*)(cw + FFD + ch0 + 4 * n); w2[n] = *(const f32x4*)(cw + 2 * FFD + ch0 + 4 * n); bb[n] = *(const f32x4*)(cb + ch0 + 4 * n); }
        PG8_LAS float* tab = (PG8_LAS float*)(xch + 256);
#define RSTD4(r_) __builtin_amdgcn_rsqf(((rss[(r_)] + rss[32768 + (r_)]) + (rss[65536 + (r_)] + rss[98304 + (r_)])) * (1.f / 1024.f) + 1e-6f)
        if (wr == 0) { const int trow = wc * 64 + fq * 16 + fr; tab[trow] = RSTD4(u.pm * BM + trow); }
        const int rl = wr * 64 + 4 * fr;
        if (fr == 15) {
#pragma unroll
            for (int ai = 0; ai < 2; ++ai)
#pragma unroll
                for (int q = 0; q < 2; ++q) { PG8_LAS f32x4* s = xch + (((((ai * 2 + wr) * 4 + wc) * 4 + fq) * 2 + q) * 2); s[0] = acc[ai][0][2 + q][0]; s[1] = acc[ai][0][2 + q][1]; }
        }
        asm volatile("s_waitcnt lgkmcnt(0)" ::: "memory"); __builtin_amdgcn_s_barrier(); asm volatile("" ::: "memory");
        if (fr == 15 && wr == 1) {
#pragma unroll
            for (int q = 0; q < 2; ++q) { const float r3 = tab[rl + HALF + 2 + q]; float* g = ulast + (size_t)(u.pm * 2 + q) * FFD + ch0; *(f32x4*)g = acc[1][0][2 + q][0] * r3; *(f32x4*)(g + 4) = acc[1][0][2 + q][1] * r3; } }
        if (fr == 0 && wr == 0) {
#pragma unroll
            for (int q = 0; q < 2; ++q) { const float r0 = tab[q]; float* g = ufirst + (size_t)(u.pm * 2 + q) * FFD + ch0; *(f32x4*)g = acc[0][0][q][0] * r0; *(f32x4*)(g + 4) = acc[0][0][q][1] * r0;
                float* h = vfirst + (size_t)(u.pm * 2 + q) * FFD + ch0; *(f32x4*)h = acc[0][1][q][0] * r0; *(f32x4*)(h + 4) = acc[0][1][q][1] * r0; } }
#pragma unroll
        for (int ai = 0; ai < 2; ++ai) {
            f32x4 h2[2] = {(f32x4){0.f, 0.f, 0.f, 0.f}, (f32x4){0.f, 0.f, 0.f, 0.f}}, h3[2] = {h2[0], h2[0]};
            if (wr == 1 || ai == 1) { const int sai = (wr == 1) ? ai : 0, swr = (wr == 1) ? 0 : 1;
                const PG8_LAS f32x4* s = xch + ((((sai * 2 + swr) * 4 + wc) * 4 + fq) * 2) * 2; const float ra = tab[sai * HALF + swr * 64 + 62], rb = tab[sai * HALF + swr * 64 + 63];
                h2[0] = s[0] * ra; h2[1] = s[1] * ra; h3[0] = s[2] * rb; h3[1] = s[3] * rb; }
            const f32x4 rs4 = *(const PG8_LAS f32x4*)(tab + rl + ai * HALF);
            f32x4 us[4][2];
#pragma unroll
            for (int m = 0; m < 4; ++m) { us[m][0] = acc[ai][0][m][0] * rs4[m]; us[m][1] = acc[ai][0][m][1] * rs4[m]; }
            f32x4 s2[2], s3[2];
#pragma unroll
            for (int n = 0; n < 2; ++n)
#pragma unroll
                for (int e = 0; e < 4; ++e) { s2[n][e] = dppo<0x111>(h2[n][e], us[2][n][e]); s3[n][e] = dppo<0x111>(h3[n][e], us[3][n][e]); }
#pragma unroll
            for (int m = 0; m < 4; ++m) {
                f32x4 uc[2];
#pragma unroll
                for (int n = 0; n < 2; ++n) { const f32x4 um1 = (m == 0) ? s3[n] : us[m - 1][n], um2 = (m == 0) ? s2[n] : (m == 1) ? s3[n] : us[m - 2][n];
                    uc[n] = bb[n] + w0[n] * um2 + w1[n] * um1 + w2[n] * us[m][n]; }
                const f32x4 v0 = acc[ai][1][m][0] * rs4[m], v1 = acc[ai][1][m][1] * rs4[m];
                const f32x2 a = gelu_pk((f32x2){uc[0][0], uc[0][1]}), b = gelu_pk((f32x2){uc[0][2], uc[0][3]}), c = gelu_pk((f32x2){uc[1][0], uc[1][1]}), d = gelu_pk((f32x2){uc[1][2], uc[1][3]});
                u32x4 w; w.x = cvt_pk_bf16(a.x * v0[0], a.y * v0[1]); w.y = cvt_pk_bf16(b.x * v0[2], b.y * v0[3]); w.z = cvt_pk_bf16(c.x * v1[0], c.y * v1[1]); w.w = cvt_pk_bf16(d.x * v1[2], d.y * v1[3]);
                *(u32x4*)(act + (size_t)(u.pm * BM + ai * HALF + rl + m) * FFD + ch0) = w;
            }
        }
    }
};
}
#define LAS __attribute__((address_space(3)))
typedef unsigned short bf16;
typedef unsigned v4u __attribute__((ext_vector_type(4)));
typedef unsigned v2u __attribute__((ext_vector_type(2)));
typedef float f32x4 __attribute__((ext_vector_type(4)));
typedef float f32x2 __attribute__((ext_vector_type(2)));
typedef short bf16x8 __attribute__((ext_vector_type(8)));
constexpr int NWAVES = 8, NTHR = 512;
constexpr int BATCH = 8, SEQ = 4096, D = 1024, M = BATCH * SEQ, FFD = 2816, NUP = 2 * FFD, NAB = 2048, NGLA = 3584, GLA_SRC_N = 3088;
constexpr float EPS = 1e-6f;
constexpr size_t MiB = 1u << 20;
constexpr size_t WS_DEC = 1 * MiB, WS_ULAST = 2 * MiB, WS_UFIRST = 5 * MiB, WS_VFIRST = 8 * MiB;
constexpr size_t WS_WABIN = 12 * MiB, WS_WABOUT = 16 * MiB, WS_WGLAIN = 18 * MiB, WS_WGLAOUT = 25 * MiB, WS_WUP = 27 * MiB  , WS_WDN = 49 * MiB  ;
constexpr size_t WS_XN = 64 * MiB, WS_CAT = 128 * MiB, WS_H = 192 * MiB, WS_XS = 416 * MiB  , WS_END = 480 * MiB;
constexpr int LDS_BYTES = 147456, XCH_OFF = 131072;
#ifndef PHM
#define PHM 0xffff
#endif

__device__ __forceinline__ float bflo(unsigned w) { return __builtin_bit_cast(float, w << 16); }
__device__ __forceinline__ float bfhi(unsigned w) { return __builtin_bit_cast(float, w & 0xffff0000u); }
__device__ __forceinline__ unsigned pk2(float lo, float hi) { return pg8::cvt_pk_bf16(lo, hi); }
__device__ __forceinline__ float wave_sum(float v) {
#pragma unroll
    for (int o = 1; o < 64; o <<= 1) v += __shfl_xor(v, o);
    return v;
}
#define LDS_WAIT() asm volatile("s_waitcnt lgkmcnt(0)" ::: "memory")

__device__ __forceinline__ void transpose_item(const float* W, int ldw, int K, bf16* WT, int k0, int n0, int trow0, LAS float* scr, int lane, const float* g = nullptr) {
    float tv[32];
#pragma unroll
    for (int i = 0; i < 32; ++i) { const int kk = 2 * i + (lane >> 5); tv[i] = __builtin_nontemporal_load(W + (size_t)(k0 + kk) * ldw + n0 + (lane & 31)); }
#pragma unroll
    for (int i = 0; i < 32; ++i) { const int kk = 2 * i + (lane >> 5); scr[kk * 33 + (lane & 31)] = tv[i] * (g ? g[k0 + kk] : 1.f); }
    LDS_WAIT(); asm volatile("" ::: "memory");
    const int c = lane & 7;
#pragma unroll
    for (int j = 0; j < 4; ++j) { const int n = (lane >> 3) + 8 * j; const LAS float* s = scr + (8 * c) * 33 + n;
        v4u o; o.x = pk2(s[0 * 33], s[1 * 33]); o.y = pk2(s[2 * 33], s[3 * 33]); o.z = pk2(s[4 * 33], s[5 * 33]); o.w = pk2(s[6 * 33], s[7 * 33]);
        *(v4u*)(WT + (size_t)(trow0 + n) * K + k0 + 8 * c) = o; }
    LDS_WAIT(); asm volatile("" ::: "memory");
}

struct Args { const float* in[20]; float* out; unsigned char* ws; };

__device__ __forceinline__ void convert_rows(const float* X, bf16* XS, float* rss, int gw, int ngw, int lane) {
#pragma unroll 2
    for (int m = gw; m < M; m += ngw) {
        const f32x4* xr = (const f32x4*)(X + (size_t)m * D) + lane;
        f32x4 v[4]; float s = 0.f;
#pragma unroll
        for (int j = 0; j < 4; ++j) { v[j] = __builtin_nontemporal_load(xr + 64 * j); s += (v[j].x * v[j].x + v[j].y * v[j].y) + (v[j].z * v[j].z + v[j].w * v[j].w); }
        s = wave_sum(s);
        unsigned long long* o8 = (unsigned long long*)(XS + (size_t)m * D) + lane;
#pragma unroll
        for (int j = 0; j < 4; ++j) o8[64 * j] = (unsigned long long)pk2(v[j].x, v[j].y) | ((unsigned long long)pk2(v[j].z, v[j].w) << 32);
        if (lane < 4) rss[(size_t)lane * 32768 + m] = lane == 0 ? s : 0.f;
    }
}
__device__ __forceinline__ void final_norm_rows(const bf16* XS, float* OUT, const float* g, const float* rss, int gw, int ngw, int lane) {
    f32x4 gv[4];
#pragma unroll
    for (int j = 0; j < 4; ++j) gv[j] = ((const f32x4*)g)[lane + 64 * j];
#pragma unroll 4
    for (int m = gw; m < M; m += ngw) {
        const v2u* xr = (const v2u*)(XS + (size_t)m * D) + lane; f32x4* orow = (f32x4*)(OUT + (size_t)m * D) + lane;
        const float rstd = rsqrtf(((rss[m] + rss[32768 + m]) + (rss[65536 + m] + rss[98304 + m])) * (1.f / D) + EPS);
#pragma unroll
        for (int j = 0; j < 4; ++j) { const v2u w = xr[64 * j]; orow[64 * j] = (f32x4){bflo(w.x), bfhi(w.x), bflo(w.y), bfhi(w.y)} * rstd * gv[j]; }
    }
}

__device__ __forceinline__ void unpack8(const v4u w, float (&f)[8]) {
    f[0] = bflo(w.x); f[1] = bfhi(w.x); f[2] = bflo(w.y); f[3] = bfhi(w.y); f[4] = bflo(w.z); f[5] = bfhi(w.z); f[6] = bflo(w.w); f[7] = bfhi(w.w);
}
__device__ __forceinline__ void ab_mixer(const bf16* H, bf16* CAT, const float* pool_b, const float* pool_scale, const float* scw, const float* scb, int wg, int nwg, int tid) {
    const int cv = tid & 127, sub = tid >> 7;
    float pa[8], pb[8], pc[8], pd[8];
    if (cv < 64) {
#pragma unroll
        for (int e = 0; e < 8; ++e) { pa[e] = pool_b[cv * 8 + e]; pb[e] = pool_scale[cv * 8 + e]; pc[e] = 0.f; pd[e] = 0.f; }
    } else {
        const int c = (cv - 64) * 8;
#pragma unroll
        for (int e = 0; e < 8; ++e) { pa[e] = scw[c + e]; pb[e] = scw[512 + c + e]; pc[e] = scw[1024 + c + e]; pd[e] = scb[c + e]; }
    }
    for (int chunk = wg * 4 + sub; chunk < M / 32; chunk += nwg * 4) {
        const int r0 = chunk * 32, t0 = r0 & (SEQ - 1);
        bf16* outp = CAT + (size_t)r0 * D + cv * 8;
        if (cv < 64) {
            const int win = 2 << (cv >> 4);
            const bf16* p = H + (size_t)r0 * NAB + cv * 8;
            float s[8], f[8];
#pragma unroll
            for (int e = 0; e < 8; ++e) s[e] = 0.f;
            if (t0 > 0) for (int i = 1; i < win; ++i) { unpack8(*(const v4u*)(p - (size_t)i * NAB), f);
#pragma unroll
                for (int e = 0; e < 8; ++e) s[e] += f[e]; }
#pragma unroll 4
            for (int jr = 0; jr < 32; ++jr) {
                const int t = t0 + jr; float cur[8], y[8];
                unpack8(*(const v4u*)(p + (size_t)jr * NAB), cur);
                if (jr >= 1 && t >= win) { unpack8(__builtin_nontemporal_load((const v4u*)(p + (ptrdiff_t)(jr - win) * NAB)), f);
#pragma unroll
                    for (int e = 0; e < 8; ++e) s[e] -= f[e]; }
#pragma unroll
                for (int e = 0; e < 8; ++e) s[e] += cur[e];
                const float inv = 1.f / (float)((t + 1) < win ? (t + 1) : win);
#pragma unroll
                for (int e = 0; e < 8; ++e) y[e] = (s[e] * inv - cur[e] + pa[e]) * pb[e];
                v4u o; o.x = pk2(y[0], y[1]); o.y = pk2(y[2], y[3]); o.z = pk2(y[4], y[5]); o.w = pk2(y[6], y[7]);
                *(v4u*)(outp + (size_t)jr * D) = o;
            }
        } else {
            const bf16* p = H + (size_t)r0 * NAB + (cv - 64) * 8;
            float p1[8], p2[8], a[8], b[8];
#pragma unroll
            for (int e = 0; e < 8; ++e) { p1[e] = 0.f; p2[e] = 0.f; }
            if (t0 > 0) { unpack8(*(const v4u*)(p - NAB + 1024), a); unpack8(*(const v4u*)(p - NAB + 1536), b);
#pragma unroll
                for (int e = 0; e < 8; ++e) p1[e] = a[e] * b[e];
                unpack8(*(const v4u*)(p - 2 * NAB + 1024), a); unpack8(*(const v4u*)(p - 2 * NAB + 1536), b);
#pragma unroll
                for (int e = 0; e < 8; ++e) p2[e] = a[e] * b[e]; }
#pragma unroll 4
            for (int jr = 0; jr < 32; ++jr) {
                float sb[8], y[8];
                unpack8(__builtin_nontemporal_load((const v4u*)(p + (size_t)jr * NAB + 512)), sb); unpack8(__builtin_nontemporal_load((const v4u*)(p + (size_t)jr * NAB + 1024)), a); unpack8(__builtin_nontemporal_load((const v4u*)(p + (size_t)jr * NAB + 1536)), b);
#pragma unroll
                for (int e = 0; e < 8; ++e) { const float pr = a[e] * b[e]; y[e] = sb[e] * (pd[e] + pc[e] * pr + pb[e] * p1[e] + pa[e] * p2[e]); p2[e] = p1[e]; p1[e] = pr; }
                v4u o; o.x = pk2(y[0], y[1]); o.y = pk2(y[2], y[3]); o.z = pk2(y[4], y[5]); o.w = pk2(y[6], y[7]);
                *(v4u*)(outp + (size_t)jr * D) = o;
            }
        }
    }
}

__device__ __forceinline__ float gate_log(float z) { return (fminf(z, 0.f) - __logf(1.f + __expf(-fabsf(z)))) * (1.f / 16.f); }
__device__ __forceinline__ void gla_prep(bf16* H, bf16* KDT, float* DEC, const float* b_g, int wg, int nwg, int tid) {
    const int half = tid >> 8, cp = tid & 255, c = 2 * cp;
    const float bg0 = b_g[c], bg1 = b_g[c + 1];
    const float QS = 0.08838834764831845f;
    for (int it = wg * 2 + half; it < BATCH * 64; it += nwg * 2) {
        bf16* base = H + (size_t)it * 64 * NGLA + c;
        unsigned cg[8], cq[8], ck[8], ng[8], nq[8], nk[8];
#pragma unroll
        for (int m = 0; m < 8; ++m) { const bf16* rp = base + (size_t)m * NGLA; cg[m] = __builtin_nontemporal_load((const unsigned*)(rp + 3072)); cq[m] = __builtin_nontemporal_load((const unsigned*)rp); ck[m] = __builtin_nontemporal_load((const unsigned*)(rp + 512)); }
        float c0 = 0.f, c1 = 0.f;
        for (int g = 0; g < 8; ++g) {
            bf16* gb = base + (size_t)(g * 8) * NGLA;
            if (g < 7) {
#pragma unroll
                for (int m = 0; m < 8; ++m) { const bf16* rp = gb + (size_t)(8 + m) * NGLA; ng[m] = __builtin_nontemporal_load((const unsigned*)(rp + 3072)); nq[m] = __builtin_nontemporal_load((const unsigned*)rp); nk[m] = __builtin_nontemporal_load((const unsigned*)(rp + 512)); }
            }
#pragma unroll
            for (int m = 0; m < 8; ++m) { bf16* rp = gb + (size_t)m * NGLA;
                c0 += gate_log(bflo(cg[m]) + bg0); c1 += gate_log(bfhi(cg[m]) + bg1);
                const float d0 = bflo(ck[m]) * __expf(-c0), d1 = bfhi(ck[m]) * __expf(-c1);
                *(unsigned*)rp = pk2(bflo(cq[m]) * QS * __expf(c0), bfhi(cq[m]) * QS * __expf(c1));
                *(unsigned*)(rp + 512) = pk2(d0, d1);
            }
#pragma unroll
            for (int m = 0; m < 8; ++m) { cg[m] = ng[m]; cq[m] = nq[m]; ck[m] = nk[m]; }
        }
        *(f32x2*)(DEC + (size_t)it * 512 + c) = (f32x2){__expf(c0), __expf(c1)};
    }
}

constexpr int QP = 136, VP = 40;
constexpr int L_Q = 0, L_K = L_Q + 64 * QP * 2, L_V = L_K + 64 * QP * 2, L_ST = L_V + 64 * VP * 2, L_SCAN_END = L_ST + 2 * 32 * QP * 2;
static_assert(L_SCAN_END <= XCH_OFF, "scan LDS");
typedef short v4i16_t __attribute__((ext_vector_type(4)));
__device__ __forceinline__ bf16x8 ldfrag(const LAS unsigned char* p) { return *(const LAS bf16x8*)p; }
__device__ __forceinline__ v4i16_t ldtr(const LAS unsigned char* img, int pitch, int row0, int col0, int l16) {
    return __builtin_amdgcn_ds_read_tr16_b64_v4i16((LAS v4i16_t*)(img + (row0 + (l16 >> 2)) * pitch + (col0 + 4 * (l16 & 3)) * 2)); }
__device__ __forceinline__ bf16x8 cat8(v4i16_t a, v4i16_t b) { return __builtin_shufflevector(a, b, 0, 1, 2, 3, 4, 5, 6, 7); }
__device__ __forceinline__ void gla_scan(LAS unsigned char* lds, const bf16* H, const float* DEC, bf16* O, int wg, int nwg, int tid) {
    const int wave = __builtin_amdgcn_readfirstlane(tid >> 6), lane = tid & 63, l16 = lane & 15, lq = lane >> 4;
    for (int item = wg; item < 256; item += nwg) {
        const int x = item & 7, j = item >> 3, bh = x * 4 + (j >> 3), vs = j & 7, b = bh >> 2, h = bh & 3;
        __syncthreads();
        for (int i = tid; i < 2 * 32 * QP / 2; i += NTHR) ((LAS unsigned*)(lds + L_ST))[i] = 0u;
        f32x4 S[2][2];
#pragma unroll
        for (int bq = 0; bq < 2; ++bq)
#pragma unroll
            for (int jv = 0; jv < 2; ++jv) S[bq][jv] = (f32x4){0.f, 0.f, 0.f, 0.f};
        const int hb = (wave & 3) * 2;
        const int r0 = tid >> 4, c16 = tid & 15, mv = (tid & 255) >> 2, c8v = tid & 3;
        const bf16* pq = H + ((size_t)b * SEQ + r0) * NGLA + h * 128 + c16 * 8;
        const bf16* pv = H + ((size_t)b * SEQ + mv) * NGLA + 1024 + h * 256 + vs * 32 + c8v * 8;
        const float* pdec = DEC + ((size_t)(b * 64)) * 512 + h * 128 + 16 * hb + 4 * lq;
        v4u rq0 = *(const v4u*)pq, rq1 = *(const v4u*)(pq + (size_t)32 * NGLA), rk0 = *(const v4u*)(pq + 512), rk1 = *(const v4u*)(pq + (size_t)32 * NGLA + 512);
        v4u rv = *(const v4u*)pv;
        f32x4 rdec0 = *(const f32x4*)pdec, rdec1 = *(const f32x4*)(pdec + 16);
        for (int n = 0; n < 64; ++n) {
            const size_t row0 = (size_t)b * SEQ + n * 64;
            *(LAS v4u*)(lds + L_Q + (r0 * QP + c16 * 8) * 2) = rq0; *(LAS v4u*)(lds + L_Q + ((r0 + 32) * QP + c16 * 8) * 2) = rq1;
            *(LAS v4u*)(lds + L_K + (r0 * QP + c16 * 8) * 2) = rk0; *(LAS v4u*)(lds + L_K + ((r0 + 32) * QP + c16 * 8) * 2) = rk1;
            if (tid < 256) *(LAS v4u*)(lds + L_V + (mv * VP + c8v * 8) * 2) = rv;
            const f32x4 dec0 = rdec0, dec1 = rdec1;
            __syncthreads();
            if (n + 1 < 64) {
                pq += (size_t)64 * NGLA; pv += (size_t)64 * NGLA; pdec += 512;
                rq0 = *(const v4u*)pq; rq1 = *(const v4u*)(pq + (size_t)32 * NGLA); rk0 = *(const v4u*)(pq + 512); rk1 = *(const v4u*)(pq + (size_t)32 * NGLA + 512);
                rv = *(const v4u*)pv; rdec0 = *(const f32x4*)pdec; rdec1 = *(const f32x4*)(pdec + 16);
            }
            if (wave < 4) {
                const int qi = wave; f32x4 o[2] = {(f32x4){0.f, 0.f, 0.f, 0.f}, (f32x4){0.f, 0.f, 0.f, 0.f}};
                bf16x8 qf[4];
#pragma unroll
                for (int kk = 0; kk < 4; ++kk) qf[kk] = ldfrag(lds + L_Q + ((16 * qi + l16) * QP + kk * 32 + lq * 8) * 2);
#pragma unroll
                for (int t = 0; t < 2; ++t) if (2 * t <= qi) {
                    f32x4 a0 = (f32x4){0.f, 0.f, 0.f, 0.f}, a1 = a0;
#pragma unroll
                    for (int kk = 0; kk < 4; ++kk) a0 = __builtin_amdgcn_mfma_f32_16x16x32_bf16(ldfrag(lds + L_K + ((32 * t + l16) * QP + kk * 32 + lq * 8) * 2), qf[kk], a0, 0, 0, 0);
                    if (2 * t == qi) {
#pragma unroll
                        for (int ii = 0; ii < 4; ++ii) if (4 * lq + ii > l16) a0[ii] = 0.f; }
                    if (2 * t + 1 <= qi) {
#pragma unroll
                        for (int kk = 0; kk < 4; ++kk) a1 = __builtin_amdgcn_mfma_f32_16x16x32_bf16(ldfrag(lds + L_K + ((32 * t + 16 + l16) * QP + kk * 32 + lq * 8) * 2), qf[kk], a1, 0, 0, 0);
                        if (2 * t + 1 == qi) {
#pragma unroll
                            for (int ii = 0; ii < 4; ++ii) if (4 * lq + ii > l16) a1[ii] = 0.f; } }
                    const v4u bw = (v4u){pk2(a0[0], a0[1]), pk2(a0[2], a0[3]), pk2(a1[0], a1[1]), pk2(a1[2], a1[3])};
#pragma unroll
                    for (int jv = 0; jv < 2; ++jv) {
                        const bf16x8 aw = cat8(ldtr(lds + L_V, VP * 2, 32 * t + 4 * lq, 16 * jv, l16), ldtr(lds + L_V, VP * 2, 32 * t + 16 + 4 * lq, 16 * jv, l16));
                        o[jv] = __builtin_amdgcn_mfma_f32_16x16x32_bf16(aw, __builtin_bit_cast(bf16x8, bw), o[jv], 0, 0, 0); } }
#pragma unroll
                for (int jv = 0; jv < 2; ++jv) {
#pragma unroll
                    for (int kk = 0; kk < 4; ++kk) o[jv] = __builtin_amdgcn_mfma_f32_16x16x32_bf16(ldfrag(lds + L_ST + ((n & 1) * 32 * QP + (16 * jv + l16) * QP + kk * 32 + lq * 8) * 2), qf[kk], o[jv], 0, 0, 0);
                    *(v2u*)(O + (row0 + 16 * qi + l16) * D + h * 256 + vs * 32 + 16 * jv + 4 * lq) = (v2u){pk2(o[jv][0], o[jv][1]), pk2(o[jv][2], o[jv][3])}; }
            } else {
#pragma unroll
                for (int kk = 0; kk < 2; ++kk) {
                    bf16x8 vb[2];
#pragma unroll
                    for (int jv = 0; jv < 2; ++jv) vb[jv] = cat8(ldtr(lds + L_V, VP * 2, 32 * kk + 8 * lq, 16 * jv, l16), ldtr(lds + L_V, VP * 2, 32 * kk + 8 * lq + 4, 16 * jv, l16));
#pragma unroll
                    for (int bq = 0; bq < 2; ++bq) { const bf16x8 ka = cat8(ldtr(lds + L_K, QP * 2, 32 * kk + 8 * lq, 16 * (hb + bq), l16), ldtr(lds + L_K, QP * 2, 32 * kk + 8 * lq + 4, 16 * (hb + bq), l16));
#pragma unroll
                        for (int jv = 0; jv < 2; ++jv) S[bq][jv] = __builtin_amdgcn_mfma_f32_16x16x32_bf16(ka, vb[jv], S[bq][jv], 0, 0, 0); } }
#pragma unroll
                for (int bq = 0; bq < 2; ++bq)
#pragma unroll
                    for (int jv = 0; jv < 2; ++jv) { S[bq][jv] = S[bq][jv] * (bq ? dec1 : dec0);
                        *(LAS v2u*)(lds + L_ST + (((n + 1) & 1) * 32 * QP + (16 * jv + l16) * QP + 16 * (hb + bq) + 4 * lq) * 2) = (v2u){pk2(S[bq][jv][0], S[bq][jv][1]), pk2(S[bq][jv][2], S[bq][jv][3])}; }
            }
            __syncthreads();
        }
    }
}
__device__ __forceinline__ void gla_post(const bf16* O, const bf16* H, bf16* CAT, const float* gnorm, int gw, int ngw, int lane) {
    const int hs = lane >> 5, cl = (lane & 31) * 8;
    float gn[8];
#pragma unroll
    for (int e = 0; e < 8; ++e) gn[e] = gnorm[cl + e];
#pragma unroll 2
    for (int m = gw; m < M; m += ngw) {
        v4u ow[2], rw[2];
#pragma unroll
        for (int p = 0; p < 2; ++p) { ow[p] = __builtin_nontemporal_load((const v4u*)(O + (size_t)m * D + (hs + 2 * p) * 256 + cl)); rw[p] = __builtin_nontemporal_load((const v4u*)(H + (size_t)m * NGLA + 2048 + (hs + 2 * p) * 256 + cl)); }
#pragma unroll
        for (int p = 0; p < 2; ++p) { float o[8], r[8], y[8]; unpack8(ow[p], o); unpack8(rw[p], r);
            float ss = 0.f;
#pragma unroll
            for (int e = 0; e < 8; ++e) ss += o[e] * o[e];
#pragma unroll
            for (int sh = 1; sh < 32; sh <<= 1) ss += __shfl_xor(ss, sh);
            const float rs = rsqrtf(ss * (1.f / 256.f) + EPS);
#pragma unroll
            for (int e = 0; e < 8; ++e) y[e] = o[e] * rs * gn[e] * (r[e] / (1.f + __expf(-r[e])));
            *(v4u*)(CAT + (size_t)m * D + (hs + 2 * p) * 256 + cl) = (v4u){pk2(y[0], y[1]), pk2(y[2], y[3]), pk2(y[4], y[5]), pk2(y[6], y[7])}; }
    }
}

#define XB_TMO      128
#define XB_XCNT(j)  (256  + 64 * (j))
#define XB_XSUB(j)  (1280 + 64 * (j))
#define XB_XGEN(j)  (2304 + 64 * (j))
#define XB_TOP      3328
#define XB_TOPGEN   3392
#define XCD_BAR_WORDS 3456
#define XB_SPIN_CAP (1u << 18)

__device__ __forceinline__ unsigned xb_ld(unsigned* p)              { return __hip_atomic_load(p, __ATOMIC_RELAXED, __HIP_MEMORY_SCOPE_AGENT); }
__device__ __forceinline__ unsigned xb_add(unsigned* p, unsigned v) { return __hip_atomic_fetch_add(p, v, __ATOMIC_RELAXED, __HIP_MEMORY_SCOPE_AGENT); }
__device__ __forceinline__ unsigned xb_xcc_id() { return (unsigned)__builtin_amdgcn_s_getreg((3 << 11) | 20) & 0xFu; }
#define XB_SPIN(cond, bar) do { unsigned _sp = 0; while (cond) { __builtin_amdgcn_s_sleep(1); \
    if ((++_sp & 255u) == 0u) { if (xb_ld(&(bar)[XB_TMO])) break; if (_sp > XB_SPIN_CAP) { atomicAdd(&(bar)[XB_TMO], 1u); break; } } } } while (0)

struct XcdBarrier {
    unsigned* bar; unsigned x;
    volatile LAS unsigned* st;
};

__device__ __forceinline__ XcdBarrier xcd_barrier_post(unsigned* bar, volatile LAS unsigned* st) {
    XcdBarrier b; b.bar = bar; b.x = xb_xcc_id(); b.st = st;
    if (threadIdx.x == 0) (void)xb_add(&bar[XB_XCNT(b.x)], 1u);
    return b;
}
__device__ __forceinline__ void xcd_barrier_complete(unsigned* bar, unsigned x, unsigned& nloc, unsigned& nx) {
    const unsigned G = gridDim.x * gridDim.y * gridDim.z;
    unsigned sum, cnt, mine, sp = 0u;
    for (;;) {
        sum = 0u; cnt = 0u; mine = 0u;
#pragma unroll
        for (unsigned j = 0; j < 16; ++j) { const unsigned c = xb_ld(&bar[XB_XCNT(j)]); sum += c; cnt += (c > 0u) ? 1u : 0u; mine = (j == x) ? c : mine; }
        if (sum == G) break;
        __builtin_amdgcn_s_sleep(1);
        if ((++sp & 255u) == 0u) { if (xb_ld(&bar[XB_TMO])) break; if (sp > XB_SPIN_CAP) { atomicAdd(&bar[XB_TMO], 1u); break; } }
    }
    nloc = mine > 0u ? mine : 1u; nx = cnt > 0u ? cnt : 1u;
}

__device__ __forceinline__ void xcd_barrier(const XcdBarrier& b) {
    asm volatile("s_waitcnt vmcnt(0)" ::: "memory");
    __syncthreads();
    if (threadIdx.x == 0) {
        unsigned* bar = b.bar;
        __builtin_amdgcn_s_waitcnt(0);
        unsigned nloc = b.st[0], nx = b.st[1];
        if (nloc == 0u) { xcd_barrier_complete(bar, b.x, nloc, nx); b.st[0] = nloc; b.st[1] = nx; }
        const unsigned old = xb_add(&bar[XB_XSUB(b.x)], 1u);
        const unsigned gen = old / nloc;
        if (old + 1u == (gen + 1u) * nloc) {
            __builtin_amdgcn_fence(__ATOMIC_RELEASE, "agent");
            asm volatile("s_waitcnt vmcnt(0)" ::: "memory");
            const unsigned og = xb_add(&bar[XB_TOP], 1u);
            const unsigned tg = og / nx;
            if (og + 1u == (tg + 1u) * nx) xb_add(&bar[XB_TOPGEN], 1u);
            else XB_SPIN(xb_ld(&bar[XB_TOPGEN]) == tg, bar);
            __builtin_amdgcn_fence(__ATOMIC_ACQUIRE, "agent");
            xb_add(&bar[XB_XGEN(b.x)], 1u);
            asm volatile("s_waitcnt vmcnt(0)" ::: "memory");
        } else {
            XB_SPIN(xb_ld(&bar[XB_XGEN(b.x)]) == gen, bar);
            __builtin_amdgcn_fence(__ATOMIC_ACQUIRE, "agent");
            asm volatile("s_waitcnt vmcnt(0)" ::: "memory");
        }
    }
    __syncthreads();
}

#define GRID_SYNC() do { XcdBarrier b_; b_.bar = (unsigned*)(GAS unsigned*)karg(21); b_.x = xb_xcc_id(); b_.st = (volatile LAS unsigned*)(lds + MISC_OFF); xcd_barrier(b_); } while (0)
constexpr int MISC_OFF = XCH_OFF + 8192;
#define GAS __attribute__((address_space(1)))
typedef const __attribute__((address_space(4))) unsigned long long* kaptr_t;
__device__ __forceinline__ unsigned long long karg(int k) { kaptr_t p = (kaptr_t)__builtin_amdgcn_kernarg_segment_ptr(); asm volatile("" : "+s"(p)); return p[k]; }
#define INF(k) ((const float*)(const GAS float*)karg(k))
#define XOUT() ((float*)(GAS float*)karg(20))
#define WSB(off) ((bf16*)(GAS bf16*)(karg(21) + (off)))
#define WSF(off) ((float*)(GAS float*)(karg(21) + (off)))
#define RSSP(i) WSF(60 * MiB + (size_t)(i) * 524288)
__global__ void __launch_bounds__(NTHR, 2) fwd_megakernel(Args args) {
    extern __shared__ __attribute__((aligned(16))) unsigned char lds_raw[];
    cg::grid_group grid = cg::this_grid();
    LAS unsigned char* lds = (LAS unsigned char*)lds_raw;
    { const int tid = threadIdx.x; if (tid < 2) ((LAS unsigned*)(lds + MISC_OFF))[tid] = 0u; }
    __syncthreads();
    grid.sync();
    (void)xcd_barrier_post((unsigned*)(GAS unsigned*)karg(21), (volatile LAS unsigned*)(lds + MISC_OFF));
    (void)args;
#define WAVE_IDS() const int tid_ = fresh_tid(), lane = tid_ & 63, wave = __builtin_amdgcn_readfirstlane(tid_ >> 6), G = gridDim.x, wg = blockIdx.x, gw = wg * NWAVES + wave, ngw = G * NWAVES

    {
        WAVE_IDS();
        LAS float* scr = (LAS float*)(lds + wave * 16384);
        constexpr int I_ABIN = 16 * 48, I_ABOUT = 16 * 32, I_GLAIN = 16 * 96, I_GLAOUT = 16 * 32, I_UP = 16 * 176, I_DN = 44 * 32;
        constexpr int NITEMS = I_ABIN + I_ABOUT + I_GLAIN + I_GLAOUT + 2 * I_UP + 2 * I_DN;
        for (int it = gw; it < NITEMS; it += ngw) {
            int r = it;
            if (r < I_ABIN) { const int kb = r / 48, nb = r % 48; transpose_item(INF(3), NAB, D, WSB(WS_WABIN), kb * 64, 512 + nb * 32, 512 + nb * 32, scr, lane, INF(1)); continue; } r -= I_ABIN;
            if (r < I_ABOUT) { const int kb = r / 32, nb = r % 32; transpose_item(INF(9), D, D, WSB(WS_WABOUT), kb * 64, nb * 32, nb * 32, scr, lane); continue; } r -= I_ABOUT;
            if (r < I_GLAIN) { const int kb = r / 96, nb = r % 96; transpose_item(INF(10), GLA_SRC_N, D, WSB(WS_WGLAIN), kb * 64, nb * 32, nb * 32, scr, lane, INF(1) + D); continue; } r -= I_GLAIN;
            if (r < I_GLAOUT) { const int kb = r / 32, nb = r % 32; transpose_item(INF(14), D, D, WSB(WS_WGLAOUT), kb * 64, nb * 32, nb * 32, scr, lane); continue; } r -= I_GLAOUT;
            if (r < 2 * I_UP) { const int l = r / I_UP, q = r % I_UP, kb = q / 176, nb = q % 176, n0 = nb * 32, isv = n0 >= FFD, ch = isv ? n0 - FFD : n0;
                transpose_item(INF(15) + (size_t)l * D * NUP, NUP, D, WSB(WS_WUP) + (size_t)l * NUP * D, kb * 64, n0, (ch >> 7) * 256 + isv * 128 + (ch & 127), scr, lane, INF(2) + (size_t)l * D); continue; } r -= 2 * I_UP;
            { const int l = r / I_DN, q = r % I_DN, kb = q / 32, nb = q % 32;
                transpose_item(INF(18) + (size_t)l * FFD * D, D, FFD, WSB(WS_WDN) + (size_t)l * D * FFD, kb * 64, nb * 32, nb * 32, scr, lane); }
        }
        __syncthreads();
        for (int fb = wg; fb < 256; fb += G) {
            const int g = fb & 3, kb = fb >> 2; LAS float* PW = (LAS float*)lds; LAS float* WI = (LAS float*)(lds + 65536);
            const float* poolw = INF(4) + (size_t)g * 16384; const float* abin = INF(3) + (size_t)(16 * kb) * NAB + g * 128;
#pragma unroll
            for (int q = 0; q < 8; ++q) *(LAS f32x4*)(PW + 4 * (tid_ + NTHR * q)) = *(const f32x4*)(poolw + 4 * (tid_ + NTHR * q));
            *(LAS f32x4*)(WI + 4 * tid_) = *(const f32x4*)(abin + (size_t)(tid_ >> 5) * NAB + (tid_ & 31) * 4);
            __syncthreads();
            const int n = tid_ & 127, kq = tid_ >> 7; const LAS float* wi = WI + (4 * kq) * 128;
            float s0 = 0.f, s1 = 0.f, s2 = 0.f, s3 = 0.f;
#pragma unroll 16
            for (int c = 0; c < 128; ++c) { const float w = PW[c * 128 + n]; s0 += wi[c] * w; s1 += wi[128 + c] * w; s2 += wi[256 + c] * w; s3 += wi[384 + c] * w; }
            const int k0 = 16 * kb + 4 * kq; const f32x4 m0 = *(const f32x4*)(INF(1) + k0);
            *(v2u*)(WSB(WS_WABIN) + (size_t)(g * 128 + n) * D + k0) = (v2u){pk2(s0 * m0[0], s1 * m0[1]), pk2(s2 * m0[2], s3 * m0[3])};
            __syncthreads();
        }
        { const float* glain = INF(10); const float* wg2 = INF(11); const float* mn1 = INF(1) + D; bf16* W_GLAIN = WSB(WS_WGLAIN);
        for (int idx = wg * NTHR + tid_; idx < 256 * 512; idx += G * NTHR) {
            const int k4 = idx >> 9, n = idx & 511;
            const float* gi = glain + (size_t)(4 * k4) * GLA_SRC_N + 3072; const float* g2 = wg2 + n;
            float t0 = 0.f, t1 = 0.f, t2 = 0.f, t3 = 0.f;
#pragma unroll
            for (int r = 0; r < 16; ++r) { const float w = g2[r * 512]; t0 += gi[r] * w; t1 += gi[GLA_SRC_N + r] * w; t2 += gi[2 * GLA_SRC_N + r] * w; t3 += gi[3 * GLA_SRC_N + r] * w; }
            const f32x4 mg = *(const f32x4*)(mn1 + 4 * k4);
            *(v2u*)(W_GLAIN + (size_t)(3072 + n) * D + 4 * k4) = (v2u){pk2(t0 * mg[0], t1 * mg[1]), pk2(t2 * mg[2], t3 * mg[3])};
        } }
        convert_rows(INF(0), WSB(WS_XS), RSSP(4), gw, ngw, lane);
    }
    GRID_SYNC();

    for (int l = 0; l < 2; ++l) {
        { const int N = (l == 0) ? NAB : NGLA;
          pg8::Gemm g{WSB(WS_XS), (l == 0) ? WSB(WS_WABIN) : WSB(WS_WGLAIN), M, N, D}; pg8::StaticOrder S; S.init(M, N, gridDim.x, blockIdx.x);
          pg8::EpiBf16P E{WSB(WS_H), N, (l == 0) ? (const float*)RSSP(4) : (const float*)RSSP(1), (LAS float*)(lds + XCH_OFF)};
          if (PHM & 1) pg8::gemm_phase<pg8::EpiBf16P, pg8::StaticOrder, true, true>(lds, g, S, E); }
        GRID_SYNC();
        if (l == 0) {
            if (PHM & 2) ab_mixer(WSB(WS_H), WSB(WS_CAT), INF(5), INF(6), INF(7), INF(8), blockIdx.x, gridDim.x, fresh_tid());
        } else {
            if (PHM & 4) gla_prep(WSB(WS_H), WSB(WS_CAT), WSF(WS_DEC), INF(12), blockIdx.x, gridDim.x, fresh_tid());
            GRID_SYNC();
            if (PHM & 8) gla_scan(lds, WSB(WS_H), WSF(WS_DEC), WSB(WS_XN), blockIdx.x, gridDim.x, fresh_tid());
            GRID_SYNC();
            { WAVE_IDS(); if (PHM & 16) gla_post(WSB(WS_XN), WSB(WS_H), WSB(WS_CAT), INF(13), gw, ngw, lane); }
        }
        GRID_SYNC();
        { pg8::Gemm g{WSB(WS_CAT), (l == 0) ? WSB(WS_WABOUT) : WSB(WS_WGLAOUT), M, D, D}; pg8::StaticOrder S; S.init(M, D, gridDim.x, blockIdx.x);
          pg8::EpiRes E{(const float*)nullptr, WSB(WS_XS), D, RSSP(2 * l), (LAS float*)(lds + XCH_OFF)};
          if (PHM & 32) pg8::gemm_phase<pg8::EpiRes, pg8::StaticOrder, true, true>(lds, g, S, E); }
        GRID_SYNC();
        { pg8::Gemm g{WSB(WS_XS), WSB(WS_WUP) + (size_t)l * NUP * D, M, NUP, D}; pg8::StaticOrder S; S.init(M, NUP, gridDim.x, blockIdx.x);
          pg8::EpiFfnUp E{WSB(WS_H), INF(16) + (size_t)l * 3 * FFD, INF(17) + (size_t)l * FFD, WSF(WS_ULAST), WSF(WS_UFIRST), WSF(WS_VFIRST), (LAS f32x4*)(lds + XCH_OFF), RSSP(2 * l)};
          if (PHM & 64) pg8::gemm_phase<pg8::EpiFfnUp, pg8::StaticOrder, true, true, true>(lds, g, S, E); }
        GRID_SYNC();
        { pg8::Gemm g{WSB(WS_H), WSB(WS_WDN) + (size_t)l * D * FFD, M, D, FFD}; pg8::StaticOrder S; S.init(M, D, gridDim.x, blockIdx.x);
          if (PHM & 256) {
          const float* cw = INF(16) + (size_t)l * 3 * FFD; const float* cb = INF(17) + (size_t)l * FFD;
          const float* ULAST = WSF(WS_ULAST); const float* UFIRST = WSF(WS_UFIRST); const float* VFIRST = WSF(WS_VFIRST); bf16* ACT = WSB(WS_H);
          pg8::Unit u;
          for (int i = 0; S.next(i, u); ++i) {
              if ((u.pm & 15) == 0) continue;
              for (int c4 = fresh_tid(); c4 < FFD / 4; c4 += NTHR) {
                  const int ch = 4 * c4;
                  const f32x4 uf0 = *(const f32x4*)(UFIRST + (size_t)(u.pm * 2) * FFD + ch), uf1 = *(const f32x4*)(UFIRST + (size_t)(u.pm * 2 + 1) * FFD + ch);
                  const f32x4 ul0 = *(const f32x4*)(ULAST + (size_t)((u.pm - 1) * 2) * FFD + ch), ul1 = *(const f32x4*)(ULAST + (size_t)((u.pm - 1) * 2 + 1) * FFD + ch);
                  const f32x4 vf0 = *(const f32x4*)(VFIRST + (size_t)(u.pm * 2) * FFD + ch), vf1 = *(const f32x4*)(VFIRST + (size_t)(u.pm * 2 + 1) * FFD + ch);
                  const f32x4 a0 = *(const f32x4*)(cw + ch), a1 = *(const f32x4*)(cw + FFD + ch), a2 = *(const f32x4*)(cw + 2 * FFD + ch), bb = *(const f32x4*)(cb + ch);
                  const f32x4 u0 = bb + a0 * ul0 + a1 * ul1 + a2 * uf0, u1 = bb + a0 * ul1 + a1 * uf0 + a2 * uf1;
                  const f32x2 g00 = pg8::gelu_pk((f32x2){u0[0], u0[1]}), g01 = pg8::gelu_pk((f32x2){u0[2], u0[3]}), g10 = pg8::gelu_pk((f32x2){u1[0], u1[1]}), g11 = pg8::gelu_pk((f32x2){u1[2], u1[3]});
                  *(v2u*)(ACT + (size_t)(u.pm * 256) * FFD + ch) = (v2u){pk2(g00.x * vf0[0], g00.y * vf0[1]), pk2(g01.x * vf0[2], g01.y * vf0[3])};
                  *(v2u*)(ACT + (size_t)(u.pm * 256 + 1) * FFD + ch) = (v2u){pk2(g10.x * vf1[0], g10.y * vf1[1]), pk2(g11.x * vf1[2], g11.y * vf1[3])};
              }
          }
          asm volatile("s_waitcnt vmcnt(0)" ::: "memory"); __syncthreads();
          }
          if (l == 0 || gridDim.x != 256) { pg8::EpiRes E{(const float*)nullptr, WSB(WS_XS), D, RSSP(2 * l + 1), (LAS float*)(lds + XCH_OFF)};
              pg8::gemm_phase<pg8::EpiRes, pg8::StaticOrder, true, true>(lds, g, S, E); }
          else { pg8::EpiResFinal E{WSB(WS_XS), XOUT(), D, RSSP(3), INF(19), (unsigned*)(GAS unsigned*)(karg(21) + 16384), (LAS float*)(lds + XCH_OFF)};
              pg8::gemm_phase<pg8::EpiResFinal, pg8::StaticOrder, true, true>(lds, g, S, E); } }
        if (l == 0) GRID_SYNC();
    }
    if (gridDim.x != 256) { GRID_SYNC(); WAVE_IDS(); final_norm_rows(WSB(WS_XS), XOUT(), INF(19), RSSP(3), gw, ngw, lane); }
}

extern "C" void kernel_launch(void* const* d_in, const int* in_sizes, int n_in, void* d_out, int out_size, void* d_ws, size_t ws_size, hipStream_t stream) {
    static int grid_blocks = 0;
    if (grid_blocks == 0) {
        if (n_in != 20 || out_size != M * D || ws_size < WS_END) { fprintf(stderr, "kernel_launch: unexpected shapes (n_in %d out %d ws %zu)\n", n_in, out_size, ws_size); grid_blocks = -1; return; }
        int dev = 0, cus = 0, per_cu = 0;
        hipGetDevice(&dev); hipDeviceGetAttribute(&cus, hipDeviceAttributeMultiprocessorCount, dev);
        if (hipFuncSetAttribute((const void*)fwd_megakernel, hipFuncAttributeMaxDynamicSharedMemorySize, LDS_BYTES) != hipSuccess) fprintf(stderr, "kernel_launch: hipFuncSetAttribute failed\n");
        if (hipOccupancyMaxActiveBlocksPerMultiprocessor(&per_cu, (const void*)fwd_megakernel, NTHR, LDS_BYTES) != hipSuccess || per_cu < 1) { fprintf(stderr, "kernel_launch: occupancy query says %d\n", per_cu); per_cu = 1; }
        (void)hipGetLastError();
        grid_blocks = cus * per_cu;
    }
    if (grid_blocks < 0) return;
    if (hipMemsetAsync(d_ws, 0, 65536, stream) != hipSuccess) { fprintf(stderr, "kernel_launch: memset failed\n"); return; }
    Args a{};
    for (int i = 0; i < 20; ++i) a.in[i] = (const float*)d_in[i];
    a.out = (float*)d_out; a.ws = (unsigned char*)d_ws;
    void* kargs[] = {&a};
    hipError_t e = hipLaunchCooperativeKernel((const void*)fwd_megakernel, dim3(grid_blocks), dim3(NTHR), kargs, LDS_BYTES, stream);
    if (e != hipSuccess) fprintf(stderr, "cooperative launch failed: %s (grid %d)\n", hipGetErrorString(e), grid_blocks);
}
```
